# Optimizing an MI355X kernel written in HIP

```python
import math
import jax, jax.numpy as jnp
from jax import lax
import numpy as np

D_MODEL = 2048
BATCH = 4
SEQ = 2048
DEPTH = 2

EXPAND = 2
MIX_WIDTH = EXPAND * D_MODEL
SSD_WIDTH = MIX_WIDTH // 2
SSD_HEAD_DIM = 64
SSD_HEADS = SSD_WIDTH // SSD_HEAD_DIM
SSD_GROUPS = 8
SSD_STATE = 128
SSD_CONV = 4
SSD_CHUNK = 128
SSD_CONV_DIM = SSD_WIDTH + 2 * SSD_GROUPS * SSD_STATE
SGU_WIDTH = MIX_WIDTH - SSD_WIDTH
SGU_CHUNK = 128
SGU_GROUPS = 16
SGU_GROUP_DIM = SGU_WIDTH // SGU_GROUPS
EVEN_SPLITS = (SSD_WIDTH, SSD_CONV_DIM, SSD_HEADS, SGU_WIDTH, SGU_WIDTH, SGU_WIDTH)
EVEN_IN = sum(EVEN_SPLITS)
DIFF_HEADS = 16
DIFF_HEAD_DIM = 128
DIFF_V_DIM = 2 * DIFF_HEAD_DIM
DIFF_WIDTH = DIFF_HEADS * DIFF_V_DIM
ODD_IN = 4 * DIFF_WIDTH
Q_BLOCK = 128
EPS = 1e-6
N_EVEN = (DEPTH + 1) // 2
N_ODD = DEPTH // 2

kernel_name = "hybrid_ssd_sgu_diffattn_block"


def rmsnorm(x, w):
    xf = x.astype(jnp.float32)
    y = xf * lax.rsqrt(jnp.mean(xf * xf, axis=-1, keepdims=True) + EPS)
    return (y * w.astype(jnp.float32)).astype(x.dtype)


def layernorm(x, w, b):
    xf = x.astype(jnp.float32)
    mu = jnp.mean(xf, axis=-1, keepdims=True)
    xc = xf - mu
    y = xc * lax.rsqrt(jnp.mean(xc * xc, axis=-1, keepdims=True) + EPS)
    return (y * w.astype(jnp.float32) + b.astype(jnp.float32)).astype(x.dtype)


def causal_depthwise_conv(x, w, b):
    K, C = w.shape
    y = lax.conv_general_dilated(x, w[:, None, :].astype(x.dtype), window_strides=(1,),
                                 padding=[(K - 1, 0)], dimension_numbers=('NWC', 'WIO', 'NWC'),
                                 feature_group_count=C)
    return y + b.astype(x.dtype)


def ssd_chunked(x, dt, a, bmat, cmat, d_skip):
    Bsz, S, H, P = x.shape
    G, N = bmat.shape[2], bmat.shape[3]
    R = H // G
    L = SSD_CHUNK
    nc = S // L
    xd = (x * dt[..., None].astype(x.dtype)).reshape(Bsz, nc, L, G, R, P)
    da = (dt.astype(jnp.float32) * a).reshape(Bsz, nc, L, G, R)
    da = jnp.moveaxis(da, 2, -1)
    cs = jnp.cumsum(da, axis=-1)
    bc = bmat.reshape(Bsz, nc, L, G, N)
    cc = cmat.reshape(Bsz, nc, L, G, N)
    causal = jnp.tril(jnp.ones((L, L), dtype=bool))
    seg = cs[..., :, None] - cs[..., None, :]
    decay = jnp.where(causal, jnp.exp(jnp.where(causal, seg, 0.0)), 0.0)
    cb = jnp.einsum('bclgn,bcsgn->bcgls', cc, bc)
    y_diag = jnp.einsum('bcgls,bcgrls,bcsgrp->bclgrp', cb, decay, xd)
    decay_to_end = jnp.exp(cs[..., -1:] - cs)
    states = jnp.einsum('bclgn,bcgrl,bclgrp->bcgrpn', bc, decay_to_end, xd).astype(jnp.float32)
    chunk_decay = jnp.exp(cs[..., -1])

    def step(h, inp):
        st, dec = inp
        return h * dec[..., None, None] + st, h

    h0 = jnp.zeros((Bsz, G, R, P, N), jnp.float32)
    _, prev = lax.scan(step, h0, (jnp.moveaxis(states, 1, 0), jnp.moveaxis(chunk_decay, 1, 0)))
    prev = jnp.moveaxis(prev, 0, 1)
    y_off = jnp.einsum('bclgn,bcgrpn,bcgrl->bclgrp', cc, prev, jnp.exp(cs))
    y = (y_diag + y_off).reshape(Bsz, S, H, P).astype(x.dtype)
    return y + x * d_skip[:, None].astype(x.dtype)


def even_mixer(h, w_in, conv_w, conv_b, dt_bias, a_log, d_skip, ssd_norm_w,
               sgu_ln_w, sgu_ln_b, sgu_ws, sgu_b, w_out):
    Bsz, S, _ = h.shape
    proj = h @ w_in
    z_a, xbc, dt_raw, z_b, u, v = jnp.split(proj, [int(c) for c in np.cumsum(EVEN_SPLITS)[:-1]], axis=-1)
    xbc = jax.nn.silu(causal_depthwise_conv(xbc, conv_w, conv_b))
    xs, bm, cm = jnp.split(xbc, [SSD_WIDTH, SSD_WIDTH + SSD_GROUPS * SSD_STATE], axis=-1)
    dt = jax.nn.softplus(dt_raw.astype(jnp.float32) + dt_bias.astype(jnp.float32))
    a = -jnp.exp(a_log.astype(jnp.float32))
    y = ssd_chunked(xs.reshape(Bsz, S, SSD_HEADS, SSD_HEAD_DIM), dt, a,
                    bm.reshape(Bsz, S, SSD_GROUPS, SSD_STATE),
                    cm.reshape(Bsz, S, SSD_GROUPS, SSD_STATE), d_skip)
    y = y.reshape(Bsz, S, SSD_WIDTH) * jax.nn.silu(z_a)
    y_a = rmsnorm(y.reshape(Bsz, S, SSD_GROUPS, SSD_WIDTH // SSD_GROUPS),
                  ssd_norm_w.reshape(SSD_GROUPS, -1)).reshape(Bsz, S, SSD_WIDTH)
    u = jax.nn.gelu(u)
    v = layernorm(jax.nn.gelu(v), sgu_ln_w, sgu_ln_b)
    nc = S // SGU_CHUNK
    vg = v.reshape(Bsz, nc, SGU_CHUNK, SGU_GROUPS, SGU_GROUP_DIM)
    ws = sgu_ws * jnp.tril(jnp.ones((SGU_CHUNK, SGU_CHUNK), sgu_ws.dtype))
    mixed = jnp.einsum('gts,bnsgc->bntgc', ws, vg) + sgu_b.T[:, :, None]
    y_b = u * mixed.reshape(Bsz, S, SGU_WIDTH) * jax.nn.silu(z_b)
    return jnp.concatenate([y_a, y_b], axis=-1) @ w_out


def odd_mixer(h, w_in, lam_q1, lam_k1, lam_q2, lam_k2, subln_w, w_out, lambda_init):
    Bsz, S, _ = h.shape
    proj = h @ w_in
    q, k, v, g = jnp.split(proj, 4, axis=-1)
    q = q.reshape(Bsz, S, DIFF_HEADS, 2, DIFF_HEAD_DIM).transpose(0, 2, 3, 1, 4)
    k = k.reshape(Bsz, S, DIFF_HEADS, 2, DIFF_HEAD_DIM).transpose(0, 2, 3, 1, 4)
    v = v.reshape(Bsz, S, DIFF_HEADS, DIFF_V_DIM).transpose(0, 2, 1, 3)
    lam = (jnp.exp(jnp.sum(lam_q1.astype(jnp.float32) * lam_k1.astype(jnp.float32)))
           - jnp.exp(jnp.sum(lam_q2.astype(jnp.float32) * lam_k2.astype(jnp.float32)))
           + lambda_init)
    scale = DIFF_HEAD_DIM ** -0.5
    outs = []
    for i in range(S // Q_BLOCK):
        end = (i + 1) * Q_BLOCK
        qb = q[:, :, :, i * Q_BLOCK:end]
        kb = k[:, :, :, :end]
        s = jnp.einsum('bhjqd,bhjkd->bhjqk', qb, kb).astype(jnp.float32) * scale
        qpos = i * Q_BLOCK + jnp.arange(Q_BLOCK)
        kpos = jnp.arange(end)
        s = jnp.where(kpos[None, :] <= qpos[:, None], s, -jnp.inf)
        p = jax.nn.softmax(s, axis=-1)
        attn = p[:, :, 0] - lam * p[:, :, 1]
        outs.append(jnp.einsum('bhqk,bhkd->bhqd', attn.astype(v.dtype), v[:, :, :end]))
    o = jnp.concatenate(outs, axis=2)
    o = rmsnorm(o, subln_w) * (1.0 - lambda_init)
    o = o.transpose(0, 2, 1, 3).reshape(Bsz, S, DIFF_WIDTH) * jax.nn.silu(g)
    return o @ w_out


def setup_inputs(seed: int = 0) -> dict:
    key = jax.random.key(seed)
    ks = jax.random.split(key, 24)
    f32 = jnp.float32
    nrm = lambda k, shape, s: jax.random.normal(k, shape, f32) * s
    dt0 = jnp.exp(jax.random.uniform(ks[5], (N_EVEN, SSD_HEADS), f32, math.log(1e-3), math.log(1e-1)))
    return {
        "x": nrm(ks[0], (BATCH, SEQ, D_MODEL), 1.0),
        "norm_w": 1.0 + nrm(ks[1], (DEPTH, D_MODEL), 0.02),
        "even_w_in": nrm(ks[2], (N_EVEN, D_MODEL, EVEN_IN), D_MODEL ** -0.5),
        "even_conv_w": nrm(ks[3], (N_EVEN, SSD_CONV, SSD_CONV_DIM), SSD_CONV ** -0.5),
        "even_conv_b": nrm(ks[4], (N_EVEN, SSD_CONV_DIM), 0.02),
        "even_dt_bias": dt0 + jnp.log(-jnp.expm1(-dt0)),
        "even_a_log": jnp.log(jax.random.uniform(ks[6], (N_EVEN, SSD_HEADS), f32, 1.0, 16.0)),
        "even_d_skip": 1.0 + nrm(ks[7], (N_EVEN, SSD_HEADS), 0.02),
        "even_ssd_norm_w": 1.0 + nrm(ks[8], (N_EVEN, SSD_WIDTH), 0.02),
        "even_sgu_ln_w": 1.0 + nrm(ks[9], (N_EVEN, SGU_WIDTH), 0.02),
        "even_sgu_ln_b": nrm(ks[10], (N_EVEN, SGU_WIDTH), 0.02),
        "even_sgu_ws": nrm(ks[11], (N_EVEN, SGU_GROUPS, SGU_CHUNK, SGU_CHUNK), SGU_CHUNK ** -0.5),
        "even_sgu_b": 1.0 + nrm(ks[12], (N_EVEN, SGU_GROUPS, SGU_CHUNK), 0.02),
        "even_w_out": nrm(ks[13], (N_EVEN, MIX_WIDTH, D_MODEL), MIX_WIDTH ** -0.5),
        "odd_w_in": nrm(ks[14], (N_ODD, D_MODEL, ODD_IN), D_MODEL ** -0.5),
        "odd_lam_q1": nrm(ks[15], (N_ODD, DIFF_HEAD_DIM), 0.1),
        "odd_lam_k1": nrm(ks[16], (N_ODD, DIFF_HEAD_DIM), 0.1),
        "odd_lam_q2": nrm(ks[17], (N_ODD, DIFF_HEAD_DIM), 0.1),
        "odd_lam_k2": nrm(ks[18], (N_ODD, DIFF_HEAD_DIM), 0.1),
        "odd_subln_w": 1.0 + nrm(ks[19], (N_ODD, DIFF_V_DIM), 0.02),
        "odd_w_out": nrm(ks[20], (N_ODD, DIFF_WIDTH, D_MODEL), DIFF_WIDTH ** -0.5),
        "final_norm_w": 1.0 + nrm(ks[21], (D_MODEL,), 0.02),
    }


def reference(x, norm_w, even_w_in, even_conv_w, even_conv_b, even_dt_bias, even_a_log,
              even_d_skip, even_ssd_norm_w, even_sgu_ln_w, even_sgu_ln_b, even_sgu_ws,
              even_sgu_b, even_w_out, odd_w_in, odd_lam_q1, odd_lam_k1, odd_lam_q2,
              odd_lam_k2, odd_subln_w, odd_w_out, final_norm_w):
    h = x
    for layer in range(DEPTH):
        hn = rmsnorm(h, norm_w[layer])
        i = layer // 2
        if layer % 2 == 0:
            h = h + even_mixer(hn, even_w_in[i], even_conv_w[i], even_conv_b[i], even_dt_bias[i],
                               even_a_log[i], even_d_skip[i], even_ssd_norm_w[i],
                               even_sgu_ln_w[i], even_sgu_ln_b[i], even_sgu_ws[i],
                               even_sgu_b[i], even_w_out[i])
        else:
            lambda_init = 0.8 - 0.6 * math.exp(-0.3 * layer)
            h = h + odd_mixer(hn, odd_w_in[i], odd_lam_q1[i], odd_lam_k1[i], odd_lam_q2[i],
                              odd_lam_k2[i], odd_subln_w[i], odd_w_out[i], lambda_init)
    return rmsnorm(h, final_norm_w)
```

```cpp
#include <hip/hip_runtime.h>
#include <stdint.h>
#include <stdio.h>

typedef unsigned short bf16_t;
__device__ __forceinline__ float bf2f(bf16_t v) { return __uint_as_float(((unsigned)v) << 16); }
__device__ __forceinline__ bf16_t f2bf(float f) { unsigned u = __float_as_uint(f); return (bf16_t)((u + 0x7fffu + ((u >> 16) & 1u)) >> 16); }
__device__ __forceinline__ float sigmoidf_(float v) { return 1.f / (1.f + __expf(-v)); }
__device__ __forceinline__ float siluf_(float v) { return v * sigmoidf_(v); }
__device__ __forceinline__ float geluf_(float v) { const float c = 0.7978845608028654f; float t = tanhf(c * (v + 0.044715f * v * v * v)); return 0.5f * v * (1.f + t); }
__device__ __forceinline__ float softplusf_(float v) { return v > 20.f ? v : log1pf(__expf(v)); }

constexpr int NB = 4, S = 2048, M = NB * S, D = 2048;
constexpr int EVEN_IN = 12320, N1 = 12288;
constexpr int C_ZA = 0, C_XBC = 2048, C_ZB = 6144, C_U = 8192, C_V = 10240;
constexpr int XBC_W = 4096;
constexpr int ODD_IN = 16384, MIXW = 4096;
constexpr float EPS = 1e-6f;
constexpr float LAMBDA_INIT = 0.35550906759096924f;

constexpr size_t MiB = 1u << 20;
constexpr size_t WS_XB = 145 * MiB;
constexpr size_t WS_PROJ0 = 177 * MiB;
constexpr size_t WS_STATES = 369 * MiB;
constexpr size_t WS_YCAT = 433 * MiB;
constexpr size_t WS_DT = 497 * MiB;
constexpr size_t WS_RSTD0 = 498 * MiB;
constexpr size_t WS_RSTD1 = WS_RSTD0 + 64 * 1024;
constexpr size_t WS_SGU_MU = WS_RSTD1 + 64 * 1024;
constexpr size_t WS_SGU_RS = WS_SGU_MU + 64 * 1024;
constexpr size_t WS_END = 499 * MiB;

__device__ __forceinline__ float wave_sum(float v) {
#pragma unroll
    for (int o = 1; o < 64; o <<= 1) v += __shfl_xor(v, o);
    return v;
}
__device__ __forceinline__ float block_sum256(float v, float* red) {
    v = wave_sum(v);
    __syncthreads();
    if ((threadIdx.x & 63) == 0) red[threadIdx.x >> 6] = v;
    __syncthreads();
    return red[0] + red[1] + red[2] + red[3];
}

__global__ __launch_bounds__(256) void k_prep(const float* __restrict__ x, const float* __restrict__ nw0, const float* __restrict__ w_in0,
                                              const float* __restrict__ dt_bias, bf16_t* xb, float* rstd0, float* dt) {
    __shared__ float red[4];
    __shared__ float xs[D];
    __shared__ float part[8][32];
    const int r = blockIdx.x, t = threadIdx.x;
    const float* xr = x + (size_t)r * D;
    float ss = 0.f;
#pragma unroll
    for (int i = 0; i < 8; ++i) { const int k = t + 256 * i; const float v = xr[k]; ss += v * v; xb[(size_t)r * D + k] = f2bf(v); xs[k] = v * nw0[k]; }
    const float tot = block_sum256(ss, red);
    const float rstd = rsqrtf(tot / (float)D + EPS);
    if (t == 0) rstd0[r] = rstd;
    const int h = t & 31, p = t >> 5;
    float acc = 0.f;
    for (int k = p * 256; k < p * 256 + 256; ++k) acc += xs[k] * w_in0[(size_t)k * EVEN_IN + 6144 + h];
    part[p][h] = acc;
    __syncthreads();
    if (t < 32) { float a = 0.f;
#pragma unroll
        for (int i = 0; i < 8; ++i) a += part[i][t];
        dt[(size_t)r * 32 + t] = softplusf_(a * rstd + dt_bias[t]); }
}

struct GemmP { const bf16_t* A; const float* kscale; const float* W; int lda; int ldw; int shift_from; int shift; int K; int pad; };
template <class EP>
__global__ __launch_bounds__(256) void k_gemm_naive(GemmP g, EP ep) {
    __shared__ float As[16][132];
    __shared__ float Bs[16][132];
    const int tid = threadIdx.x, bm = blockIdx.y * 128, bn = blockIdx.x * 128;
    const int tx = tid & 15, ty = tid >> 4;
    float acc[8][8];
#pragma unroll
    for (int i = 0; i < 8; ++i)
#pragma unroll
        for (int j = 0; j < 8; ++j) acc[i][j] = 0.f;
    for (int k0 = 0; k0 < g.K; k0 += 16) {
        { const int row = tid >> 1, kk = (tid & 1) * 8;
          const uint4 raw = *(const uint4*)(g.A + (size_t)(bm + row) * g.lda + k0 + kk);
          const unsigned w[4] = {raw.x, raw.y, raw.z, raw.w};
#pragma unroll
          for (int i = 0; i < 4; ++i) {
              const float lo = __uint_as_float(w[i] << 16), hi = __uint_as_float(w[i] & 0xffff0000u);
              const float s0 = g.kscale ? g.kscale[k0 + kk + 2 * i] : 1.f, s1 = g.kscale ? g.kscale[k0 + kk + 2 * i + 1] : 1.f;
              As[kk + 2 * i][row] = lo * s0; As[kk + 2 * i + 1][row] = hi * s1; } }
        { const int kk = tid >> 4, c = (tid & 15) * 8; const int gc = bn + c; const int sc = gc >= g.shift_from ? gc + g.shift : gc;
          const float* wp = g.W + (size_t)(k0 + kk) * g.ldw + sc;
          const float4 a = *(const float4*)wp, b = *(const float4*)(wp + 4);
          *(float4*)&Bs[kk][c] = a; *(float4*)&Bs[kk][c + 4] = b; }
        __syncthreads();
#pragma unroll
        for (int kk = 0; kk < 16; ++kk) {
            float a[8], b[8];
#pragma unroll
            for (int i = 0; i < 8; ++i) a[i] = As[kk][ty * 8 + i];
#pragma unroll
            for (int j = 0; j < 8; ++j) b[j] = Bs[kk][tx * 8 + j];
#pragma unroll
            for (int i = 0; i < 8; ++i)
#pragma unroll
                for (int j = 0; j < 8; ++j) acc[i][j] += a[i] * b[j];
        }
        __syncthreads();
    }
#pragma unroll
    for (int i = 0; i < 8; ++i)
#pragma unroll
        for (int j = 0; j < 8; ++j) ep(bm + ty * 8 + i, bn + tx * 8 + j, acc[i][j]);
}
struct EpScaleBf16 { bf16_t* O; const float* rs; int ldo; int pad; __device__ void operator()(int r, int c, float v) const { O[(size_t)r * ldo + c] = f2bf(v * rs[r]); } };
struct EpResid1 { const float* x; float* out; bf16_t* hb; __device__ void operator()(int r, int c, float v) const { const float h = x[(size_t)r * D + c] + v; out[(size_t)r * D + c] = h; hb[(size_t)r * D + c] = f2bf(h); } };
struct EpResid2 { float* out; __device__ void operator()(int r, int c, float v) const { out[(size_t)r * D + c] += v; } };

__global__ __launch_bounds__(256) void k_ssd_naive(const bf16_t* __restrict__ proj0, const float* __restrict__ conv_w, const float* __restrict__ conv_b,
                                                  const float* __restrict__ dt, const float* __restrict__ a_log, const float* __restrict__ d_skip, float* y) {
    constexpr int TB = 32;
    __shared__ float xs_s[TB][64];
    __shared__ float B_s[TB][128];
    __shared__ float C_s[TB][128];
    __shared__ float dt_s[TB];
    const int b = blockIdx.y, hd = blockIdx.x, g = hd >> 2, tid = threadIdx.x;
    const int p = tid >> 2, nq = tid & 3;
    const float a = -__expf(a_log[hd]), Dk = d_skip[hd];
    float h[32];
#pragma unroll
    for (int i = 0; i < 32; ++i) h[i] = 0.f;
    for (int t0 = 0; t0 < S; t0 += TB) {
        for (int idx = tid; idx < TB * 320; idx += 256) {
            const int tt = idx / 320, cc = idx % 320;
            const int ch = cc < 64 ? hd * 64 + cc : (cc < 192 ? 2048 + g * 128 + (cc - 64) : 3072 + g * 128 + (cc - 192));
            const int t = t0 + tt;
            float acc = conv_b[ch];
#pragma unroll
            for (int k = 0; k < 4; ++k) { const int ts = t - 3 + k; if (ts >= 0) acc += conv_w[k * XBC_W + ch] * bf2f(proj0[(size_t)(b * S + ts) * N1 + C_XBC + ch]); }
            const float v = siluf_(acc);
            if (cc < 64) xs_s[tt][cc] = v; else if (cc < 192) B_s[tt][cc - 64] = v; else C_s[tt][cc - 192] = v;
        }
        if (tid < TB) dt_s[tid] = dt[(size_t)(b * S + t0 + tid) * 32 + hd];
        __syncthreads();
        for (int tt = 0; tt < TB; ++tt) {
            const float dtv = dt_s[tt], dA = __expf(dtv * a), xv = xs_s[tt][p], xd = dtv * xv;
            float acc = 0.f;
#pragma unroll
            for (int i = 0; i < 32; ++i) { const int n = i * 4 + nq; h[i] = h[i] * dA + xd * B_s[tt][n]; acc += C_s[tt][n] * h[i]; }
            acc += __shfl_xor(acc, 1); acc += __shfl_xor(acc, 2);
            if (nq == 0) y[(size_t)(b * S + t0 + tt) * 2048 + hd * 64 + p] = acc + Dk * xv;
        }
        __syncthreads();
    }
}
__global__ __launch_bounds__(256) void k_ssd_gate(const float* __restrict__ y, const bf16_t* __restrict__ proj0, const float* __restrict__ nw, bf16_t* ycat) {
    const int r = blockIdx.x, t = threadIdx.x;
    float v[8]; float ss = 0.f;
#pragma unroll
    for (int i = 0; i < 8; ++i) { const int ch = t * 8 + i; const float z = bf2f(proj0[(size_t)r * N1 + C_ZA + ch]); v[i] = y[(size_t)r * 2048 + ch] * siluf_(z); ss += v[i] * v[i]; }
#pragma unroll
    for (int o = 1; o < 32; o <<= 1) ss += __shfl_xor(ss, o);
    const float rs = rsqrtf(ss / 256.f + EPS);
#pragma unroll
    for (int i = 0; i < 8; ++i) { const int ch = t * 8 + i; ycat[(size_t)r * MIXW + ch] = f2bf(v[i] * rs * nw[ch]); }
}
__global__ __launch_bounds__(256) void k_sgu_stats(const bf16_t* __restrict__ proj0, float* mu, float* rs) {
    __shared__ float red[4];
    const int r = blockIdx.x, t = threadIdx.x;
    float v[8]; float s = 0.f;
#pragma unroll
    for (int i = 0; i < 8; ++i) { v[i] = geluf_(bf2f(proj0[(size_t)r * N1 + C_V + t + 256 * i])); s += v[i]; }
    const float mean = block_sum256(s, red) / 2048.f;
    float q = 0.f;
#pragma unroll
    for (int i = 0; i < 8; ++i) { const float d = v[i] - mean; q += d * d; }
    const float var = block_sum256(q, red) / 2048.f;
    if (t == 0) { mu[r] = mean; rs[r] = rsqrtf(var + EPS); }
}
__global__ __launch_bounds__(256) void k_sgu_naive(const bf16_t* __restrict__ proj0, const float* __restrict__ mu, const float* __restrict__ rs,
                                                  const float* __restrict__ ln_w, const float* __restrict__ ln_b, const float* __restrict__ ws,
                                                  const float* __restrict__ sb, bf16_t* ycat) {
    __shared__ float vln[128][64];
    const int g = blockIdx.x >> 1, half = blockIdx.x & 1, bn = blockIdx.y, tid = threadIdx.x;
    const int row0 = bn * 128;
    for (int idx = tid; idx < 128 * 64; idx += 256) {
        const int s = idx >> 6, c = idx & 63, ch = g * 128 + half * 64 + c, r = row0 + s;
        const float gv = geluf_(bf2f(proj0[(size_t)r * N1 + C_V + ch]));
        vln[s][c] = (gv - mu[r]) * rs[r] * ln_w[ch] + ln_b[ch];
    }
    __syncthreads();
    const int c = tid & 63, tq = tid >> 6, ch = g * 128 + half * 64 + c;
    for (int t = tq; t < 128; t += 4) {
        const float* wr = ws + ((size_t)g * 128 + t) * 128;
        float acc = 0.f;
        for (int s = 0; s <= t; ++s) acc += wr[s] * vln[s][c];
        acc += sb[g * 128 + t];
        const int r = row0 + t;
        const float u = geluf_(bf2f(proj0[(size_t)r * N1 + C_U + ch])), zb = bf2f(proj0[(size_t)r * N1 + C_ZB + ch]);
        ycat[(size_t)r * MIXW + 2048 + ch] = f2bf(u * acc * siluf_(zb));
    }
}
__global__ __launch_bounds__(256) void k_rowrstd(const float* __restrict__ h, float* rstd) {
    __shared__ float red[4];
    const int r = blockIdx.x, t = threadIdx.x; float ss = 0.f;
#pragma unroll
    for (int i = 0; i < 8; ++i) { const float v = h[(size_t)r * D + t + 256 * i]; ss += v * v; }
    const float tot = block_sum256(ss, red);
    if (t == 0) rstd[r] = rsqrtf(tot / (float)D + EPS);
}
__global__ __launch_bounds__(128) void k_attn_naive(const bf16_t* __restrict__ qkvg, const float* __restrict__ lq1, const float* __restrict__ lk1,
                                                   const float* __restrict__ lq2, const float* __restrict__ lk2, const float* __restrict__ subw, bf16_t* ocat) {
    __shared__ float sc[2][2][S];
    const int w = threadIdx.x >> 6, lane = threadIdx.x & 63;
    const int q = blockIdx.x * 2 + w, hd = blockIdx.y, b = blockIdx.z;
    const size_t row = (size_t)b * S + q;
    float l1 = lq1[lane] * lk1[lane] + lq1[lane + 64] * lk1[lane + 64], l2 = lq2[lane] * lk2[lane] + lq2[lane + 64] * lk2[lane + 64];
    l1 = wave_sum(l1); l2 = wave_sum(l2);
    const float lam = __expf(l1) - __expf(l2) + LAMBDA_INIT;
    const float scale = 0.08838834764831845f;
    const unsigned qa = *(const unsigned*)(qkvg + row * ODD_IN + hd * 256 + 2 * lane);
    const unsigned qb = *(const unsigned*)(qkvg + row * ODD_IN + hd * 256 + 128 + 2 * lane);
    const float q1x = __uint_as_float(qa << 16), q1y = __uint_as_float(qa & 0xffff0000u), q2x = __uint_as_float(qb << 16), q2y = __uint_as_float(qb & 0xffff0000u);
    float m0 = -INFINITY, m1 = -INFINITY;
    for (int key = 0; key <= q; ++key) {
        const size_t kr = ((size_t)b * S + key) * ODD_IN + 4096 + hd * 256;
        const unsigned ka = *(const unsigned*)(qkvg + kr + 2 * lane), kb = *(const unsigned*)(qkvg + kr + 128 + 2 * lane);
        float s0 = q1x * __uint_as_float(ka << 16) + q1y * __uint_as_float(ka & 0xffff0000u);
        float s1 = q2x * __uint_as_float(kb << 16) + q2y * __uint_as_float(kb & 0xffff0000u);
        s0 = wave_sum(s0) * scale; s1 = wave_sum(s1) * scale;
        if (lane == 0) { sc[w][0][key] = s0; sc[w][1][key] = s1; }
        m0 = fmaxf(m0, s0); m1 = fmaxf(m1, s1);
    }
    __syncthreads();
    float e0 = 0.f, e1 = 0.f;
    for (int key = lane; key <= q; key += 64) { const float p0 = __expf(sc[w][0][key] - m0), p1 = __expf(sc[w][1][key] - m1); sc[w][0][key] = p0; sc[w][1][key] = p1; e0 += p0; e1 += p1; }
    e0 = wave_sum(e0); e1 = wave_sum(e1);
    __syncthreads();
    const float i0 = 1.f / e0, i1 = lam / e1;
    float o[4] = {0.f, 0.f, 0.f, 0.f};
    for (int key = 0; key <= q; ++key) {
        const float a = sc[w][0][key] * i0 - sc[w][1][key] * i1;
        const uint2 vv = *(const uint2*)(qkvg + ((size_t)b * S + key) * ODD_IN + 8192 + hd * 256 + 4 * lane);
        o[0] += a * __uint_as_float(vv.x << 16); o[1] += a * __uint_as_float(vv.x & 0xffff0000u);
        o[2] += a * __uint_as_float(vv.y << 16); o[3] += a * __uint_as_float(vv.y & 0xffff0000u);
    }
    float ss = o[0] * o[0] + o[1] * o[1] + o[2] * o[2] + o[3] * o[3];
    ss = wave_sum(ss);
    const float rs = rsqrtf(ss / 256.f + EPS) * (1.f - LAMBDA_INIT);
#pragma unroll
    for (int i = 0; i < 4; ++i) {
        const int dv = 4 * lane + i;
        const float gt = bf2f(qkvg[row * ODD_IN + 12288 + hd * 256 + dv]);
        ocat[row * MIXW + hd * 256 + dv] = f2bf(o[i] * rs * subw[dv] * siluf_(gt));
    }
}
__global__ __launch_bounds__(256) void k_final(float* out, const float* __restrict__ fw) {
    __shared__ float red[4];
    const int r = blockIdx.x, t = threadIdx.x; float v[8]; float ss = 0.f;
#pragma unroll
    for (int i = 0; i < 8; ++i) { v[i] = out[(size_t)r * D + t + 256 * i]; ss += v[i] * v[i]; }
    const float rs = rsqrtf(block_sum256(ss, red) / (float)D + EPS);
#pragma unroll
    for (int i = 0; i < 8; ++i) out[(size_t)r * D + t + 256 * i] = v[i] * rs * fw[t + 256 * i];
}

extern "C" void kernel_launch(void* const* d_in, const int* in_sizes, int n_in, void* d_out, int out_size, void* d_ws, size_t ws_size, hipStream_t stream) {
    if (n_in != 22 || ws_size < WS_END) { fprintf(stderr, "kernel_launch: unexpected n_in %d or ws_size %zu (< %zu)\n", n_in, ws_size, (size_t)WS_END); return; }
    const float* x = (const float*)d_in[0]; const float* norm_w = (const float*)d_in[1]; const float* w_in0 = (const float*)d_in[2];
    const float* conv_w = (const float*)d_in[3]; const float* conv_b = (const float*)d_in[4]; const float* dt_bias = (const float*)d_in[5];
    const float* a_log = (const float*)d_in[6]; const float* d_skip = (const float*)d_in[7]; const float* ssd_nw = (const float*)d_in[8];
    const float* ln_w = (const float*)d_in[9]; const float* ln_b = (const float*)d_in[10]; const float* sgu_ws = (const float*)d_in[11];
    const float* sgu_b = (const float*)d_in[12]; const float* w_out0 = (const float*)d_in[13]; const float* w_in1 = (const float*)d_in[14];
    const float* lq1 = (const float*)d_in[15]; const float* lk1 = (const float*)d_in[16]; const float* lq2 = (const float*)d_in[17]; const float* lk2 = (const float*)d_in[18];
    const float* subw = (const float*)d_in[19]; const float* w_out1 = (const float*)d_in[20]; const float* fw = (const float*)d_in[21];
    float* out = (float*)d_out; char* ws = (char*)d_ws;
    bf16_t* xb = (bf16_t*)(ws + WS_XB); bf16_t* proj0 = (bf16_t*)(ws + WS_PROJ0); float* ytmp = (float*)(ws + WS_STATES); bf16_t* ycat = (bf16_t*)(ws + WS_YCAT);
    float* dt = (float*)(ws + WS_DT); float* rstd0 = (float*)(ws + WS_RSTD0); float* rstd1 = (float*)(ws + WS_RSTD1); float* mu = (float*)(ws + WS_SGU_MU); float* rs = (float*)(ws + WS_SGU_RS);
    bf16_t* h1b = xb; bf16_t* qkvg = proj0; bf16_t* ocat = ycat;

    k_prep<<<M, 256, 0, stream>>>(x, norm_w, w_in0, dt_bias, xb, rstd0, dt);
    { GemmP g{xb, norm_w, w_in0, D, EVEN_IN, 6144, 32, D, 0}; EpScaleBf16 e{proj0, rstd0, N1, 0}; k_gemm_naive<<<dim3(N1 / 128, M / 128), 256, 0, stream>>>(g, e); }
    k_ssd_naive<<<dim3(32, NB), 256, 0, stream>>>(proj0, conv_w, conv_b, dt, a_log, d_skip, ytmp);
    k_ssd_gate<<<M, 256, 0, stream>>>(ytmp, proj0, ssd_nw, ycat);
    k_sgu_stats<<<M, 256, 0, stream>>>(proj0, mu, rs);
    k_sgu_naive<<<dim3(32, M / 128), 256, 0, stream>>>(proj0, mu, rs, ln_w, ln_b, sgu_ws, sgu_b, ycat);
    { GemmP g{ycat, nullptr, w_out0, MIXW, D, 1 << 30, 0, MIXW, 0}; EpResid1 e{x, out, h1b}; k_gemm_naive<<<dim3(D / 128, M / 128), 256, 0, stream>>>(g, e); }
    k_rowrstd<<<M, 256, 0, stream>>>(out, rstd1);
    { GemmP g{h1b, norm_w + D, w_in1, D, ODD_IN, 1 << 30, 0, D, 0}; EpScaleBf16 e{qkvg, rstd1, ODD_IN, 0}; k_gemm_naive<<<dim3(ODD_IN / 128, M / 128), 256, 0, stream>>>(g, e); }
    k_attn_naive<<<dim3(S / 2, 16, NB), 128, 0, stream>>>(qkvg, lq1, lk1, lq2, lk2, subw, ocat);
    { GemmP g{ocat, nullptr, w_out1, MIXW, D, 1 << 30, 0, MIXW, 0}; EpResid2 e{out}; k_gemm_naive<<<dim3(D / 128, M / 128), 256, 0, stream>>>(g, e); }
    k_final<<<M, 256, 0, stream>>>(out, fw);
}
```

```cpp
#include <hip/hip_runtime.h>
#include <cstdio>
#include <cstdint>

namespace pg8 {
#define PG8_LAS __attribute__((address_space(3)))
typedef unsigned short bf16_t;
typedef short bf16x8 __attribute__((ext_vector_type(8)));
typedef float f32x4 __attribute__((ext_vector_type(4)));
typedef unsigned u32x4 __attribute__((ext_vector_type(4)));
constexpr int BM = 256, BK = 64, HALF = 128, HTB = HALF * BK * 2  , STAGE_BYTES = 8 * HTB, NXCD = 8, WGM = 8;

__host__ __device__ __forceinline__ int lds_byte(int r, int c) { const int st = (r >> 4) * 2 + (c >> 5), rr = r & 15, cc = c & 31, ob = rr * 64 + cc * 2; return st * 1024 + (ob ^ (((ob >> 9) & 1) << 5)); }
__host__ __device__ __forceinline__ void stage_rc(int b, int& R, int& C) { const int st = b / 1024, sb = b % 1024, swz = sb ^ (((sb >> 9) & 1) << 5); R = (st >> 1) * 16 + swz / 64; C = (st & 1) * 32 + (swz % 64) / 2; }
__host__ __device__ __forceinline__ int perm32(int rho) { const int n = rho >> 4, i = rho & 15; return 8 * (i >> 2) + 4 * n + (i & 3); }

struct Unit { int pm, pn; };
struct Gemm { const bf16_t* A; const bf16_t* Bt; int M, N, K; };

struct StaticOrder {
    int nM, nN, nwg, G, c;
    __host__ __device__ void init(int M, int N, int G_, int c_) { nM = M / BM; nN = N / BM; nwg = nM * nN; G = G_; c = c_; }
    __host__ __device__ bool next(int i, Unit& u) const {
        const long L = (long)i * G + c; if (L >= nwg) return false;
        int wgid = (int)L; { const int q = nwg / NXCD, r = nwg % NXCD, xcd = wgid % NXCD, off = wgid / NXCD; wgid = (xcd < r ? xcd * (q + 1) : r * (q + 1) + (xcd - r) * q) + off; }
        const int nig = WGM * nN, gid = wgid / nig, fm = gid * WGM, gsz = (nM - fm) < WGM ? (nM - fm) : WGM;
        u.pm = fm + ((wgid % nig) % gsz); u.pn = (wgid % nig) / gsz; return true;
    }
    __device__ __forceinline__ void a_ready(const Unit&) const {}
    __device__ __forceinline__ void done(const Unit&) const {}
};

__device__ __forceinline__ unsigned cvt_pk_bf16(float lo, float hi) { unsigned r; asm volatile("v_cvt_pk_bf16_f32 %0, %1, %2" : "=v"(r) : "v"(lo), "v"(hi)); return r; }

constexpr float RMS_EPS = 1e-6f;
template <int NP> struct EpiRowScaleBf16 {
    static constexpr bool PERM = true, AFTER_DRAIN = false;
    bf16_t* O; int ldc; const float* rs;
    __device__ __forceinline__ void operator()(const f32x4 (&acc)[2][2][4][2], const Unit& u, int wr, int wc, int fr, int fq) const {
        const int row0 = u.pm * BM + wr * 64 + fr, col0 = u.pn * BM + wc * 32 + 8 * fq;
#pragma unroll
        for (int ai = 0; ai < 2; ++ai)
#pragma unroll
            for (int m = 0; m < 4; ++m) {
                const int row = row0 + ai * HALF + m * 16;
                float sc;
                if (NP == 1) sc = rs[row];
                else { const f32x4 a = *(const f32x4*)(rs + (size_t)row * 8), b = *(const f32x4*)(rs + (size_t)row * 8 + 4);
                       sc = rsqrtf((((a[0] + a[1]) + (a[2] + a[3])) + ((b[0] + b[1]) + (b[2] + b[3]))) * (1.0f / 2048.0f) + RMS_EPS); }
                bf16_t* rowp = O + (size_t)row * ldc + col0;
#pragma unroll
                for (int bj = 0; bj < 2; ++bj) { const f32x4 v0 = acc[ai][bj][m][0] * sc, v1 = acc[ai][bj][m][1] * sc;
                    u32x4 w; w.x = cvt_pk_bf16(v0[0], v0[1]); w.y = cvt_pk_bf16(v0[2], v0[3]); w.z = cvt_pk_bf16(v1[0], v1[1]); w.w = cvt_pk_bf16(v1[2], v1[3]);
                    *(u32x4*)(rowp + bj * HALF) = w; }
            }
    }
};
template <bool WBF> struct EpiResid {
    static constexpr bool PERM = false, AFTER_DRAIN = true;
    const float* base; float* out; bf16_t* hb; float* ssqp; int ldc;
    __device__ __forceinline__ void fused(f32x4 (&acc)[2][2][4][2], const Unit& u, int wr, int wc, int fr, int fq, PG8_LAS unsigned char* lds, int wid, int lane) const {
        typedef unsigned u32x2v __attribute__((ext_vector_type(2)));
        PG8_LAS float* P = (PG8_LAS float*)lds;
        const int col0 = u.pn * BM + wc * 32 + 4 * fq;
#pragma unroll
        for (int ai = 0; ai < 2; ++ai)
#pragma unroll
            for (int m = 0; m < 4; ++m) {
                const int r = ai * HALF + wr * 64 + m * 16 + fr; const size_t off = (size_t)(u.pm * BM + r) * ldc + col0; float ss = 0.f;
#pragma unroll
                for (int bj = 0; bj < 2; ++bj)
#pragma unroll
                    for (int n = 0; n < 2; ++n) {
                        const f32x4 bs = *(const f32x4*)(base + off + bj * HALF + n * 16); const f32x4 h = bs + acc[ai][bj][m][n];
                        *(f32x4*)(out + off + bj * HALF + n * 16) = h;
                        if (WBF) { u32x2v w; w.x = cvt_pk_bf16(h[0], h[1]); w.y = cvt_pk_bf16(h[2], h[3]); *(u32x2v*)(hb + off + bj * HALF + n * 16) = w; }
                        ss += (h[0] * h[0] + h[1] * h[1]) + (h[2] * h[2] + h[3] * h[3]); }
                ss += __shfl_xor(ss, 16); ss += __shfl_xor(ss, 32);
                if (fq == 0) P[r * 4 + wc] = ss;
                if (m & 1) asm volatile("" ::: "memory");
            }
        asm volatile("s_waitcnt lgkmcnt(0)" ::: "memory"); __builtin_amdgcn_s_barrier(); asm volatile("" ::: "memory");
        const int tid = wid * 64 + lane;
        if (tid < 256) { const f32x4 p = *(const PG8_LAS f32x4*)(P + tid * 4); ssqp[(size_t)(u.pm * BM + tid) * 8 + u.pn] = (p[0] + p[1]) + (p[2] + p[3]); }
    }
};
template <class Epi, class Sched, bool ALIGN_EPI = false, bool SP2 = false>
__device__ __forceinline__ void gemm_phase(PG8_LAS unsigned char* lds, const Gemm g, const Sched& S, const Epi& E) {
    const int tid = threadIdx.x, wid = __builtin_amdgcn_readfirstlane(tid >> 6), lane = tid & 63, wr = wid >> 2, wc = wid & 3, fr = lane & 15, fq = lane >> 4;
    const int K = g.K, nt = K / BK;
    unsigned voffA[2], voffB[2];
#pragma unroll
    for (int i = 0; i < 2; ++i) { int R, C; stage_rc(tid * 16 + i * 8192, R, C); const int Rb = Epi::PERM ? ((R & ~31) + perm32(R & 31)) : R;
        voffA[i] = (unsigned)(R * K + C) * 2u; voffB[i] = (unsigned)(Rb * K + C) * 2u; }
    const size_t kstep = (size_t)(BK * 2);
    const size_t hstep = (size_t)HALF * K * 2;
    const size_t tstep = 2 * hstep;
    const unsigned ldsw = (unsigned)wid * 1024u;
    const int aoff = lds_byte(wr * 64 + fr, fq * 8), boff = lds_byte(wc * 32 + fr, fq * 8);
#define PG8_SA(b, h) (((b) * 2 + (h)) * HTB)
#define PG8_SB(b, h) ((4 + (b) * 2 + (h)) * HTB)
#define PG8_STAGE(bufoff, gbase, voff) do { _Pragma("unroll") for (int _i = 0; _i < 2; ++_i) \
        __builtin_amdgcn_global_load_lds((const unsigned*)((const char*)(gbase) + (voff)[_i]), (PG8_LAS unsigned*)(lds + (bufoff) + ldsw + _i * 8192), 16, 0, 0); } while (0)
#define PG8_LDA(dst, b, h) do { _Pragma("unroll") for (int m = 0; m < 4; ++m) _Pragma("unroll") for (int k = 0; k < 2; ++k) dst[m][k] = *(const PG8_LAS bf16x8*)(lds + PG8_SA(b, h) + aoff + m * 2048 + k * 1024); } while (0)
#define PG8_LDB(dst, b, h) do { _Pragma("unroll") for (int n = 0; n < 2; ++n) _Pragma("unroll") for (int k = 0; k < 2; ++k) dst[n][k] = *(const PG8_LAS bf16x8*)(lds + PG8_SB(b, h) + boff + n * 2048 + k * 1024); } while (0)
#define PG8_MMA(ai, bj, At, Bt) do { __builtin_amdgcn_s_setprio(1); _Pragma("unroll") for (int m = 0; m < 4; ++m) _Pragma("unroll") for (int n = 0; n < 2; ++n) _Pragma("unroll") for (int k = 0; k < 2; ++k) \
        acc[ai][bj][m][n] = __builtin_amdgcn_mfma_f32_16x16x32_bf16(Bt[n][k], At[m][k], acc[ai][bj][m][n], 0, 0, 0); __builtin_amdgcn_s_setprio(0); } while (0)
#define PG8_WAIT_V(n) asm volatile("s_waitcnt vmcnt(" #n ")" ::: "memory")
#define PG8_WAIT_L(n) asm volatile("s_waitcnt lgkmcnt(" #n ")" ::: "memory")
#define PG8_BAR __builtin_amdgcn_s_barrier()
#define PG8_SCHED __builtin_amdgcn_sched_barrier(0)
    Unit cur, nxt; int ui = 0;
    if (!S.next(0, cur)) return;
    f32x4 acc[2][2][4][2];
#pragma unroll
    for (int a = 0; a < 2; ++a)
#pragma unroll
        for (int b = 0; b < 2; ++b)
#pragma unroll
            for (int m = 0; m < 4; ++m)
#pragma unroll
                for (int n = 0; n < 2; ++n) acc[a][b][m][n] = (f32x4){0.f, 0.f, 0.f, 0.f};
    bf16x8 At[4][2], B0[2][2], B1[2][2];
    const char* cA = (const char*)g.A + (size_t)cur.pm * tstep; const char* cB = (const char*)g.Bt + (size_t)cur.pn * tstep;
    S.a_ready(cur);
    if constexpr (SP2) {
        PG8_STAGE(PG8_SB(0, 0), cB, voffB); PG8_STAGE(PG8_SB(0, 1), cB + hstep, voffB); PG8_STAGE(PG8_SA(0, 0), cA, voffA); PG8_STAGE(PG8_SA(0, 1), cA + hstep, voffA);
        if (wr == 1) PG8_BAR;
        PG8_WAIT_V(2); PG8_BAR;
        PG8_STAGE(PG8_SB(1, 0), cB + kstep, voffB); PG8_STAGE(PG8_SA(1, 0), cA + kstep, voffA); PG8_STAGE(PG8_SB(1, 1), cB + hstep + kstep, voffB);
        PG8_WAIT_V(6); PG8_BAR;
    } else {
        PG8_STAGE(PG8_SB(0, 0), cB, voffB); PG8_STAGE(PG8_SA(0, 0), cA, voffA); PG8_STAGE(PG8_SB(0, 1), cB + hstep, voffB); PG8_STAGE(PG8_SA(0, 1), cA + hstep, voffA);
        if (wr == 1) PG8_BAR;
        PG8_WAIT_V(4); PG8_BAR;
        PG8_STAGE(PG8_SB(1, 0), cB + kstep, voffB); PG8_STAGE(PG8_SA(1, 0), cA + kstep, voffA); PG8_STAGE(PG8_SB(1, 1), cB + hstep + kstep, voffB);
        PG8_WAIT_V(6); PG8_BAR;
    }
    for (;;) {
        const bool has_next = S.next(ui + 1, nxt);
        const char* nA = has_next ? (const char*)g.A + (size_t)nxt.pm * tstep : cA; const char* nB = has_next ? (const char*)g.Bt + (size_t)nxt.pn * tstep : cB;
        for (int t = 0; t < nt; t += 2) {
            const bool last = (t == nt - 2);
            const char* a1 = cA + (size_t)(t + 1) * kstep;
            const char* a2 = last ? nA : cA + (size_t)(t + 2) * kstep; const char* b2 = last ? nB : cB + (size_t)(t + 2) * kstep;
            const char* a3 = a2 + kstep; const char* b3 = b2 + kstep;
            if (last && has_next) S.a_ready(nxt);
            if constexpr (SP2) {
            PG8_LDB(B0, 0, 0); PG8_LDB(B1, 0, 1); PG8_SCHED; PG8_LDA(At, 0, 0); PG8_STAGE(PG8_SA(1, 1), a1 + hstep, voffA);
            PG8_WAIT_V(8); PG8_WAIT_L(0); PG8_BAR; PG8_MMA(0, 0, At, B0); PG8_MMA(0, 1, At, B1); PG8_BAR; PG8_SCHED;
            PG8_LDA(At, 0, 1); PG8_STAGE(PG8_SB(0, 0), b2, voffB); PG8_STAGE(PG8_SB(0, 1), b2 + hstep, voffB); PG8_STAGE(PG8_SA(0, 0), a2, voffA);
            PG8_WAIT_V(8); PG8_WAIT_L(0); PG8_BAR; PG8_MMA(1, 0, At, B0); PG8_MMA(1, 1, At, B1); PG8_BAR; PG8_SCHED;
            PG8_LDB(B0, 1, 0); PG8_LDB(B1, 1, 1); PG8_SCHED; PG8_LDA(At, 1, 0); PG8_STAGE(PG8_SA(0, 1), a2 + hstep, voffA);
            PG8_WAIT_V(8); PG8_WAIT_L(0); PG8_BAR; PG8_MMA(0, 0, At, B0); PG8_MMA(0, 1, At, B1); PG8_BAR; PG8_SCHED;
            PG8_LDA(At, 1, 1); PG8_STAGE(PG8_SB(1, 0), b3, voffB); PG8_STAGE(PG8_SB(1, 1), b3 + hstep, voffB); PG8_STAGE(PG8_SA(1, 0), a3, voffA);
            PG8_WAIT_V(8); PG8_WAIT_L(0); PG8_BAR; PG8_MMA(1, 0, At, B0); PG8_MMA(1, 1, At, B1); PG8_BAR; PG8_SCHED;
            } else {
            PG8_LDB(B0, 0, 0); PG8_SCHED; PG8_LDA(At, 0, 0); PG8_STAGE(PG8_SA(1, 1), a1 + hstep, voffA);
            PG8_WAIT_L(8); PG8_BAR; PG8_WAIT_L(0); PG8_MMA(0, 0, At, B0); PG8_BAR; PG8_SCHED;
            PG8_LDB(B1, 0, 1); PG8_STAGE(PG8_SB(0, 0), b2, voffB);
            PG8_BAR; PG8_WAIT_L(0); PG8_MMA(0, 1, At, B1); PG8_BAR;
            PG8_LDA(At, 0, 1); PG8_STAGE(PG8_SA(0, 0), a2, voffA);
            PG8_BAR; PG8_WAIT_L(0); PG8_MMA(1, 0, At, B0); PG8_BAR; PG8_SCHED;
            PG8_STAGE(PG8_SB(0, 1), b2 + hstep, voffB);
            PG8_WAIT_V(6); PG8_BAR; PG8_MMA(1, 1, At, B1); PG8_BAR;
            PG8_LDB(B0, 1, 0); PG8_SCHED; PG8_LDA(At, 1, 0); PG8_STAGE(PG8_SA(0, 1), a2 + hstep, voffA);
            PG8_WAIT_L(8); PG8_BAR; PG8_WAIT_L(0); PG8_MMA(0, 0, At, B0); PG8_BAR; PG8_SCHED;
            PG8_LDB(B1, 1, 1); PG8_STAGE(PG8_SB(1, 0), b3, voffB);
            PG8_BAR; PG8_WAIT_L(0); PG8_MMA(0, 1, At, B1); PG8_BAR;
            PG8_LDA(At, 1, 1); PG8_STAGE(PG8_SA(1, 0), a3, voffA);
            PG8_BAR; PG8_WAIT_L(0); PG8_MMA(1, 0, At, B0); PG8_BAR; PG8_SCHED;
            PG8_STAGE(PG8_SB(1, 1), b3 + hstep, voffB);
            PG8_WAIT_V(6); PG8_BAR; PG8_MMA(1, 1, At, B1); PG8_BAR;
            }
        }
        if constexpr (ALIGN_EPI) { if (wr == 0) PG8_BAR; }
        if constexpr (!Epi::AFTER_DRAIN) { E(acc, cur, wr, wc, fr, fq); S.done(cur); }
        if (!has_next) break;
#pragma unroll
        for (int a = 0; a < 2; ++a)
#pragma unroll
            for (int b = 0; b < 2; ++b)
#pragma unroll
                for (int m = 0; m < 4; ++m)
#pragma unroll
                    for (int n = 0; n < 2; ++n) acc[a][b][m][n] = (f32x4){0.f, 0.f, 0.f, 0.f};
        cur = nxt; cA = nA; cB = nB; ++ui;
        if constexpr (ALIGN_EPI) { if (wr == 1) PG8_BAR; }
    }
    PG8_WAIT_V(0);
    if constexpr (!ALIGN_EPI) { if (wr == 0) PG8_BAR; }
    PG8_BAR;
    if constexpr (Epi::AFTER_DRAIN) { E.fused(acc, cur, wr, wc, fr, fq, lds, wid, lane); S.done(cur); }
#undef PG8_SA
#undef PG8_SB
#undef PG8_STAGE
#undef PG8_LDA
#undef PG8_LDB
#undef PG8_MMA
#undef PG8_WAIT_V
#undef PG8_WAIT_L
#undef PG8_BAR
#undef PG8_SCHED
}

}

constexpr int NB = 4, S = 2048, M = NB * S, D = 2048;
constexpr int EVEN_IN = 12320, N1 = 12288;
constexpr int C_ZA = 0, C_XBC = 2048, C_ZB = 6144, C_U = 8192, C_V = 10240;
constexpr int XBC_W = 4096;
constexpr int ODD_IN = 16384, MIXW = 4096;
constexpr float EPS = 1e-6f;
constexpr float LAMBDA_INIT = 0.35550906759096924f;

constexpr size_t MiB = 1u << 20;
constexpr size_t WS_CTL = 0, CTL_ZERO_BYTES = 1 * MiB;
constexpr size_t WS_WIN0 = 1 * MiB;
constexpr size_t WS_WOUT0 = 49 * MiB;
constexpr size_t WS_WIN1 = 65 * MiB;
constexpr size_t WS_WOUT1 = 129 * MiB;
constexpr size_t WS_XB = 145 * MiB;
constexpr size_t WS_PROJ0 = 177 * MiB;
constexpr size_t WS_STATES = 369 * MiB;
constexpr size_t WS_YCAT = 433 * MiB;
constexpr size_t WS_DT = 497 * MiB;
constexpr size_t WS_RSTD0 = 498 * MiB;
constexpr size_t WS_SGU_MU = WS_RSTD0 + 128 * 1024;
constexpr size_t WS_SGU_RS = WS_SGU_MU + 64 * 1024;
constexpr size_t WS_SSQ1 = WS_RSTD0 + 256 * 1024;
constexpr size_t WS_SSQ2 = WS_RSTD0 + 512 * 1024;
constexpr size_t WS_END = 499 * MiB;
constexpr int CW_BAR = 4096;

#define GAS __attribute__((address_space(1)))
#define LAS __attribute__((address_space(3)))
typedef unsigned short bf16;
typedef unsigned v4u __attribute__((ext_vector_type(4)));
typedef unsigned v2u __attribute__((ext_vector_type(2)));
typedef float f32x4 __attribute__((ext_vector_type(4)));
typedef float f32x16 __attribute__((ext_vector_type(16)));
typedef short bf16x8 __attribute__((ext_vector_type(8)));
#define LDS_WAIT() asm volatile("s_waitcnt lgkmcnt(0)" ::: "memory")
#define VM_WAIT() asm volatile("s_waitcnt vmcnt(0)" ::: "memory")
__device__ __forceinline__ unsigned pk2(float lo, float hi) { return pg8::cvt_pk_bf16(lo, hi); }
__device__ __forceinline__ float bf2f(bf16 v) { return __uint_as_float(((unsigned)v) << 16); }
__device__ __forceinline__ bf16 f2bf(float f) { unsigned u = __float_as_uint(f); return (bf16)((u + 0x7fffu + ((u >> 16) & 1u)) >> 16); }
__device__ __forceinline__ float sigmoidf_(float v) { return 1.f / (1.f + __expf(-v)); }
__device__ __forceinline__ float siluf_(float v) { return v * sigmoidf_(v); }
__device__ __forceinline__ float geluf_(float v) { const float c = 0.7978845608028654f; float t = tanhf(c * (v + 0.044715f * v * v * v)); return 0.5f * v * (1.f + t); }
__device__ __forceinline__ float softplusf_(float v) { return v > 20.f ? v : log1pf(__expf(v)); }
__device__ __forceinline__ float wave_sum(float v) {
#pragma unroll
    for (int o = 1; o < 64; o <<= 1) v += __shfl_xor(v, o);
    return v;
}

#define XB_TMO      128
#define XB_XCNT(j)  (256  + 64 * (j))
#define XB_XSUB(j)  (1280 + 64 * (j))
#define XB_XGEN(j)  (2304 + 64 * (j))
#define XB_TOP      3328
#define XB_TOPGEN   3392
#define XCD_BAR_WORDS 3456
#define XB_SPIN_CAP (1u << 25)

__device__ __forceinline__ unsigned xb_ld(unsigned* p)              { return __hip_atomic_load(p, __ATOMIC_RELAXED, __HIP_MEMORY_SCOPE_AGENT); }
__device__ __forceinline__ unsigned xb_add(unsigned* p, unsigned v) { return __hip_atomic_fetch_add(p, v, __ATOMIC_RELAXED, __HIP_MEMORY_SCOPE_AGENT); }
__device__ __forceinline__ unsigned xb_xcc_id() { return (unsigned)__builtin_amdgcn_s_getreg((3 << 11) | 20) & 0xFu; }
#define XB_SPIN(cond, bar) do { unsigned _sp = 0; while (cond) { __builtin_amdgcn_s_sleep(1); \
    if ((++_sp & 255u) == 0u) { if (xb_ld(&(bar)[XB_TMO])) break; if (_sp > XB_SPIN_CAP) { atomicAdd(&(bar)[XB_TMO], 1u); break; } } } } while (0)

struct XcdBarrier {
    unsigned* bar; unsigned x;
    volatile LAS unsigned* st;
};

__device__ __forceinline__ XcdBarrier xcd_barrier_post(unsigned* bar, volatile LAS unsigned* st) {
    XcdBarrier b; b.bar = bar; b.x = xb_xcc_id(); b.st = st;
    if (threadIdx.x == 0) (void)xb_add(&bar[XB_XCNT(b.x)], 1u);
    return b;
}
__device__ __forceinline__ void xcd_barrier_complete(unsigned* bar, unsigned x, unsigned& nloc, unsigned& nx) {
    const unsigned G = gridDim.x * gridDim.y * gridDim.z;
    unsigned sum, cnt, mine, sp = 0u;
    for (;;) {
        sum = 0u; cnt = 0u; mine = 0u;
#pragma unroll
        for (unsigned j = 0; j < 16; ++j) { const unsigned c = xb_ld(&bar[XB_XCNT(j)]); sum += c; cnt += (c > 0u) ? 1u : 0u; mine = (j == x) ? c : mine; }
        if (sum == G) break;
        __builtin_amdgcn_s_sleep(1);
        if ((++sp & 255u) == 0u) { if (xb_ld(&bar[XB_TMO])) break; if (sp > XB_SPIN_CAP) { atomicAdd(&bar[XB_TMO], 1u); break; } }
    }
    nloc = mine > 0u ? mine : 1u; nx = cnt > 0u ? cnt : 1u;
}

__device__ __forceinline__ void xcd_barrier(const XcdBarrier& b) {
    asm volatile("s_waitcnt vmcnt(0)" ::: "memory");
    __syncthreads();
    if (threadIdx.x == 0) {
        unsigned* bar = b.bar;
        __builtin_amdgcn_s_waitcnt(0);
        unsigned nloc = b.st[0], nx = b.st[1];
        if (nloc == 0u) { xcd_barrier_complete(bar, b.x, nloc, nx); b.st[0] = nloc; b.st[1] = nx; }
        const unsigned old = xb_add(&bar[XB_XSUB(b.x)], 1u);
        const unsigned gen = old / nloc;
        if (old + 1u == (gen + 1u) * nloc) {
            __builtin_amdgcn_fence(__ATOMIC_RELEASE, "agent");
            asm volatile("s_waitcnt vmcnt(0)" ::: "memory");
            const unsigned og = xb_add(&bar[XB_TOP], 1u);
            const unsigned tg = og / nx;
            if (og + 1u == (tg + 1u) * nx) xb_add(&bar[XB_TOPGEN], 1u);
            else XB_SPIN(xb_ld(&bar[XB_TOPGEN]) == tg, bar);
            __builtin_amdgcn_fence(__ATOMIC_ACQUIRE, "agent");
            xb_add(&bar[XB_XGEN(b.x)], 1u);
            asm volatile("s_waitcnt vmcnt(0)" ::: "memory");
        } else {
            XB_SPIN(xb_ld(&bar[XB_XGEN(b.x)]) == gen, bar);
            __builtin_amdgcn_fence(__ATOMIC_ACQUIRE, "agent");
            asm volatile("s_waitcnt vmcnt(0)" ::: "memory");
        }
    }
    __syncthreads();
}


constexpr int NWAVES = 8;
constexpr int LDS_BYTES = 163840;
constexpr int LDSCTL_OFF = LDS_BYTES - 256;
struct Frame {
    LAS unsigned char* lds;
    volatile LAS unsigned* MISC;
    unsigned* ctl;
    int tid, lane, wave, G;
    const float* in[22]; float* out;
    bf16 *Wt_in0, *Wt_out0, *Wt_in1, *Wt_out1, *xb, *proj0, *ycat, *h1b, *qkvg, *ocat;
    float *dt, *rstd0, *ssq1, *ssq2;
};
enum InIdx { I_X = 0, I_NORMW, I_WIN0, I_CONVW, I_CONVB, I_DTB, I_ALOG, I_DSKIP, I_SSDNW, I_LNW, I_LNB, I_SGUWS, I_SGUB, I_WOUT0, I_WIN1, I_LQ1, I_LK1, I_LQ2, I_LK2, I_SUBW, I_WOUT1, I_FW };

__device__ __forceinline__ void p0_transpose_item(const float* W, int ldw, int K, bf16* WT, int nblk, int shift_from, int shift, const float* ksc, LAS float* scr, int item, int lane) {
    const int kb = item / nblk, nb = item % nblk, k0 = 64 * kb, n0 = 32 * nb, ns = n0 + (n0 >= shift_from ? shift : 0);
#pragma unroll 8
    for (int i = 0; i < 32; ++i) { const int kk = 2 * i + (lane >> 5); float v = W[(size_t)(k0 + kk) * ldw + ns + (lane & 31)]; if (ksc) v *= ksc[k0 + kk]; scr[kk * 33 + (lane & 31)] = v; }
    LDS_WAIT(); asm volatile("" ::: "memory");
    const int c = lane & 7;
#pragma unroll
    for (int j = 0; j < 4; ++j) { const int n = (lane >> 3) + 8 * j; const LAS float* s = scr + (8 * c) * 33 + n;
        v4u o; o.x = pk2(s[0 * 33], s[1 * 33]); o.y = pk2(s[2 * 33], s[3 * 33]); o.z = pk2(s[4 * 33], s[5 * 33]); o.w = pk2(s[6 * 33], s[7 * 33]);
        *(GAS v4u*)(WT + (size_t)(n0 + n) * K + k0 + 8 * c) = o; }
    LDS_WAIT(); asm volatile("" ::: "memory");
}
__device__ __forceinline__ void p0_prologue(Frame& F) {
    {
        LAS float* scr = (LAS float*)(F.lds + F.wave * 16384);
        const int gw = (int)blockIdx.x * NWAVES + F.wave, NGW = F.G * NWAVES;
        constexpr int I_A = (D / 64) * (N1 / 32), I_B = (MIXW / 64) * (D / 32), I_C = (D / 64) * (ODD_IN / 32), I_D = I_B;
        constexpr int NITEMS = I_A + I_B + I_C + I_D;
        const float* nw = F.in[I_NORMW];
        for (int it = gw; it < NITEMS; it += NGW) {
            int r = it;
            if (r < I_A) { p0_transpose_item(F.in[I_WIN0], EVEN_IN, D, F.Wt_in0, N1 / 32, 6144, 32, nw, scr, r, F.lane); continue; } r -= I_A;
            if (r < I_B) { p0_transpose_item(F.in[I_WOUT0], D, MIXW, F.Wt_out0, D / 32, 1 << 30, 0, nullptr, scr, r, F.lane); continue; } r -= I_B;
            if (r < I_C) { p0_transpose_item(F.in[I_WIN1], ODD_IN, D, F.Wt_in1, ODD_IN / 32, 1 << 30, 0, nw + D, scr, r, F.lane); continue; } r -= I_C;
            p0_transpose_item(F.in[I_WOUT1], D, MIXW, F.Wt_out1, D / 32, 1 << 30, 0, nullptr, scr, r, F.lane);
        }
    }
    __syncthreads();
    constexpr int TROW = 4112;
    LAS unsigned char* tile = F.lds;
    LAS float* rst = (LAS float*)(F.lds + 32 * TROW);
    const float* x = F.in[I_X]; const float* nw0 = F.in[I_NORMW]; const float* wdt = F.in[I_WIN0] + 6144; const float* dtb = F.in[I_DTB];
    for (int blk = blockIdx.x; blk < M / 32; blk += F.G) {
        for (int i = 0; i < 4; ++i) {
            const int rl = F.wave * 4 + i, row = blk * 32 + rl;
            const GAS f32x4* xr = (const GAS f32x4*)(x + (size_t)row * D) + F.lane;
            f32x4 v[8]; float ss = 0.f;
#pragma unroll
            for (int j = 0; j < 8; ++j) { v[j] = xr[64 * j]; ss += (v[j][0] * v[j][0] + v[j][1] * v[j][1]) + (v[j][2] * v[j][2] + v[j][3] * v[j][3]); }
            ss = wave_sum(ss);
            const float rstd = rsqrtf(ss * (1.0f / D) + EPS);
            if (F.lane == 0) { F.rstd0[row] = rstd; rst[rl] = rstd; }
            GAS v2u* o8 = (GAS v2u*)(F.xb + (size_t)row * D) + F.lane;
#pragma unroll
            for (int j = 0; j < 8; ++j) { v2u w; w.x = pk2(v[j][0], v[j][1]); w.y = pk2(v[j][2], v[j][3]); o8[64 * j] = w; *(LAS v2u*)(tile + rl * TROW + (64 * j + F.lane) * 8) = w; }
        }
        LDS_WAIT(); __syncthreads();
        const int r32 = F.lane & 31, hi = F.lane >> 5;
        f32x16 acc = {};
        for (int ks = 0; ks < 16; ++ks) {
            const int k0 = 256 * F.wave + 16 * ks + 8 * hi;
            const bf16x8 a = *(const LAS bf16x8*)(tile + r32 * TROW + k0 * 2);
            float wv[8];
#pragma unroll
            for (int j = 0; j < 8; ++j) wv[j] = wdt[(size_t)(k0 + j) * EVEN_IN + r32] * nw0[k0 + j];
            v4u bw; bw.x = pk2(wv[0], wv[1]); bw.y = pk2(wv[2], wv[3]); bw.z = pk2(wv[4], wv[5]); bw.w = pk2(wv[6], wv[7]);
            acc = __builtin_amdgcn_mfma_f32_32x32x16_bf16(a, __builtin_bit_cast(bf16x8, bw), acc, 0, 0, 0);
        }
        LDS_WAIT(); __syncthreads();
        LAS float* red = (LAS float*)F.lds;
#pragma unroll
        for (int r = 0; r < 16; ++r) { const int row = (r & 3) + 8 * (r >> 2) + 4 * hi; red[(F.wave * 32 + row) * 33 + r32] = acc[r]; }
        LDS_WAIT(); __syncthreads();
        for (int idx = F.tid; idx < 1024; idx += NWAVES * 64) {
            const int row = idx >> 5, h = idx & 31; float s = 0.f;
#pragma unroll
            for (int w = 0; w < 8; ++w) s += red[(w * 32 + row) * 33 + h];
            F.dt[(size_t)(blk * 32 + row) * 32 + h] = softplusf_(s * rst[row] + dtb[h]);
        }
        LDS_WAIT(); __syncthreads();
    }
}
__device__ __forceinline__ void final_norm(Frame& F) {
    const int gw = (int)blockIdx.x * NWAVES + F.wave, NGW = F.G * NWAVES;
    const GAS f32x4* fw = (const GAS f32x4*)F.in[I_FW] + F.lane;
    for (int row = gw; row < M; row += NGW) {
        GAS f32x4* o = (GAS f32x4*)(F.out + (size_t)row * D) + F.lane;
        const f32x4 a = *(const f32x4*)(F.ssq2 + (size_t)row * 8), b = *(const f32x4*)(F.ssq2 + (size_t)row * 8 + 4);
        const float rs = rsqrtf((((a[0] + a[1]) + (a[2] + a[3])) + ((b[0] + b[1]) + (b[2] + b[3]))) * (1.0f / D) + EPS);
        f32x4 v[8];
#pragma unroll
        for (int j = 0; j < 8; ++j) v[j] = o[64 * j];
#pragma unroll
        for (int j = 0; j < 8; ++j) o[64 * j] = v[j] * rs * fw[64 * j];
    }
}


__device__ __forceinline__ float half_sum256(float v, LAS float* red, int t) {
    v = wave_sum(v);
    __syncthreads();
    if ((t & 63) == 0) red[t >> 6] = v;
    __syncthreads();
    return red[0] + red[1] + red[2] + red[3];
}
__device__ __forceinline__ void ph_ssd_naive(Frame& F, float* y) {
    constexpr int TB = 32;
    const int half = F.tid >> 8, tid = F.tid & 255;
    LAS float* xs_s = (LAS float*)(F.lds + half * 49152); LAS float* B_s = xs_s + TB * 64; LAS float* C_s = B_s + TB * 128; LAS float* dt_s = C_s + TB * 128;
    const bf16* proj0 = F.proj0; const float* conv_w = F.in[I_CONVW]; const float* conv_b = F.in[I_CONVB];
    for (int vb0 = (int)blockIdx.x * 2; vb0 < 128; vb0 += F.G * 2) {
        const int vb = vb0 + half, b = vb >> 5, hd = vb & 31, g = hd >> 2;
        const int p = tid >> 2, nq = tid & 3;
        const float a = -__expf(F.in[I_ALOG][hd]), Dk = F.in[I_DSKIP][hd];
        float h[32];
#pragma unroll
        for (int i = 0; i < 32; ++i) h[i] = 0.f;
        for (int t0 = 0; t0 < S; t0 += TB) {
            for (int idx = tid; idx < TB * 320; idx += 256) {
                const int tt = idx / 320, cc = idx % 320;
                const int ch = cc < 64 ? hd * 64 + cc : (cc < 192 ? 2048 + g * 128 + (cc - 64) : 3072 + g * 128 + (cc - 192));
                const int t = t0 + tt;
                float acc = conv_b[ch];
#pragma unroll
                for (int k = 0; k < 4; ++k) { const int ts = t - 3 + k; if (ts >= 0) acc += conv_w[k * XBC_W + ch] * bf2f(proj0[(size_t)(b * S + ts) * N1 + C_XBC + ch]); }
                const float v = siluf_(acc);
                if (cc < 64) xs_s[tt * 64 + cc] = v; else if (cc < 192) B_s[tt * 128 + cc - 64] = v; else C_s[tt * 128 + cc - 192] = v;
            }
            if (tid < TB) dt_s[tid] = F.dt[(size_t)(b * S + t0 + tid) * 32 + hd];
            __syncthreads();
            for (int tt = 0; tt < TB; ++tt) {
                const float dtv = dt_s[tt], dA = __expf(dtv * a), xv = xs_s[tt * 64 + p], xd = dtv * xv;
                float acc = 0.f;
#pragma unroll
                for (int i = 0; i < 32; ++i) { const int n = i * 4 + nq; h[i] = h[i] * dA + xd * B_s[tt * 128 + n]; acc += C_s[tt * 128 + n] * h[i]; }
                acc += __shfl_xor(acc, 1); acc += __shfl_xor(acc, 2);
                if (nq == 0) y[(size_t)(b * S + t0 + tt) * 2048 + hd * 64 + p] = acc + Dk * xv;
            }
            __syncthreads();
        }
    }
}
__device__ __forceinline__ void ph_sgu_stats_naive(Frame& F, float* mu, float* rs) {
    const int half = F.tid >> 8, t = F.tid & 255;
    LAS float* red = (LAS float*)(F.lds + 131072) + half * 4;
    for (int r0 = (int)blockIdx.x * 2; r0 < M; r0 += F.G * 2) {
        const int r = r0 + half;
        float v[8]; float s = 0.f;
#pragma unroll
        for (int i = 0; i < 8; ++i) { v[i] = geluf_(bf2f(F.proj0[(size_t)r * N1 + C_V + t + 256 * i])); s += v[i]; }
        const float mean = half_sum256(s, red, t) / 2048.f;
        float q = 0.f;
#pragma unroll
        for (int i = 0; i < 8; ++i) { const float d = v[i] - mean; q += d * d; }
        const float var = half_sum256(q, red, t) / 2048.f;
        if (t == 0) { mu[r] = mean; rs[r] = rsqrtf(var + EPS); }
    }
}
__device__ __forceinline__ void ph_ssd_gate_naive(Frame& F, const float* y) {
    const int half = F.tid >> 8, t = F.tid & 255; const float* nw = F.in[I_SSDNW];
    for (int r0 = (int)blockIdx.x * 2; r0 < M; r0 += F.G * 2) {
        const int r = r0 + half;
        float v[8]; float ss = 0.f;
#pragma unroll
        for (int i = 0; i < 8; ++i) { const int ch = t * 8 + i; const float z = bf2f(F.proj0[(size_t)r * N1 + C_ZA + ch]); v[i] = y[(size_t)r * 2048 + ch] * siluf_(z); ss += v[i] * v[i]; }
#pragma unroll
        for (int o = 1; o < 32; o <<= 1) ss += __shfl_xor(ss, o);
        const float rsv = rsqrtf(ss / 256.f + EPS);
#pragma unroll
        for (int i = 0; i < 8; ++i) { const int ch = t * 8 + i; F.ycat[(size_t)r * MIXW + ch] = f2bf(v[i] * rsv * nw[ch]); }
    }
}
__device__ __forceinline__ void ph_sgu_naive(Frame& F, const float* mu, const float* rs) {
    const int half = F.tid >> 8, tid = F.tid & 255;
    LAS float* vln = (LAS float*)(F.lds + half * 32768);
    const float* ln_w = F.in[I_LNW]; const float* ln_b = F.in[I_LNB]; const float* wsg = F.in[I_SGUWS]; const float* sb = F.in[I_SGUB];
    for (int vb0 = (int)blockIdx.x * 2; vb0 < 32 * 64; vb0 += F.G * 2) {
        const int vb = vb0 + half, bx = vb & 31, bn = vb >> 5, g = bx >> 1, hf = bx & 1, row0 = bn * 128;
        for (int idx = tid; idx < 128 * 64; idx += 256) {
            const int s = idx >> 6, c = idx & 63, ch = g * 128 + hf * 64 + c, r = row0 + s;
            const float gv = geluf_(bf2f(F.proj0[(size_t)r * N1 + C_V + ch]));
            vln[s * 64 + c] = (gv - mu[r]) * rs[r] * ln_w[ch] + ln_b[ch];
        }
        __syncthreads();
        const int c = tid & 63, tq = tid >> 6, ch = g * 128 + hf * 64 + c;
        for (int t = tq; t < 128; t += 4) {
            const float* wr = wsg + ((size_t)g * 128 + t) * 128;
            float acc = 0.f;
            for (int s = 0; s <= t; ++s) acc += wr[s] * vln[s * 64 + c];
            acc += sb[g * 128 + t];
            const int r = row0 + t;
            const float u = geluf_(bf2f(F.proj0[(size_t)r * N1 + C_U + ch])), zb = bf2f(F.proj0[(size_t)r * N1 + C_ZB + ch]);
            F.ycat[(size_t)r * MIXW + 2048 + ch] = f2bf(u * acc * siluf_(zb));
        }
        __syncthreads();
    }
}
__device__ __forceinline__ void ph_attn_naive(Frame& F) {
    const int w = F.wave, lane = F.lane;
    LAS float* sc0 = (LAS float*)(F.lds + w * 16384); LAS float* sc1 = sc0 + S;
    const bf16* qkvg = F.qkvg; const float* lq1 = F.in[I_LQ1]; const float* lk1 = F.in[I_LK1]; const float* lq2 = F.in[I_LQ2]; const float* lk2 = F.in[I_LK2]; const float* subw = F.in[I_SUBW];
    float l1 = lq1[lane] * lk1[lane] + lq1[lane + 64] * lk1[lane + 64], l2 = lq2[lane] * lk2[lane] + lq2[lane + 64] * lk2[lane + 64];
    l1 = wave_sum(l1); l2 = wave_sum(l2);
    const float lam = __expf(l1) - __expf(l2) + LAMBDA_INIT;
    const float scale = 0.08838834764831845f;
    for (int vb = (int)blockIdx.x; vb < (S / 8) * 16 * NB; vb += F.G) {
        const int qg = vb % (S / 8), hd = (vb / (S / 8)) & 15, b = vb / ((S / 8) * 16);
        const int q = qg * 8 + w;
        const size_t row = (size_t)b * S + q;
        const unsigned qa = *(const unsigned*)(qkvg + row * ODD_IN + hd * 256 + 2 * lane);
        const unsigned qb = *(const unsigned*)(qkvg + row * ODD_IN + hd * 256 + 128 + 2 * lane);
        const float q1x = __uint_as_float(qa << 16), q1y = __uint_as_float(qa & 0xffff0000u), q2x = __uint_as_float(qb << 16), q2y = __uint_as_float(qb & 0xffff0000u);
        float m0 = -INFINITY, m1 = -INFINITY;
        for (int key = 0; key <= q; ++key) {
            const size_t kr = ((size_t)b * S + key) * ODD_IN + 4096 + hd * 256;
            const unsigned ka = *(const unsigned*)(qkvg + kr + 2 * lane), kb = *(const unsigned*)(qkvg + kr + 128 + 2 * lane);
            float s0 = q1x * __uint_as_float(ka << 16) + q1y * __uint_as_float(ka & 0xffff0000u);
            float s1 = q2x * __uint_as_float(kb << 16) + q2y * __uint_as_float(kb & 0xffff0000u);
            s0 = wave_sum(s0) * scale; s1 = wave_sum(s1) * scale;
            if (lane == 0) { sc0[key] = s0; sc1[key] = s1; }
            m0 = fmaxf(m0, s0); m1 = fmaxf(m1, s1);
        }
        LDS_WAIT();
        float e0 = 0.f, e1 = 0.f;
        for (int key = lane; key <= q; key += 64) { const float p0 = __expf(sc0[key] - m0), p1 = __expf(sc1[key] - m1); sc0[key] = p0; sc1[key] = p1; e0 += p0; e1 += p1; }
        e0 = wave_sum(e0); e1 = wave_sum(e1);
        LDS_WAIT();
        const float i0 = 1.f / e0, i1 = lam / e1;
        float o[4] = {0.f, 0.f, 0.f, 0.f};
        for (int key = 0; key <= q; ++key) {
            const float a = sc0[key] * i0 - sc1[key] * i1;
            const uint2 vv = *(const uint2*)(qkvg + ((size_t)b * S + key) * ODD_IN + 8192 + hd * 256 + 4 * lane);
            o[0] += a * __uint_as_float(vv.x << 16); o[1] += a * __uint_as_float(vv.x & 0xffff0000u);
            o[2] += a * __uint_as_float(vv.y << 16); o[3] += a * __uint_as_float(vv.y & 0xffff0000u);
        }
        float ss = o[0] * o[0] + o[1] * o[1] + o[2] * o[2] + o[3] * o[3];
        ss = wave_sum(ss);
        const float rsv = rsqrtf(ss / 256.f + EPS) * (1.f - LAMBDA_INIT);
#pragma unroll
        for (int i = 0; i < 4; ++i) {
            const int dv = 4 * lane + i;
            const float gt = bf2f(qkvg[row * ODD_IN + 12288 + hd * 256 + dv]);
            F.ocat[row * MIXW + hd * 256 + dv] = f2bf(o[i] * rsv * subw[dv] * siluf_(gt));
        }
        LDS_WAIT();
    }
}

enum Phase { PH_PRO = 0, PH_G1, PH_SSD_A, PH_SSD_B, PH_SSD_C, PH_G2, PH_G3, PH_ATT, PH_G4, PH_FIN, PH_N };
struct Args { const float* in[22]; float* out; unsigned char* ws; int ph_lo, ph_hi, li, pad; };
__global__ void __launch_bounds__(NWAVES * 64, 2) mega(Args args) {
    extern __shared__ __attribute__((aligned(16))) unsigned char lds[];
    Frame F;
    F.lds = (LAS unsigned char*)lds;
    F.MISC = (volatile LAS unsigned*)(F.lds + LDSCTL_OFF);
    F.tid = threadIdx.x; F.lane = F.tid & 63; F.wave = __builtin_amdgcn_readfirstlane(F.tid >> 6); F.G = gridDim.x;
    unsigned char* ws = args.ws;
    F.ctl = (unsigned*)(ws + WS_CTL);
#pragma unroll
    for (int i = 0; i < 22; ++i) F.in[i] = args.in[i];
    F.out = args.out;
    F.Wt_in0 = (bf16*)(ws + WS_WIN0); F.Wt_out0 = (bf16*)(ws + WS_WOUT0); F.Wt_in1 = (bf16*)(ws + WS_WIN1); F.Wt_out1 = (bf16*)(ws + WS_WOUT1);
    F.xb = (bf16*)(ws + WS_XB); F.proj0 = (bf16*)(ws + WS_PROJ0); F.ycat = (bf16*)(ws + WS_YCAT); F.h1b = F.xb; F.qkvg = F.proj0; F.ocat = F.ycat;
    F.dt = (float*)(ws + WS_DT); F.rstd0 = (float*)(ws + WS_RSTD0); F.ssq1 = (float*)(ws + WS_SSQ1); F.ssq2 = (float*)(ws + WS_SSQ2);
    if (F.tid < 64) ((LAS unsigned*)(F.lds + LDSCTL_OFF))[F.tid] = 0u;
    __syncthreads();
    const int lo = args.ph_lo, hi = args.ph_hi;
    XcdBarrier bar; bar.bar = F.ctl + CW_BAR + args.li * XCD_BAR_WORDS; bar.x = 0; bar.st = nullptr;
    if (hi - lo > 1) bar = xcd_barrier_post(F.ctl + CW_BAR + args.li * XCD_BAR_WORDS, F.MISC + 8);
#define IN(k) (lo <= (k) && (k) < hi)
#define SEAM(k) do { if (IN(k) && IN((k) + 1)) xcd_barrier(bar); } while (0)

    if (IN(PH_PRO)) { p0_prologue(F); }
    SEAM(PH_PRO);
    if (IN(PH_G1)) {
        pg8::Gemm g{F.xb, F.Wt_in0, M, N1, D}; pg8::StaticOrder S; S.init(M, N1, F.G, (int)blockIdx.x);
        pg8::EpiRowScaleBf16<1> E{F.proj0, N1, F.rstd0};
        pg8::gemm_phase<pg8::EpiRowScaleBf16<1>, pg8::StaticOrder, true, true>(F.lds, g, S, E);
    }
    SEAM(PH_G1);
    float* ytmp = (float*)(ws + WS_STATES); float* sgu_mu = (float*)(ws + WS_SGU_MU); float* sgu_rs = (float*)(ws + WS_SGU_RS);
    if (IN(PH_SSD_A)) { ph_ssd_naive(F, ytmp); ph_sgu_stats_naive(F, sgu_mu, sgu_rs); }
    SEAM(PH_SSD_A);
    if (IN(PH_SSD_B)) { ph_ssd_gate_naive(F, ytmp); ph_sgu_naive(F, sgu_mu, sgu_rs); }
    SEAM(PH_SSD_B);
    SEAM(PH_SSD_C);
    if (IN(PH_G2)) {
        pg8::Gemm g{F.ycat, F.Wt_out0, M, D, MIXW}; pg8::StaticOrder S; S.init(M, D, F.G, (int)blockIdx.x);
        pg8::EpiResid<true> E{F.in[I_X], F.out, F.h1b, F.ssq1, D};
        pg8::gemm_phase<pg8::EpiResid<true>, pg8::StaticOrder, false, true>(F.lds, g, S, E);
    }
    SEAM(PH_G2);
    if (IN(PH_G3)) {
        pg8::Gemm g{F.h1b, F.Wt_in1, M, ODD_IN, D}; pg8::StaticOrder S; S.init(M, ODD_IN, F.G, (int)blockIdx.x);
        pg8::EpiRowScaleBf16<8> E{F.qkvg, ODD_IN, F.ssq1};
        pg8::gemm_phase<pg8::EpiRowScaleBf16<8>, pg8::StaticOrder, true, true>(F.lds, g, S, E);
    }
    SEAM(PH_G3);
    if (IN(PH_ATT)) { ph_attn_naive(F); }
    SEAM(PH_ATT);
    if (IN(PH_G4)) {
        pg8::Gemm g{F.ocat, F.Wt_out1, M, D, MIXW}; pg8::StaticOrder S; S.init(M, D, F.G, (int)blockIdx.x);
        pg8::EpiResid<false> E{F.out, F.out, nullptr, F.ssq2, D};
        pg8::gemm_phase<pg8::EpiResid<false>, pg8::StaticOrder, false, true>(F.lds, g, S, E);
    }
    SEAM(PH_G4);
    if (IN(PH_FIN)) { final_norm(F); }
#undef IN
#undef SEAM
}

__device__ __forceinline__ float block_sum256(float v, float* red) {
    v = wave_sum(v);
    __syncthreads();
    if ((threadIdx.x & 63) == 0) red[threadIdx.x >> 6] = v;
    __syncthreads();
    return red[0] + red[1] + red[2] + red[3];
}
__global__ __launch_bounds__(256) void k_ssd_naive(const bf16* __restrict__ proj0, const float* __restrict__ conv_w, const float* __restrict__ conv_b,
                                                  const float* __restrict__ dt, const float* __restrict__ a_log, const float* __restrict__ d_skip, float* y) {
    constexpr int TB = 32;
    __shared__ float xs_s[TB][64];
    __shared__ float B_s[TB][128];
    __shared__ float C_s[TB][128];
    __shared__ float dt_s[TB];
    const int b = blockIdx.y, hd = blockIdx.x, g = hd >> 2, tid = threadIdx.x;
    const int p = tid >> 2, nq = tid & 3;
    const float a = -__expf(a_log[hd]), Dk = d_skip[hd];
    float h[32];
#pragma unroll
    for (int i = 0; i < 32; ++i) h[i] = 0.f;
    for (int t0 = 0; t0 < S; t0 += TB) {
        for (int idx = tid; idx < TB * 320; idx += 256) {
            const int tt = idx / 320, cc = idx % 320;
            const int ch = cc < 64 ? hd * 64 + cc : (cc < 192 ? 2048 + g * 128 + (cc - 64) : 3072 + g * 128 + (cc - 192));
            const int t = t0 + tt;
            float acc = conv_b[ch];
#pragma unroll
            for (int k = 0; k < 4; ++k) { const int ts = t - 3 + k; if (ts >= 0) acc += conv_w[k * XBC_W + ch] * bf2f(proj0[(size_t)(b * S + ts) * N1 + C_XBC + ch]); }
            const float v = siluf_(acc);
            if (cc < 64) xs_s[tt][cc] = v; else if (cc < 192) B_s[tt][cc - 64] = v; else C_s[tt][cc - 192] = v;
        }
        if (tid < TB) dt_s[tid] = dt[(size_t)(b * S + t0 + tid) * 32 + hd];
        __syncthreads();
        for (int tt = 0; tt < TB; ++tt) {
            const float dtv = dt_s[tt], dA = __expf(dtv * a), xv = xs_s[tt][p], xd = dtv * xv;
            float acc = 0.f;
#pragma unroll
            for (int i = 0; i < 32; ++i) { const int n = i * 4 + nq; h[i] = h[i] * dA + xd * B_s[tt][n]; acc += C_s[tt][n] * h[i]; }
            acc += __shfl_xor(acc, 1); acc += __shfl_xor(acc, 2);
            if (nq == 0) y[(size_t)(b * S + t0 + tt) * 2048 + hd * 64 + p] = acc + Dk * xv;
        }
        __syncthreads();
    }
}
__global__ __launch_bounds__(256) void k_ssd_gate(const float* __restrict__ y, const bf16* __restrict__ proj0, const float* __restrict__ nw, bf16* ycat) {
    const int r = blockIdx.x, t = threadIdx.x;
    float v[8]; float ss = 0.f;
#pragma unroll
    for (int i = 0; i < 8; ++i) { const int ch = t * 8 + i; const float z = bf2f(proj0[(size_t)r * N1 + C_ZA + ch]); v[i] = y[(size_t)r * 2048 + ch] * siluf_(z); ss += v[i] * v[i]; }
#pragma unroll
    for (int o = 1; o < 32; o <<= 1) ss += __shfl_xor(ss, o);
    const float rs = rsqrtf(ss / 256.f + EPS);
#pragma unroll
    for (int i = 0; i < 8; ++i) { const int ch = t * 8 + i; ycat[(size_t)r * MIXW + ch] = f2bf(v[i] * rs * nw[ch]); }
}
__global__ __launch_bounds__(256) void k_sgu_stats(const bf16* __restrict__ proj0, float* mu, float* rs) {
    __shared__ float red[4];
    const int r = blockIdx.x, t = threadIdx.x;
    float v[8]; float s = 0.f;
#pragma unroll
    for (int i = 0; i < 8; ++i) { v[i] = geluf_(bf2f(proj0[(size_t)r * N1 + C_V + t + 256 * i])); s += v[i]; }
    const float mean = block_sum256(s, red) / 2048.f;
    float q = 0.f;
#pragma unroll
    for (int i = 0; i < 8; ++i) { const float d = v[i] - mean; q += d * d; }
    const float var = block_sum256(q, red) / 2048.f;
    if (t == 0) { mu[r] = mean; rs[r] = rsqrtf(var + EPS); }
}
__global__ __launch_bounds__(256) void k_sgu_naive(const bf16* __restrict__ proj0, const float* __restrict__ mu, const float* __restrict__ rs,
                                                  const float* __restrict__ ln_w, const float* __restrict__ ln_b, const float* __restrict__ ws,
                                                  const float* __restrict__ sb, bf16* ycat) {
    __shared__ float vln[128][64];
    const int g = blockIdx.x >> 1, half = blockIdx.x & 1, bn = blockIdx.y, tid = threadIdx.x;
    const int row0 = bn * 128;
    for (int idx = tid; idx < 128 * 64; idx += 256) {
        const int s = idx >> 6, c = idx & 63, ch = g * 128 + half * 64 + c, r = row0 + s;
        const float gv = geluf_(bf2f(proj0[(size_t)r * N1 + C_V + ch]));
        vln[s][c] = (gv - mu[r]) * rs[r] * ln_w[ch] + ln_b[ch];
    }
    __syncthreads();
    const int c = tid & 63, tq = tid >> 6, ch = g * 128 + half * 64 + c;
    for (int t = tq; t < 128; t += 4) {
        const float* wr = ws + ((size_t)g * 128 + t) * 128;
        float acc = 0.f;
        for (int s = 0; s <= t; ++s) acc += wr[s] * vln[s][c];
        acc += sb[g * 128 + t];
        const int r = row0 + t;
        const float u = geluf_(bf2f(proj0[(size_t)r * N1 + C_U + ch])), zb = bf2f(proj0[(size_t)r * N1 + C_ZB + ch]);
        ycat[(size_t)r * MIXW + 2048 + ch] = f2bf(u * acc * siluf_(zb));
    }
}
__global__ __launch_bounds__(128) void k_attn_naive(const bf16* __restrict__ qkvg, const float* __restrict__ lq1, const float* __restrict__ lk1,
                                                   const float* __restrict__ lq2, const float* __restrict__ lk2, const float* __restrict__ subw, bf16* ocat) {
    __shared__ float sc[2][2][S];
    const int w = threadIdx.x >> 6, lane = threadIdx.x & 63;
    const int q = blockIdx.x * 2 + w, hd = blockIdx.y, b = blockIdx.z;
    const size_t row = (size_t)b * S + q;
    float l1 = lq1[lane] * lk1[lane] + lq1[lane + 64] * lk1[lane + 64], l2 = lq2[lane] * lk2[lane] + lq2[lane + 64] * lk2[lane + 64];
    l1 = wave_sum(l1); l2 = wave_sum(l2);
    const float lam = __expf(l1) - __expf(l2) + LAMBDA_INIT;
    const float scale = 0.08838834764831845f;
    const unsigned qa = *(const unsigned*)(qkvg + row * ODD_IN + hd * 256 + 2 * lane);
    const unsigned qb = *(const unsigned*)(qkvg + row * ODD_IN + hd * 256 + 128 + 2 * lane);
    const float q1x = __uint_as_float(qa << 16), q1y = __uint_as_float(qa & 0xffff0000u), q2x = __uint_as_float(qb << 16), q2y = __uint_as_float(qb & 0xffff0000u);
    float m0 = -INFINITY, m1 = -INFINITY;
    for (int key = 0; key <= q; ++key) {
        const size_t kr = ((size_t)b * S + key) * ODD_IN + 4096 + hd * 256;
        const unsigned ka = *(const unsigned*)(qkvg + kr + 2 * lane), kb = *(const unsigned*)(qkvg + kr + 128 + 2 * lane);
        float s0 = q1x * __uint_as_float(ka << 16) + q1y * __uint_as_float(ka & 0xffff0000u);
        float s1 = q2x * __uint_as_float(kb << 16) + q2y * __uint_as_float(kb & 0xffff0000u);
        s0 = wave_sum(s0) * scale; s1 = wave_sum(s1) * scale;
        if (lane == 0) { sc[w][0][key] = s0; sc[w][1][key] = s1; }
        m0 = fmaxf(m0, s0); m1 = fmaxf(m1, s1);
    }
    __syncthreads();
    float e0 = 0.f, e1 = 0.f;
    for (int key = lane; key <= q; key += 64) { const float p0 = __expf(sc[w][0][key] - m0), p1 = __expf(sc[w][1][key] - m1); sc[w][0][key] = p0; sc[w][1][key] = p1; e0 += p0; e1 += p1; }
    e0 = wave_sum(e0); e1 = wave_sum(e1);
    __syncthreads();
    const float i0 = 1.f / e0, i1 = lam / e1;
    float o[4] = {0.f, 0.f, 0.f, 0.f};
    for (int key = 0; key <= q; ++key) {
        const float a = sc[w][0][key] * i0 - sc[w][1][key] * i1;
        const uint2 vv = *(const uint2*)(qkvg + ((size_t)b * S + key) * ODD_IN + 8192 + hd * 256 + 4 * lane);
        o[0] += a * __uint_as_float(vv.x << 16); o[1] += a * __uint_as_float(vv.x & 0xffff0000u);
        o[2] += a * __uint_as_float(vv.y << 16); o[3] += a * __uint_as_float(vv.y & 0xffff0000u);
    }
    float ss = o[0] * o[0] + o[1] * o[1] + o[2] * o[2] + o[3] * o[3];
    ss = wave_sum(ss);
    const float rs = rsqrtf(ss / 256.f + EPS) * (1.f - LAMBDA_INIT);
#pragma unroll
    for (int i = 0; i < 4; ++i) {
        const int dv = 4 * lane + i;
        const float gt = bf2f(qkvg[row * ODD_IN + 12288 + hd * 256 + dv]);
        ocat[row * MIXW + hd * 256 + dv] = f2bf(o[i] * rs * subw[dv] * siluf_(gt));
    }
}

extern "C" void kernel_launch(void* const* d_in, const int* in_sizes, int n_in, void* d_out, int out_size, void* d_ws, size_t ws_size, hipStream_t stream) {
    static int grid = 0;
    if (grid == 0) {
        if (n_in != 22 || ws_size < WS_END || out_size != M * D) { fprintf(stderr, "kernel_launch: unexpected n_in %d / out_size %d / ws_size %zu (< %zu)\n", n_in, out_size, ws_size, (size_t)WS_END); grid = -1; return; }
        int dev = 0, cus = 0, per_cu = 0;
        if (hipGetDevice(&dev) != hipSuccess || hipDeviceGetAttribute(&cus, hipDeviceAttributeMultiprocessorCount, dev) != hipSuccess) { fprintf(stderr, "kernel_launch: device query failed\n"); grid = -1; return; }
        if (hipFuncSetAttribute((const void*)mega, hipFuncAttributeMaxDynamicSharedMemorySize, LDS_BYTES) != hipSuccess) { fprintf(stderr, "kernel_launch: hipFuncSetAttribute failed\n"); grid = -1; return; }
        if (hipOccupancyMaxActiveBlocksPerMultiprocessor(&per_cu, (const void*)mega, NWAVES * 64, LDS_BYTES) != hipSuccess || per_cu < 1) { fprintf(stderr, "kernel_launch: occupancy query says %d blocks/CU\n", per_cu); (void)hipGetLastError(); grid = -1; return; }
        if (cus != 256) { fprintf(stderr, "kernel_launch: built for 256 CUs, device has %d\n", cus); grid = -1; return; }
        grid = cus;
    }
    if (grid < 0) return;
    const float* in[22]; for (int i = 0; i < 22; ++i) in[i] = (const float*)d_in[i];
    float* out = (float*)d_out; unsigned char* ws = (unsigned char*)d_ws;
    bf16* proj0 = (bf16*)(ws + WS_PROJ0); float* ytmp = (float*)(ws + WS_STATES); bf16* ycat = (bf16*)(ws + WS_YCAT);
    float* dt = (float*)(ws + WS_DT); float* mu = (float*)(ws + WS_SGU_MU); float* rs = (float*)(ws + WS_SGU_RS);
    bf16* qkvg = proj0; bf16* ocat = ycat;
    (void)hipMemsetAsync(ws + WS_CTL, 0, CTL_ZERO_BYTES, stream);
    Args a{};
    for (int i = 0; i < 22; ++i) a.in[i] = in[i];
    a.out = out; a.ws = ws;
    auto launch = [&](int lo, int hi, int li) { a.ph_lo = lo; a.ph_hi = hi; a.li = li; hipLaunchKernelGGL(mega, dim3(grid), dim3(NWAVES * 64), LDS_BYTES, stream, a); };
    launch(PH_PRO, PH_N, 0);
}
```

```cpp
#include <hip/hip_runtime.h>
#include <cstdio>
#include <cstdint>

namespace pg8 {
#define PG8_LAS __attribute__((address_space(3)))
typedef unsigned short bf16_t;
typedef short bf16x8 __attribute__((ext_vector_type(8)));
typedef float f32x4 __attribute__((ext_vector_type(4)));
typedef unsigned u32x4 __attribute__((ext_vector_type(4)));
constexpr int BM = 256, BK = 64, HALF = 128, HTB = HALF * BK * 2  , STAGE_BYTES = 8 * HTB, NXCD = 8, WGM = 8;

__host__ __device__ __forceinline__ int lds_byte(int r, int c) { const int st = (r >> 4) * 2 + (c >> 5), rr = r & 15, cc = c & 31, ob = rr * 64 + cc * 2; return st * 1024 + (ob ^ (((ob >> 9) & 1) << 5)); }
__host__ __device__ __forceinline__ void stage_rc(int b, int& R, int& C) { const int st = b / 1024, sb = b % 1024, swz = sb ^ (((sb >> 9) & 1) << 5); R = (st >> 1) * 16 + swz / 64; C = (st & 1) * 32 + (swz % 64) / 2; }
__host__ __device__ __forceinline__ int perm32(int rho) { const int n = rho >> 4, i = rho & 15; return 8 * (i >> 2) + 4 * n + (i & 3); }

struct Unit { int pm, pn; };
struct Gemm { const bf16_t* A; const bf16_t* Bt; int M, N, K; };

struct StaticOrder {
    int nM, nN, nwg, G, c;
    __host__ __device__ void init(int M, int N, int G_, int c_) { nM = M / BM; nN = N / BM; nwg = nM * nN; G = G_; c = c_; }
    __host__ __device__ bool next(int i, Unit& u) const {
        const long L = (long)i * G + c; if (L >= nwg) return false;
        int wgid = (int)L; { const int q = nwg / NXCD, r = nwg % NXCD, xcd = wgid % NXCD, off = wgid / NXCD; wgid = (xcd < r ? xcd * (q + 1) : r * (q + 1) + (xcd - r) * q) + off; }
        const int nig = WGM * nN, gid = wgid / nig, fm = gid * WGM, gsz = (nM - fm) < WGM ? (nM - fm) : WGM;
        u.pm = fm + ((wgid % nig) % gsz); u.pn = (wgid % nig) / gsz; return true;
    }
    __device__ __forceinline__ void a_ready(const Unit&) const {}
    __device__ __forceinline__ void done(const Unit&) const {}
};

__device__ __forceinline__ unsigned cvt_pk_bf16(float lo, float hi) { unsigned r; asm volatile("v_cvt_pk_bf16_f32 %0, %1, %2" : "=v"(r) : "v"(lo), "v"(hi)); return r; }

constexpr float RMS_EPS = 1e-6f;
template <int NP> struct EpiRowScaleBf16 {
    static constexpr bool PERM = true, AFTER_DRAIN = false;
    bf16_t* O; int ldc; const float* rs;
    __device__ __forceinline__ void operator()(const f32x4 (&acc)[2][2][4][2], const Unit& u, int wr, int wc, int fr, int fq) const {
        const int row0 = u.pm * BM + wr * 64 + fr, col0 = u.pn * BM + wc * 32 + 8 * fq;
#pragma unroll
        for (int ai = 0; ai < 2; ++ai)
#pragma unroll
            for (int m = 0; m < 4; ++m) {
                const int row = row0 + ai * HALF + m * 16;
                float sc;
                if (NP == 1) sc = rs[row];
                else { const f32x4 a = *(const f32x4*)(rs + (size_t)row * 8), b = *(const f32x4*)(rs + (size_t)row * 8 + 4);
                       sc = rsqrtf((((a[0] + a[1]) + (a[2] + a[3])) + ((b[0] + b[1]) + (b[2] + b[3]))) * (1.0f / 2048.0f) + RMS_EPS); }
                bf16_t* rowp = O + (size_t)row * ldc + col0;
#pragma unroll
                for (int bj = 0; bj < 2; ++bj) { const f32x4 v0 = acc[ai][bj][m][0] * sc, v1 = acc[ai][bj][m][1] * sc;
                    u32x4 w; w.x = cvt_pk_bf16(v0[0], v0[1]); w.y = cvt_pk_bf16(v0[2], v0[3]); w.z = cvt_pk_bf16(v1[0], v1[1]); w.w = cvt_pk_bf16(v1[2], v1[3]);
                    *(u32x4*)(rowp + bj * HALF) = w; }
            }
    }
};
template <bool WBF> struct EpiResid {
    static constexpr bool PERM = false, AFTER_DRAIN = true;
    const float* base; float* out; bf16_t* hb; float* ssqp; int ldc;
    __device__ __forceinline__ void fused(f32x4 (&acc)[2][2][4][2], const Unit& u, int wr, int wc, int fr, int fq, PG8_LAS unsigned char* lds, int wid, int lane) const {
        typedef unsigned u32x2v __attribute__((ext_vector_type(2)));
        PG8_LAS float* P = (PG8_LAS float*)lds;
        const int col0 = u.pn * BM + wc * 32 + 4 * fq;
#pragma unroll
        for (int ai = 0; ai < 2; ++ai)
#pragma unroll
            for (int m = 0; m < 4; ++m) {
                const int r = ai * HALF + wr * 64 + m * 16 + fr; const size_t off = (size_t)(u.pm * BM + r) * ldc + col0; float ss = 0.f;
#pragma unroll
                for (int bj = 0; bj < 2; ++bj)
#pragma unroll
                    for (int n = 0; n < 2; ++n) {
                        const f32x4 bs = *(const f32x4*)(base + off + bj * HALF + n * 16); const f32x4 h = bs + acc[ai][bj][m][n];
                        *(f32x4*)(out + off + bj * HALF + n * 16) = h;
                        if (WBF) { u32x2v w; w.x = cvt_pk_bf16(h[0], h[1]); w.y = cvt_pk_bf16(h[2], h[3]); *(u32x2v*)(hb + off + bj * HALF + n * 16) = w; }
                        ss += (h[0] * h[0] + h[1] * h[1]) + (h[2] * h[2] + h[3] * h[3]); }
                ss += __shfl_xor(ss, 16); ss += __shfl_xor(ss, 32);
                if (fq == 0) P[r * 4 + wc] = ss;
                if (m & 1) asm volatile("" ::: "memory");
            }
        asm volatile("s_waitcnt lgkmcnt(0)" ::: "memory"); __builtin_amdgcn_s_barrier(); asm volatile("" ::: "memory");
        const int tid = wid * 64 + lane;
        if (tid < 256) { const f32x4 p = *(const PG8_LAS f32x4*)(P + tid * 4); ssqp[(size_t)(u.pm * BM + tid) * 8 + u.pn] = (p[0] + p[1]) + (p[2] + p[3]); }
    }
};
template <class Epi, class Sched, bool ALIGN_EPI = false, bool SP2 = false>
__device__ __forceinline__ void gemm_phase(PG8_LAS unsigned char* lds, const Gemm g, const Sched& S, const Epi& E) {
    const int tid = threadIdx.x, wid = __builtin_amdgcn_readfirstlane(tid >> 6), lane = tid & 63, wr = wid >> 2, wc = wid & 3, fr = lane & 15, fq = lane >> 4;
    const int K = g.K, nt = K / BK;
    unsigned voffA[2], voffB[2];
#pragma unroll
    for (int i = 0; i < 2; ++i) { int R, C; stage_rc(tid * 16 + i * 8192, R, C); const int Rb = Epi::PERM ? ((R & ~31) + perm32(R & 31)) : R;
        voffA[i] = (unsigned)(R * K + C) * 2u; voffB[i] = (unsigned)(Rb * K + C) * 2u; }
    const size_t kstep = (size_t)(BK * 2);
    const size_t hstep = (size_t)HALF * K * 2;
    const size_t tstep = 2 * hstep;
    const unsigned ldsw = (unsigned)wid * 1024u;
    const int aoff = lds_byte(wr * 64 + fr, fq * 8), boff = lds_byte(wc * 32 + fr, fq * 8);
#define PG8_SA(b, h) (((b) * 2 + (h)) * HTB)
#define PG8_SB(b, h) ((4 + (b) * 2 + (h)) * HTB)
#define PG8_STAGE(bufoff, gbase, voff) do { _Pragma("unroll") for (int _i = 0; _i < 2; ++_i) \
        __builtin_amdgcn_global_load_lds((const unsigned*)((const char*)(gbase) + (voff)[_i]), (PG8_LAS unsigned*)(lds + (bufoff) + ldsw + _i * 8192), 16, 0, 0); } while (0)
#define PG8_LDA(dst, b, h) do { _Pragma("unroll") for (int m = 0; m < 4; ++m) _Pragma("unroll") for (int k = 0; k < 2; ++k) dst[m][k] = *(const PG8_LAS bf16x8*)(lds + PG8_SA(b, h) + aoff + m * 2048 + k * 1024); } while (0)
#define PG8_LDB(dst, b, h) do { _Pragma("unroll") for (int n = 0; n < 2; ++n) _Pragma("unroll") for (int k = 0; k < 2; ++k) dst[n][k] = *(const PG8_LAS bf16x8*)(lds + PG8_SB(b, h) + boff + n * 2048 + k * 1024); } while (0)
#define PG8_MMA(ai, bj, At, Bt) do { __builtin_amdgcn_s_setprio(1); _Pragma("unroll") for (int m = 0; m < 4; ++m) _Pragma("unroll") for (int n = 0; n < 2; ++n) _Pragma("unroll") for (int k = 0; k < 2; ++k) \
        acc[ai][bj][m][n] = __builtin_amdgcn_mfma_f32_16x16x32_bf16(Bt[n][k], At[m][k], acc[ai][bj][m][n], 0, 0, 0); __builtin_amdgcn_s_setprio(0); } while (0)
#define PG8_WAIT_V(n) asm volatile("s_waitcnt vmcnt(" #n ")" ::: "memory")
#define PG8_WAIT_L(n) asm volatile("s_waitcnt lgkmcnt(" #n ")" ::: "memory")
#define PG8_BAR __builtin_amdgcn_s_barrier()
#define PG8_SCHED __builtin_amdgcn_sched_barrier(0)
    Unit cur, nxt; int ui = 0;
    if (!S.next(0, cur)) return;
    f32x4 acc[2][2][4][2];
#pragma unroll
    for (int a = 0; a < 2; ++a)
#pragma unroll
        for (int b = 0; b < 2; ++b)
#pragma unroll
            for (int m = 0; m < 4; ++m)
#pragma unroll
                for (int n = 0; n < 2; ++n) acc[a][b][m][n] = (f32x4){0.f, 0.f, 0.f, 0.f};
    bf16x8 At[4][2], B0[2][2], B1[2][2];
    const char* cA = (const char*)g.A + (size_t)cur.pm * tstep; const char* cB = (const char*)g.Bt + (size_t)cur.pn * tstep;
    S.a_ready(cur);
    if constexpr (SP2) {
        PG8_STAGE(PG8_SB(0, 0), cB, voffB); PG8_STAGE(PG8_SB(0, 1), cB + hstep, voffB); PG8_STAGE(PG8_SA(0, 0), cA, voffA); PG8_STAGE(PG8_SA(0, 1), cA + hstep, voffA);
        if (wr == 1) PG8_BAR;
        PG8_WAIT_V(2); PG8_BAR;
        PG8_STAGE(PG8_SB(1, 0), cB + kstep, voffB); PG8_STAGE(PG8_SA(1, 0), cA + kstep, voffA); PG8_STAGE(PG8_SB(1, 1), cB + hstep + kstep, voffB);
        PG8_WAIT_V(6); PG8_BAR;
    } else {
        PG8_STAGE(PG8_SB(0, 0), cB, voffB); PG8_STAGE(PG8_SA(0, 0), cA, voffA); PG8_STAGE(PG8_SB(0, 1), cB + hstep, voffB); PG8_STAGE(PG8_SA(0, 1), cA + hstep, voffA);
        if (wr == 1) PG8_BAR;
        PG8_WAIT_V(4); PG8_BAR;
        PG8_STAGE(PG8_SB(1, 0), cB + kstep, voffB); PG8_STAGE(PG8_SA(1, 0), cA + kstep, voffA); PG8_STAGE(PG8_SB(1, 1), cB + hstep + kstep, voffB);
        PG8_WAIT_V(6); PG8_BAR;
    }
    for (;;) {
        const bool has_next = S.next(ui + 1, nxt);
        const char* nA = has_next ? (const char*)g.A + (size_t)nxt.pm * tstep : cA; const char* nB = has_next ? (const char*)g.Bt + (size_t)nxt.pn * tstep : cB;
        for (int t = 0; t < nt; t += 2) {
            const bool last = (t == nt - 2);
            const char* a1 = cA + (size_t)(t + 1) * kstep;
            const char* a2 = last ? nA : cA + (size_t)(t + 2) * kstep; const char* b2 = last ? nB : cB + (size_t)(t + 2) * kstep;
            const char* a3 = a2 + kstep; const char* b3 = b2 + kstep;
            if (last && has_next) S.a_ready(nxt);
            if constexpr (SP2) {
            PG8_LDB(B0, 0, 0); PG8_LDB(B1, 0, 1); PG8_SCHED; PG8_LDA(At, 0, 0); PG8_STAGE(PG8_SA(1, 1), a1 + hstep, voffA);
            PG8_WAIT_V(8); PG8_WAIT_L(0); PG8_BAR; PG8_MMA(0, 0, At, B0); PG8_MMA(0, 1, At, B1); PG8_BAR; PG8_SCHED;
            PG8_LDA(At, 0, 1); PG8_STAGE(PG8_SB(0, 0), b2, voffB); PG8_STAGE(PG8_SB(0, 1), b2 + hstep, voffB); PG8_STAGE(PG8_SA(0, 0), a2, voffA);
            PG8_WAIT_V(8); PG8_WAIT_L(0); PG8_BAR; PG8_MMA(1, 0, At, B0); PG8_MMA(1, 1, At, B1); PG8_BAR; PG8_SCHED;
            PG8_LDB(B0, 1, 0); PG8_LDB(B1, 1, 1); PG8_SCHED; PG8_LDA(At, 1, 0); PG8_STAGE(PG8_SA(0, 1), a2 + hstep, voffA);
            PG8_WAIT_V(8); PG8_WAIT_L(0); PG8_BAR; PG8_MMA(0, 0, At, B0); PG8_MMA(0, 1, At, B1); PG8_BAR; PG8_SCHED;
            PG8_LDA(At, 1, 1); PG8_STAGE(PG8_SB(1, 0), b3, voffB); PG8_STAGE(PG8_SB(1, 1), b3 + hstep, voffB); PG8_STAGE(PG8_SA(1, 0), a3, voffA);
            PG8_WAIT_V(8); PG8_WAIT_L(0); PG8_BAR; PG8_MMA(1, 0, At, B0); PG8_MMA(1, 1, At, B1); PG8_BAR; PG8_SCHED;
            } else {
            PG8_LDB(B0, 0, 0); PG8_SCHED; PG8_LDA(At, 0, 0); PG8_STAGE(PG8_SA(1, 1), a1 + hstep, voffA);
            PG8_WAIT_L(8); PG8_BAR; PG8_WAIT_L(0); PG8_MMA(0, 0, At, B0); PG8_BAR; PG8_SCHED;
            PG8_LDB(B1, 0, 1); PG8_STAGE(PG8_SB(0, 0), b2, voffB);
            PG8_BAR; PG8_WAIT_L(0); PG8_MMA(0, 1, At, B1); PG8_BAR;
            PG8_LDA(At, 0, 1); PG8_STAGE(PG8_SA(0, 0), a2, voffA);
            PG8_BAR; PG8_WAIT_L(0); PG8_MMA(1, 0, At, B0); PG8_BAR; PG8_SCHED;
            PG8_STAGE(PG8_SB(0, 1), b2 + hstep, voffB);
            PG8_WAIT_V(6); PG8_BAR; PG8_MMA(1, 1, At, B1); PG8_BAR;
            PG8_LDB(B0, 1, 0); PG8_SCHED; PG8_LDA(At, 1, 0); PG8_STAGE(PG8_SA(0, 1), a2 + hstep, voffA);
            PG8_WAIT_L(8); PG8_BAR; PG8_WAIT_L(0); PG8_MMA(0, 0, At, B0); PG8_BAR; PG8_SCHED;
            PG8_LDB(B1, 1, 1); PG8_STAGE(PG8_SB(1, 0), b3, voffB);
            PG8_BAR; PG8_WAIT_L(0); PG8_MMA(0, 1, At, B1); PG8_BAR;
            PG8_LDA(At, 1, 1); PG8_STAGE(PG8_SA(1, 0), a3, voffA);
            PG8_BAR; PG8_WAIT_L(0); PG8_MMA(1, 0, At, B0); PG8_BAR; PG8_SCHED;
            PG8_STAGE(PG8_SB(1, 1), b3 + hstep, voffB);
            PG8_WAIT_V(6); PG8_BAR; PG8_MMA(1, 1, At, B1); PG8_BAR;
            }
        }
        if constexpr (ALIGN_EPI) { if (wr == 0) PG8_BAR; }
        if constexpr (!Epi::AFTER_DRAIN) { E(acc, cur, wr, wc, fr, fq); S.done(cur); }
        if (!has_next) break;
#pragma unroll
        for (int a = 0; a < 2; ++a)
#pragma unroll
            for (int b = 0; b < 2; ++b)
#pragma unroll
                for (int m = 0; m < 4; ++m)
#pragma unroll
                    for (int n = 0; n < 2; ++n) acc[a][b][m][n] = (f32x4){0.f, 0.f, 0.f, 0.f};
        cur = nxt; cA = nA; cB = nB; ++ui;
        if constexpr (ALIGN_EPI) { if (wr == 1) PG8_BAR; }
    }
    PG8_WAIT_V(0);
    if constexpr (!ALIGN_EPI) { if (wr == 0) PG8_BAR; }
    PG8_BAR;
    if constexpr (Epi::AFTER_DRAIN) { E.fused(acc, cur, wr, wc, fr, fq, lds, wid, lane); S.done(cur); }
#undef PG8_SA
#undef PG8_SB
#undef PG8_STAGE
#undef PG8_LDA
#undef PG8_LDB
#undef PG8_MMA
#undef PG8_WAIT_V
#undef PG8_WAIT_L
#undef PG8_BAR
#undef PG8_SCHED
}

}

constexpr int NB = 4, S = 2048, M = NB * S, D = 2048;
constexpr int EVEN_IN = 12320, N1 = 12288;
constexpr int C_ZA = 0, C_XBC = 2048, C_ZB = 6144, C_U = 8192, C_V = 10240;
constexpr int XBC_W = 4096;
constexpr int ODD_IN = 16384, MIXW = 4096;
constexpr float EPS = 1e-6f;
constexpr float LAMBDA_INIT = 0.35550906759096924f;

constexpr size_t MiB = 1u << 20;
constexpr size_t WS_CTL = 0, CTL_ZERO_BYTES = 1 * MiB;
constexpr size_t WS_WIN0 = 1 * MiB;
constexpr size_t WS_WOUT0 = 49 * MiB;
constexpr size_t WS_WIN1 = 65 * MiB;
constexpr size_t WS_WOUT1 = 129 * MiB;
constexpr size_t WS_XB = 145 * MiB;
constexpr size_t WS_PROJ0 = 177 * MiB;
constexpr size_t WS_STATES = 369 * MiB;
constexpr size_t WS_YCAT = 433 * MiB;
constexpr size_t WS_DT = 497 * MiB;
constexpr size_t WS_RSTD0 = 498 * MiB;
constexpr size_t WS_SGU_MU = WS_RSTD0 + 128 * 1024;
constexpr size_t WS_SGU_RS = WS_SGU_MU + 64 * 1024;
constexpr size_t WS_SSQ1 = WS_RSTD0 + 256 * 1024;
constexpr size_t WS_SSQ2 = WS_RSTD0 + 512 * 1024;
constexpr size_t WS_END = 499 * MiB;
constexpr int CW_BAR = 4096;

#define GAS __attribute__((address_space(1)))
#define LAS __attribute__((address_space(3)))
typedef unsigned short bf16;
typedef unsigned v4u __attribute__((ext_vector_type(4)));
typedef unsigned v2u __attribute__((ext_vector_type(2)));
typedef float f32x4 __attribute__((ext_vector_type(4)));
typedef float f32x16 __attribute__((ext_vector_type(16)));
typedef short bf16x8 __attribute__((ext_vector_type(8)));
#define LDS_WAIT() asm volatile("s_waitcnt lgkmcnt(0)" ::: "memory")
#define VM_WAIT() asm volatile("s_waitcnt vmcnt(0)" ::: "memory")
__device__ __forceinline__ unsigned pk2(float lo, float hi) { return pg8::cvt_pk_bf16(lo, hi); }
__device__ __forceinline__ float bf2f(bf16 v) { return __uint_as_float(((unsigned)v) << 16); }
__device__ __forceinline__ bf16 f2bf(float f) { unsigned u = __float_as_uint(f); return (bf16)((u + 0x7fffu + ((u >> 16) & 1u)) >> 16); }
__device__ __forceinline__ float sigmoidf_(float v) { return 1.f / (1.f + __expf(-v)); }
__device__ __forceinline__ float siluf_(float v) { return v * sigmoidf_(v); }
__device__ __forceinline__ float geluf_(float v) { const float c = 0.7978845608028654f; float t = tanhf(c * (v + 0.044715f * v * v * v)); return 0.5f * v * (1.f + t); }
__device__ __forceinline__ float softplusf_(float v) { return v > 20.f ? v : log1pf(__expf(v)); }
__device__ __forceinline__ float wave_sum(float v) {
#pragma unroll
    for (int o = 1; o < 64; o <<= 1) v += __shfl_xor(v, o);
    return v;
}

#define XB_TMO      128
#define XB_XCNT(j)  (256  + 64 * (j))
#define XB_XSUB(j)  (1280 + 64 * (j))
#define XB_XGEN(j)  (2304 + 64 * (j))
#define XB_TOP      3328
#define XB_TOPGEN   3392
#define XCD_BAR_WORDS 3456
#define XB_SPIN_CAP (1u << 25)

__device__ __forceinline__ unsigned xb_ld(unsigned* p)              { return __hip_atomic_load(p, __ATOMIC_RELAXED, __HIP_MEMORY_SCOPE_AGENT); }
__device__ __forceinline__ unsigned xb_add(unsigned* p, unsigned v) { return __hip_atomic_fetch_add(p, v, __ATOMIC_RELAXED, __HIP_MEMORY_SCOPE_AGENT); }
__device__ __forceinline__ unsigned xb_xcc_id() { return (unsigned)__builtin_amdgcn_s_getreg((3 << 11) | 20) & 0xFu; }
#define XB_SPIN(cond, bar) do { unsigned _sp = 0; while (cond) { __builtin_amdgcn_s_sleep(1); \
    if ((++_sp & 255u) == 0u) { if (xb_ld(&(bar)[XB_TMO])) break; if (_sp > XB_SPIN_CAP) { atomicAdd(&(bar)[XB_TMO], 1u); break; } } } } while (0)

struct XcdBarrier {
    unsigned* bar; unsigned x;
    volatile LAS unsigned* st;
};

__device__ __forceinline__ XcdBarrier xcd_barrier_post(unsigned* bar, volatile LAS unsigned* st) {
    XcdBarrier b; b.bar = bar; b.x = xb_xcc_id(); b.st = st;
    if (threadIdx.x == 0) (void)xb_add(&bar[XB_XCNT(b.x)], 1u);
    return b;
}
__device__ __forceinline__ void xcd_barrier_complete(unsigned* bar, unsigned x, unsigned& nloc, unsigned& nx) {
    const unsigned G = gridDim.x * gridDim.y * gridDim.z;
    unsigned sum, cnt, mine, sp = 0u;
    for (;;) {
        sum = 0u; cnt = 0u; mine = 0u;
#pragma unroll
        for (unsigned j = 0; j < 16; ++j) { const unsigned c = xb_ld(&bar[XB_XCNT(j)]); sum += c; cnt += (c > 0u) ? 1u : 0u; mine = (j == x) ? c : mine; }
        if (sum == G) break;
        __builtin_amdgcn_s_sleep(1);
        if ((++sp & 255u) == 0u) { if (xb_ld(&bar[XB_TMO])) break; if (sp > XB_SPIN_CAP) { atomicAdd(&bar[XB_TMO], 1u); break; } }
    }
    nloc = mine > 0u ? mine : 1u; nx = cnt > 0u ? cnt : 1u;
}

__device__ __forceinline__ void xcd_barrier(const XcdBarrier& b) {
    asm volatile("s_waitcnt vmcnt(0)" ::: "memory");
    __syncthreads();
    if (threadIdx.x == 0) {
        unsigned* bar = b.bar;
        __builtin_amdgcn_s_waitcnt(0);
        unsigned nloc = b.st[0], nx = b.st[1];
        if (nloc == 0u) { xcd_barrier_complete(bar, b.x, nloc, nx); b.st[0] = nloc; b.st[1] = nx; }
        const unsigned old = xb_add(&bar[XB_XSUB(b.x)], 1u);
        const unsigned gen = old / nloc;
        if (old + 1u == (gen + 1u) * nloc) {
            __builtin_amdgcn_fence(__ATOMIC_RELEASE, "agent");
            asm volatile("s_waitcnt vmcnt(0)" ::: "memory");
            const unsigned og = xb_add(&bar[XB_TOP], 1u);
            const unsigned tg = og / nx;
            if (og + 1u == (tg + 1u) * nx) xb_add(&bar[XB_TOPGEN], 1u);
            else XB_SPIN(xb_ld(&bar[XB_TOPGEN]) == tg, bar);
            __builtin_amdgcn_fence(__ATOMIC_ACQUIRE, "agent");
            xb_add(&bar[XB_XGEN(b.x)], 1u);
            asm volatile("s_waitcnt vmcnt(0)" ::: "memory");
        } else {
            XB_SPIN(xb_ld(&bar[XB_XGEN(b.x)]) == gen, bar);
            __builtin_amdgcn_fence(__ATOMIC_ACQUIRE, "agent");
            asm volatile("s_waitcnt vmcnt(0)" ::: "memory");
        }
    }
    __syncthreads();
}


constexpr int NWAVES = 8;
constexpr int LDS_BYTES = 163840;
constexpr int LDSCTL_OFF = LDS_BYTES - 256;
struct Frame {
    LAS unsigned char* lds;
    volatile LAS unsigned* MISC;
    unsigned* ctl;
    int tid, lane, wave, G;
    const float* in[22]; float* out;
    bf16 *Wt_in0, *Wt_out0, *Wt_in1, *Wt_out1, *xb, *proj0, *ycat, *h1b, *qkvg, *ocat;
    float *dt, *rstd0, *ssq1, *ssq2;
};
enum InIdx { I_X = 0, I_NORMW, I_WIN0, I_CONVW, I_CONVB, I_DTB, I_ALOG, I_DSKIP, I_SSDNW, I_LNW, I_LNB, I_SGUWS, I_SGUB, I_WOUT0, I_WIN1, I_LQ1, I_LK1, I_LQ2, I_LK2, I_SUBW, I_WOUT1, I_FW };

__device__ __forceinline__ void p0_transpose_item(const float* W, int ldw, int K, bf16* WT, int nblk, int shift_from, int shift, const float* ksc, LAS float* scr, int item, int lane) {
    const int kb = item / nblk, nb = item % nblk, k0 = 64 * kb, n0 = 32 * nb, ns = n0 + (n0 >= shift_from ? shift : 0);
#pragma unroll 8
    for (int i = 0; i < 32; ++i) { const int kk = 2 * i + (lane >> 5); float v = W[(size_t)(k0 + kk) * ldw + ns + (lane & 31)]; if (ksc) v *= ksc[k0 + kk]; scr[kk * 33 + (lane & 31)] = v; }
    LDS_WAIT(); asm volatile("" ::: "memory");
    const int c = lane & 7;
#pragma unroll
    for (int j = 0; j < 4; ++j) { const int n = (lane >> 3) + 8 * j; const LAS float* s = scr + (8 * c) * 33 + n;
        v4u o; o.x = pk2(s[0 * 33], s[1 * 33]); o.y = pk2(s[2 * 33], s[3 * 33]); o.z = pk2(s[4 * 33], s[5 * 33]); o.w = pk2(s[6 * 33], s[7 * 33]);
        *(GAS v4u*)(WT + (size_t)(n0 + n) * K + k0 + 8 * c) = o; }
    LDS_WAIT(); asm volatile("" ::: "memory");
}
__device__ __forceinline__ void p0_prologue(Frame& F) {
    {
        LAS float* scr = (LAS float*)(F.lds + F.wave * 16384);
        const int gw = (int)blockIdx.x * NWAVES + F.wave, NGW = F.G * NWAVES;
        constexpr int I_A = (D / 64) * (N1 / 32), I_B = (MIXW / 64) * (D / 32), I_C = (D / 64) * (ODD_IN / 32), I_D = I_B;
        constexpr int NITEMS = I_A + I_B + I_C + I_D;
        const float* nw = F.in[I_NORMW];
        for (int it = gw; it < NITEMS; it += NGW) {
            int r = it;
            if (r < I_A) { p0_transpose_item(F.in[I_WIN0], EVEN_IN, D, F.Wt_in0, N1 / 32, 6144, 32, nw, scr, r, F.lane); continue; } r -= I_A;
            if (r < I_B) { p0_transpose_item(F.in[I_WOUT0], D, MIXW, F.Wt_out0, D / 32, 1 << 30, 0, nullptr, scr, r, F.lane); continue; } r -= I_B;
            if (r < I_C) { p0_transpose_item(F.in[I_WIN1], ODD_IN, D, F.Wt_in1, ODD_IN / 32, 1 << 30, 0, nw + D, scr, r, F.lane); continue; } r -= I_C;
            p0_transpose_item(F.in[I_WOUT1], D, MIXW, F.Wt_out1, D / 32, 1 << 30, 0, nullptr, scr, r, F.lane);
        }
    }
    __syncthreads();
    constexpr int TROW = 4112;
    LAS unsigned char* tile = F.lds;
    LAS float* rst = (LAS float*)(F.lds + 32 * TROW);
    const float* x = F.in[I_X]; const float* nw0 = F.in[I_NORMW]; const float* wdt = F.in[I_WIN0] + 6144; const float* dtb = F.in[I_DTB];
    for (int blk = blockIdx.x; blk < M / 32; blk += F.G) {
        for (int i = 0; i < 4; ++i) {
            const int rl = F.wave * 4 + i, row = blk * 32 + rl;
            const GAS f32x4* xr = (const GAS f32x4*)(x + (size_t)row * D) + F.lane;
            f32x4 v[8]; float ss = 0.f;
#pragma unroll
            for (int j = 0; j < 8; ++j) { v[j] = xr[64 * j]; ss += (v[j][0] * v[j][0] + v[j][1] * v[j][1]) + (v[j][2] * v[j][2] + v[j][3] * v[j][3]); }
            ss = wave_sum(ss);
            const float rstd = rsqrtf(ss * (1.0f / D) + EPS);
            if (F.lane == 0) { F.rstd0[row] = rstd; rst[rl] = rstd; }
            GAS v2u* o8 = (GAS v2u*)(F.xb + (size_t)row * D) + F.lane;
#pragma unroll
            for (int j = 0; j < 8; ++j) { v2u w; w.x = pk2(v[j][0], v[j][1]); w.y = pk2(v[j][2], v[j][3]); o8[64 * j] = w; *(LAS v2u*)(tile + rl * TROW + (64 * j + F.lane) * 8) = w; }
        }
        LDS_WAIT(); __syncthreads();
        const int r32 = F.lane & 31, hi = F.lane >> 5;
        f32x16 acc = {};
        for (int ks = 0; ks < 16; ++ks) {
            const int k0 = 256 * F.wave + 16 * ks + 8 * hi;
            const bf16x8 a = *(const LAS bf16x8*)(tile + r32 * TROW + k0 * 2);
            float wv[8];
#pragma unroll
            for (int j = 0; j < 8; ++j) wv[j] = wdt[(size_t)(k0 + j) * EVEN_IN + r32] * nw0[k0 + j];
            v4u bw; bw.x = pk2(wv[0], wv[1]); bw.y = pk2(wv[2], wv[3]); bw.z = pk2(wv[4], wv[5]); bw.w = pk2(wv[6], wv[7]);
            acc = __builtin_amdgcn_mfma_f32_32x32x16_bf16(a, __builtin_bit_cast(bf16x8, bw), acc, 0, 0, 0);
        }
        LDS_WAIT(); __syncthreads();
        LAS float* red = (LAS float*)F.lds;
#pragma unroll
        for (int r = 0; r < 16; ++r) { const int row = (r & 3) + 8 * (r >> 2) + 4 * hi; red[(F.wave * 32 + row) * 33 + r32] = acc[r]; }
        LDS_WAIT(); __syncthreads();
        for (int idx = F.tid; idx < 1024; idx += NWAVES * 64) {
            const int row = idx >> 5, h = idx & 31; float s = 0.f;
#pragma unroll
            for (int w = 0; w < 8; ++w) s += red[(w * 32 + row) * 33 + h];
            F.dt[(size_t)(blk * 32 + row) * 32 + h] = softplusf_(s * rst[row] + dtb[h]);
        }
        LDS_WAIT(); __syncthreads();
    }
}
__device__ __forceinline__ void final_norm(Frame& F) {
    const int gw = (int)blockIdx.x * NWAVES + F.wave, NGW = F.G * NWAVES;
    const GAS f32x4* fw = (const GAS f32x4*)F.in[I_FW] + F.lane;
    for (int row = gw; row < M; row += NGW) {
        GAS f32x4* o = (GAS f32x4*)(F.out + (size_t)row * D) + F.lane;
        const f32x4 a = *(const f32x4*)(F.ssq2 + (size_t)row * 8), b = *(const f32x4*)(F.ssq2 + (size_t)row * 8 + 4);
        const float rs = rsqrtf((((a[0] + a[1]) + (a[2] + a[3])) + ((b[0] + b[1]) + (b[2] + b[3]))) * (1.0f / D) + EPS);
        f32x4 v[8];
#pragma unroll
        for (int j = 0; j < 8; ++j) v[j] = o[64 * j];
#pragma unroll
        for (int j = 0; j < 8; ++j) o[64 * j] = v[j] * rs * fw[64 * j];
    }
}


__device__ __forceinline__ float half_sum256(float v, LAS float* red, int t) {
    v = wave_sum(v);
    __syncthreads();
    if ((t & 63) == 0) red[t >> 6] = v;
    __syncthreads();
    return red[0] + red[1] + red[2] + red[3];
}
__device__ __forceinline__ void ph_ssd_naive(Frame& F, float* y) {
    constexpr int TB = 32;
    const int half = F.tid >> 8, tid = F.tid & 255;
    LAS float* xs_s = (LAS float*)(F.lds + half * 49152); LAS float* B_s = xs_s + TB * 64; LAS float* C_s = B_s + TB * 128; LAS float* dt_s = C_s + TB * 128;
    const bf16* proj0 = F.proj0; const float* conv_w = F.in[I_CONVW]; const float* conv_b = F.in[I_CONVB];
    for (int vb0 = (int)blockIdx.x * 2; vb0 < 128; vb0 += F.G * 2) {
        const int vb = vb0 + half, b = vb >> 5, hd = vb & 31, g = hd >> 2;
        const int p = tid >> 2, nq = tid & 3;
        const float a = -__expf(F.in[I_ALOG][hd]), Dk = F.in[I_DSKIP][hd];
        float h[32];
#pragma unroll
        for (int i = 0; i < 32; ++i) h[i] = 0.f;
        for (int t0 = 0; t0 < S; t0 += TB) {
            for (int idx = tid; idx < TB * 320; idx += 256) {
                const int tt = idx / 320, cc = idx % 320;
                const int ch = cc < 64 ? hd * 64 + cc : (cc < 192 ? 2048 + g * 128 + (cc - 64) : 3072 + g * 128 + (cc - 192));
                const int t = t0 + tt;
                float acc = conv_b[ch];
#pragma unroll
                for (int k = 0; k < 4; ++k) { const int ts = t - 3 + k; if (ts >= 0) acc += conv_w[k * XBC_W + ch] * bf2f(proj0[(size_t)(b * S + ts) * N1 + C_XBC + ch]); }
                const float v = siluf_(acc);
                if (cc < 64) xs_s[tt * 64 + cc] = v; else if (cc < 192) B_s[tt * 128 + cc - 64] = v; else C_s[tt * 128 + cc - 192] = v;
            }
            if (tid < TB) dt_s[tid] = F.dt[(size_t)(b * S + t0 + tid) * 32 + hd];
            __syncthreads();
            for (int tt = 0; tt < TB; ++tt) {
                const float dtv = dt_s[tt], dA = __expf(dtv * a), xv = xs_s[tt * 64 + p], xd = dtv * xv;
                float acc = 0.f;
#pragma unroll
                for (int i = 0; i < 32; ++i) { const int n = i * 4 + nq; h[i] = h[i] * dA + xd * B_s[tt * 128 + n]; acc += C_s[tt * 128 + n] * h[i]; }
                acc += __shfl_xor(acc, 1); acc += __shfl_xor(acc, 2);
                if (nq == 0) y[(size_t)(b * S + t0 + tt) * 2048 + hd * 64 + p] = acc + Dk * xv;
            }
            __syncthreads();
        }
    }
}
__device__ __forceinline__ void ph_sgu_stats_naive(Frame& F, float* mu, float* rs) {
    const int half = F.tid >> 8, t = F.tid & 255;
    LAS float* red = (LAS float*)(F.lds + 131072) + half * 4;
    for (int r0 = (int)blockIdx.x * 2; r0 < M; r0 += F.G * 2) {
        const int r = r0 + half;
        float v[8]; float s = 0.f;
#pragma unroll
        for (int i = 0; i < 8; ++i) { v[i] = geluf_(bf2f(F.proj0[(size_t)r * N1 + C_V + t + 256 * i])); s += v[i]; }
        const float mean = half_sum256(s, red, t) / 2048.f;
        float q = 0.f;
#pragma unroll
        for (int i = 0; i < 8; ++i) { const float d = v[i] - mean; q += d * d; }
        const float var = half_sum256(q, red, t) / 2048.f;
        if (t == 0) { mu[r] = mean; rs[r] = rsqrtf(var + EPS); }
    }
}
__device__ __forceinline__ void ph_ssd_gate_naive(Frame& F, const float* y) {
    const int half = F.tid >> 8, t = F.tid & 255; const float* nw = F.in[I_SSDNW];
    for (int r0 = (int)blockIdx.x * 2; r0 < M; r0 += F.G * 2) {
        const int r = r0 + half;
        float v[8]; float ss = 0.f;
#pragma unroll
        for (int i = 0; i < 8; ++i) { const int ch = t * 8 + i; const float z = bf2f(F.proj0[(size_t)r * N1 + C_ZA + ch]); v[i] = y[(size_t)r * 2048 + ch] * siluf_(z); ss += v[i] * v[i]; }
#pragma unroll
        for (int o = 1; o < 32; o <<= 1) ss += __shfl_xor(ss, o);
        const float rsv = rsqrtf(ss / 256.f + EPS);
#pragma unroll
        for (int i = 0; i < 8; ++i) { const int ch = t * 8 + i; F.ycat[(size_t)r * MIXW + ch] = f2bf(v[i] * rsv * nw[ch]); }
    }
}
__device__ __forceinline__ void ph_sgu_naive(Frame& F, const float* mu, const float* rs) {
    const int half = F.tid >> 8, tid = F.tid & 255;
    LAS float* vln = (LAS float*)(F.lds + half * 32768);
    const float* ln_w = F.in[I_LNW]; const float* ln_b = F.in[I_LNB]; const float* wsg = F.in[I_SGUWS]; const float* sb = F.in[I_SGUB];
    for (int vb0 = (int)blockIdx.x * 2; vb0 < 32 * 64; vb0 += F.G * 2) {
        const int vb = vb0 + half, bx = vb & 31, bn = vb >> 5, g = bx >> 1, hf = bx & 1, row0 = bn * 128;
        for (int idx = tid; idx < 128 * 64; idx += 256) {
            const int s = idx >> 6, c = idx & 63, ch = g * 128 + hf * 64 + c, r = row0 + s;
            const float gv = geluf_(bf2f(F.proj0[(size_t)r * N1 + C_V + ch]));
            vln[s * 64 + c] = (gv - mu[r]) * rs[r] * ln_w[ch] + ln_b[ch];
        }
        __syncthreads();
        const int c = tid & 63, tq = tid >> 6, ch = g * 128 + hf * 64 + c;
        for (int t = tq; t < 128; t += 4) {
            const float* wr = wsg + ((size_t)g * 128 + t) * 128;
            float acc = 0.f;
            for (int s = 0; s <= t; ++s) acc += wr[s] * vln[s * 64 + c];
            acc += sb[g * 128 + t];
            const int r = row0 + t;
            const float u = geluf_(bf2f(F.proj0[(size_t)r * N1 + C_U + ch])), zb = bf2f(F.proj0[(size_t)r * N1 + C_ZB + ch]);
            F.ycat[(size_t)r * MIXW + 2048 + ch] = f2bf(u * acc * siluf_(zb));
        }
        __syncthreads();
    }
}
__device__ __forceinline__ void ph_attn_naive(Frame& F) {
    const int w = F.wave, lane = F.lane;
    LAS float* sc0 = (LAS float*)(F.lds + w * 16384); LAS float* sc1 = sc0 + S;
    const bf16* qkvg = F.qkvg; const float* lq1 = F.in[I_LQ1]; const float* lk1 = F.in[I_LK1]; const float* lq2 = F.in[I_LQ2]; const float* lk2 = F.in[I_LK2]; const float* subw = F.in[I_SUBW];
    float l1 = lq1[lane] * lk1[lane] + lq1[lane + 64] * lk1[lane + 64], l2 = lq2[lane] * lk2[lane] + lq2[lane + 64] * lk2[lane + 64];
    l1 = wave_sum(l1); l2 = wave_sum(l2);
    const float lam = __expf(l1) - __expf(l2) + LAMBDA_INIT;
    const float scale = 0.08838834764831845f;
    for (int vb = (int)blockIdx.x; vb < (S / 8) * 16 * NB; vb += F.G) {
        const int qg = vb % (S / 8), hd = (vb / (S / 8)) & 15, b = vb / ((S / 8) * 16);
        const int q = qg * 8 + w;
        const size_t row = (size_t)b * S + q;
        const unsigned qa = *(const unsigned*)(qkvg + row * ODD_IN + hd * 256 + 2 * lane);
        const unsigned qb = *(const unsigned*)(qkvg + row * ODD_IN + hd * 256 + 128 + 2 * lane);
        const float q1x = __uint_as_float(qa << 16), q1y = __uint_as_float(qa & 0xffff0000u), q2x = __uint_as_float(qb << 16), q2y = __uint_as_float(qb & 0xffff0000u);
        float m0 = -INFINITY, m1 = -INFINITY;
        for (int key = 0; key <= q; ++key) {
            const size_t kr = ((size_t)b * S + key) * ODD_IN + 4096 + hd * 256;
            const unsigned ka = *(const unsigned*)(qkvg + kr + 2 * lane), kb = *(const unsigned*)(qkvg + kr + 128 + 2 * lane);
            float s0 = q1x * __uint_as_float(ka << 16) + q1y * __uint_as_float(ka & 0xffff0000u);
            float s1 = q2x * __uint_as_float(kb << 16) + q2y * __uint_as_float(kb & 0xffff0000u);
            s0 = wave_sum(s0) * scale; s1 = wave_sum(s1) * scale;
            if (lane == 0) { sc0[key] = s0; sc1[key] = s1; }
            m0 = fmaxf(m0, s0); m1 = fmaxf(m1, s1);
        }
        LDS_WAIT();
        float e0 = 0.f, e1 = 0.f;
        for (int key = lane; key <= q; key += 64) { const float p0 = __expf(sc0[key] - m0), p1 = __expf(sc1[key] - m1); sc0[key] = p0; sc1[key] = p1; e0 += p0; e1 += p1; }
        e0 = wave_sum(e0); e1 = wave_sum(e1);
        LDS_WAIT();
        const float i0 = 1.f / e0, i1 = lam / e1;
        float o[4] = {0.f, 0.f, 0.f, 0.f};
        for (int key = 0; key <= q; ++key) {
            const float a = sc0[key] * i0 - sc1[key] * i1;
            const uint2 vv = *(const uint2*)(qkvg + ((size_t)b * S + key) * ODD_IN + 8192 + hd * 256 + 4 * lane);
            o[0] += a * __uint_as_float(vv.x << 16); o[1] += a * __uint_as_float(vv.x & 0xffff0000u);
            o[2] += a * __uint_as_float(vv.y << 16); o[3] += a * __uint_as_float(vv.y & 0xffff0000u);
        }
        float ss = o[0] * o[0] + o[1] * o[1] + o[2] * o[2] + o[3] * o[3];
        ss = wave_sum(ss);
        const float rsv = rsqrtf(ss / 256.f + EPS) * (1.f - LAMBDA_INIT);
#pragma unroll
        for (int i = 0; i < 4; ++i) {
            const int dv = 4 * lane + i;
            const float gt = bf2f(qkvg[row * ODD_IN + 12288 + hd * 256 + dv]);
            F.ocat[row * MIXW + hd * 256 + dv] = f2bf(o[i] * rsv * subw[dv] * siluf_(gt));
        }
        LDS_WAIT();
    }
}


namespace att {
constexpr int STAGE = 65536, KOFF = 16384, VOFF = 32768;
constexpr float CEXP = 0.08838834764831845f * 1.4426950408889634f;
typedef short v4i16_t __attribute__((ext_vector_type(4)));
__device__ __forceinline__ v4i16_t vtr(LAS unsigned char* p) { return __builtin_amdgcn_ds_read_tr16_b64_v4i16((LAS v4i16_t*)p); }
__device__ __forceinline__ float swap_max(float v) { auto rr = __builtin_amdgcn_permlane32_swap(__float_as_uint(v), __float_as_uint(v), false, false); return fmaxf(__uint_as_float(rr[0]), __uint_as_float(rr[1])); }
__device__ __forceinline__ float swap_sum(float v) { auto rr = __builtin_amdgcn_permlane32_swap(__float_as_uint(v), __float_as_uint(v), false, false); return __uint_as_float(rr[0]) + __uint_as_float(rr[1]); }
__device__ __forceinline__ int crow(int r, int hi) { return (r & 3) + 8 * (r >> 2) + 4 * hi; }
}
__device__ __forceinline__ void attn_phase(Frame& F) {
    using namespace att;
    const int w = F.wave, map = w >> 2, sb = w & 3;
    LAS unsigned char* lds = F.lds;
    const bf16* qkvg = F.qkvg;
    const int vcu = ((int)blockIdx.x & 7) * (F.G >> 3) + ((int)blockIdx.x >> 3);
    for (int vu = vcu; vu < 64 * 4; vu += F.G) {
        const int bh = vu >> 2, s4 = vu & 3, b = bh >> 4, h = bh & 15;
        for (int ui = 0; ui < 4; ++ui) {
            const int qb = ui == 0 ? 15 - s4 : (ui == 1 ? 11 - s4 : (ui == 2 ? 4 + s4 : s4));
            const int q0 = qb * 128, NT = (q0 + 128) / 64, rb = q0 / 32 + sb;
            int lane = F.lane; asm volatile("" : "+v"(lane));
            const int r32 = lane & 31, hi = lane >> 5;
            unsigned koff[2];
#pragma unroll
            for (int i = 0; i < 2; ++i) { const int key = 8 * w + 4 * i + (lane >> 4), p = lane & 15, c = p ^ (key & 15); koff[i] = (unsigned)(key * ODD_IN + c * 8); }
            const unsigned voff0 = (unsigned)((lane >> 2) * ODD_IN + 32 * w + 8 * (lane & 3));
            const int kq = 4 * hi + ((lane & 15) >> 2);
            const int kbase = map * KOFF + r32 * 256, kswz = r32 & 15;
            const int vbase = VOFF + kq * 64 + 32 * ((lane >> 4) & 1) + 8 * (lane & 3);
            const bf16* kg = qkvg + (size_t)b * S * ODD_IN + 4096 + h * 256;
            const bf16* vg = qkvg + (size_t)b * S * ODD_IN + 8192 + h * 256;
            bf16x8 qf[8];
            { const bf16* qp = qkvg + ((size_t)b * S + q0 + 32 * sb + r32) * ODD_IN + h * 256 + map * 128 + 8 * hi;
#pragma unroll
              for (int ks = 0; ks < 8; ++ks) qf[ks] = *(const bf16x8*)(qp + 16 * ks); }
            f32x16 O[8];
#pragma unroll
            for (int i = 0; i < 8; ++i) O[i] = (f32x16){};
            float m = -1e30f, l = 0.f;
#define ATT_ISSUE(t, st) do { const size_t _ro = (size_t)(t) * 64 * ODD_IN; \
                _Pragma("unroll") for (int _i = 0; _i < 2; ++_i) { \
                    __builtin_amdgcn_global_load_lds((const unsigned*)(kg + _ro + koff[_i]), (LAS unsigned*)(lds + (st) * STAGE + (2 * w + _i) * 1024), 16, 0, 0); \
                    __builtin_amdgcn_global_load_lds((const unsigned*)(kg + _ro + 128 + koff[_i]), (LAS unsigned*)(lds + (st) * STAGE + KOFF + (2 * w + _i) * 1024), 16, 0, 0); } \
                _Pragma("unroll") for (int _i = 0; _i < 4; ++_i) \
                    __builtin_amdgcn_global_load_lds((const unsigned*)(vg + _ro + voff0 + (size_t)_i * 16 * ODD_IN), (LAS unsigned*)(lds + (st) * STAGE + VOFF + (4 * w + _i) * 1024), 16, 0, 0); } while (0)
            ATT_ISSUE(0, 0);
            for (int t = 0; t < NT; ++t) {
                asm volatile("s_waitcnt vmcnt(0)" ::: "memory"); __syncthreads();
                if (t + 1 < NT) ATT_ISSUE(t + 1, (t + 1) & 1);
                LAS unsigned char* st = lds + (t & 1) * STAGE;
#pragma unroll
                for (int kh = 0; kh < 2; ++kh) {
                    const int hidx = 2 * t + kh;
                    if (hidx <= rb) {
                        f32x16 p = (f32x16){};
#pragma unroll
                        for (int ks = 0; ks < 8; ++ks) {
                            const bf16x8 kf = *(const LAS bf16x8*)(st + kbase + kh * 8192 + (((2 * ks + hi) ^ kswz) << 4));
                            p = __builtin_amdgcn_mfma_f32_32x32x16_bf16(kf, qf[ks], p, 0, 0, 0);
                        }
                        if (hidx == rb) {
#pragma unroll
                            for (int r = 0; r < 16; ++r) if (crow(r, hi) > r32) p[r] = -INFINITY;
                        }
                        float tm = p[0];
#pragma unroll
                        for (int r = 1; r < 16; ++r) tm = fmaxf(tm, p[r]);
                        tm = swap_max(tm);
                        const float mn = fmaxf(m, tm);
                        if (__any(mn > m)) {
                            const float al = __builtin_amdgcn_exp2f((m - mn) * CEXP);
                            l *= al;
#pragma unroll
                            for (int i = 0; i < 8; ++i) O[i] = O[i] * al;
                        }
                        m = mn;
                        const float mc = -mn * CEXP;
                        float ls = 0.f;
#pragma unroll
                        for (int r = 0; r < 16; ++r) { p[r] = __builtin_amdgcn_exp2f(__builtin_fmaf(p[r], CEXP, mc)); ls += p[r]; }
                        l += ls;
                        v4u pw0, pw1;
                        pw0.x = pk2(p[0], p[1]); pw0.y = pk2(p[2], p[3]); pw0.z = pk2(p[4], p[5]); pw0.w = pk2(p[6], p[7]);
                        pw1.x = pk2(p[8], p[9]); pw1.y = pk2(p[10], p[11]); pw1.z = pk2(p[12], p[13]); pw1.w = pk2(p[14], p[15]);
                        const bf16x8 pf0 = __builtin_bit_cast(bf16x8, pw0), pf1 = __builtin_bit_cast(bf16x8, pw1);
#pragma unroll
                        for (int s2 = 0; s2 < 2; ++s2) {
#pragma unroll
                            for (int blk = 0; blk < 8; ++blk) {
                                LAS unsigned char* vp = st + vbase + blk * 4096 + (32 * kh + 16 * s2) * 64;
                                const v4i16_t lo = vtr(vp), hi4 = vtr(vp + 8 * 64);
                                const bf16x8 vf = (bf16x8){lo[0], lo[1], lo[2], lo[3], hi4[0], hi4[1], hi4[2], hi4[3]};
                                O[blk] = __builtin_amdgcn_mfma_f32_32x32x16_bf16(vf, s2 == 0 ? pf0 : pf1, O[blk], 0, 0, 0);
                            }
                        }
                    }
                }
            }
#undef ATT_ISSUE
            const float ltot = swap_sum(l);
            float lam = 1.0f;
            if (map == 1) { const float* lq1 = F.in[I_LQ1]; const float* lk1 = F.in[I_LK1]; const float* lq2 = F.in[I_LQ2]; const float* lk2 = F.in[I_LK2];
                float l1 = lq1[lane] * lk1[lane] + lq1[lane + 64] * lk1[lane + 64], l2 = lq2[lane] * lk2[lane] + lq2[lane + 64] * lk2[lane + 64];
                l1 = wave_sum(l1); l2 = wave_sum(l2); lam = __expf(l1) - __expf(l2) + LAMBDA_INIT; }
            const float inv = lam / ltot;
            LDS_WAIT(); __syncthreads();
            LAS float* X = (LAS float*)(lds + sb * 32768);
            if (map == 1) {
#pragma unroll
                for (int blk = 0; blk < 8; ++blk)
#pragma unroll
                    for (int r = 0; r < 16; ++r) X[(32 * blk + crow(r, hi)) * 32 + r32] = O[blk][r] * inv;
            }
            LDS_WAIT(); __syncthreads();
            if (map == 0) {
                float ss = 0.f;
#pragma unroll
                for (int blk = 0; blk < 8; ++blk)
#pragma unroll
                    for (int r = 0; r < 16; ++r) { const float o = O[blk][r] * inv - X[(32 * blk + crow(r, hi)) * 32 + r32]; O[blk][r] = o; ss += o * o; }
                ss = swap_sum(ss);
                const float rsv = rsqrtf(ss * (1.0f / 256.0f) + EPS) * (1.0f - LAMBDA_INIT);
                LDS_WAIT();
                LAS unsigned char* T = lds + sb * 32768;
#pragma unroll
                for (int blk = 0; blk < 8; ++blk)
#pragma unroll
                    for (int g4 = 0; g4 < 4; ++g4) {
                        v2u pk; pk.x = pk2(O[blk][4 * g4] * rsv, O[blk][4 * g4 + 1] * rsv); pk.y = pk2(O[blk][4 * g4 + 2] * rsv, O[blk][4 * g4 + 3] * rsv);
                        *(LAS v2u*)(T + r32 * 528 + (32 * blk + 8 * g4 + 4 * hi) * 2) = pk;
                    }
                LDS_WAIT();
                const int ch = lane & 31;
                const float* subw = F.in[I_SUBW];
                const f32x4 sw0 = *(const f32x4*)(subw + ch * 8), sw1 = *(const f32x4*)(subw + ch * 8 + 4);
#pragma unroll 4
                for (int it = 0; it < 16; ++it) {
                    const int row = it * 2 + (lane >> 5);
                    const size_t grow = (size_t)b * S + q0 + 32 * sb + row;
                    const v4u ov = *(const LAS v4u*)(T + row * 528 + ch * 16);
                    const v4u gv = *(const v4u*)(qkvg + grow * ODD_IN + 12288 + h * 256 + ch * 8);
                    float o8[8], g8[8];
                    o8[0] = __uint_as_float(ov.x << 16); o8[1] = __uint_as_float(ov.x & 0xffff0000u); o8[2] = __uint_as_float(ov.y << 16); o8[3] = __uint_as_float(ov.y & 0xffff0000u);
                    o8[4] = __uint_as_float(ov.z << 16); o8[5] = __uint_as_float(ov.z & 0xffff0000u); o8[6] = __uint_as_float(ov.w << 16); o8[7] = __uint_as_float(ov.w & 0xffff0000u);
                    g8[0] = __uint_as_float(gv.x << 16); g8[1] = __uint_as_float(gv.x & 0xffff0000u); g8[2] = __uint_as_float(gv.y << 16); g8[3] = __uint_as_float(gv.y & 0xffff0000u);
                    g8[4] = __uint_as_float(gv.z << 16); g8[5] = __uint_as_float(gv.z & 0xffff0000u); g8[6] = __uint_as_float(gv.w << 16); g8[7] = __uint_as_float(gv.w & 0xffff0000u);
                    v4u res;
                    res.x = pk2(o8[0] * sw0[0] * siluf_(g8[0]), o8[1] * sw0[1] * siluf_(g8[1]));
                    res.y = pk2(o8[2] * sw0[2] * siluf_(g8[2]), o8[3] * sw0[3] * siluf_(g8[3]));
                    res.z = pk2(o8[4] * sw1[0] * siluf_(g8[4]), o8[5] * sw1[1] * siluf_(g8[5]));
                    res.w = pk2(o8[6] * sw1[2] * siluf_(g8[6]), o8[7] * sw1[3] * siluf_(g8[7]));
                    *(v4u*)(F.ocat + grow * MIXW + h * 256 + ch * 8) = res;
                }
            }
            LDS_WAIT(); __syncthreads();
        }
    }
}

enum Phase { PH_PRO = 0, PH_G1, PH_SSD_A, PH_SSD_B, PH_SSD_C, PH_G2, PH_G3, PH_ATT, PH_G4, PH_FIN, PH_N };
struct Args { const float* in[22]; float* out; unsigned char* ws; int ph_lo, ph_hi, li, pad; };
__global__ void __launch_bounds__(NWAVES * 64, 2) mega(Args args) {
    extern __shared__ __attribute__((aligned(16))) unsigned char lds[];
    Frame F;
    F.lds = (LAS unsigned char*)lds;
    F.MISC = (volatile LAS unsigned*)(F.lds + LDSCTL_OFF);
    F.tid = threadIdx.x; F.lane = F.tid & 63; F.wave = __builtin_amdgcn_readfirstlane(F.tid >> 6); F.G = gridDim.x;
    unsigned char* ws = args.ws;
    F.ctl = (unsigned*)(ws + WS_CTL);
#pragma unroll
    for (int i = 0; i < 22; ++i) F.in[i] = args.in[i];
    F.out = args.out;
    F.Wt_in0 = (bf16*)(ws + WS_WIN0); F.Wt_out0 = (bf16*)(ws + WS_WOUT0); F.Wt_in1 = (bf16*)(ws + WS_WIN1); F.Wt_out1 = (bf16*)(ws + WS_WOUT1);
    F.xb = (bf16*)(ws + WS_XB); F.proj0 = (bf16*)(ws + WS_PROJ0); F.ycat = (bf16*)(ws + WS_YCAT); F.h1b = F.xb; F.qkvg = F.proj0; F.ocat = F.ycat;
    F.dt = (float*)(ws + WS_DT); F.rstd0 = (float*)(ws + WS_RSTD0); F.ssq1 = (float*)(ws + WS_SSQ1); F.ssq2 = (float*)(ws + WS_SSQ2);
    if (F.tid < 64) ((LAS unsigned*)(F.lds + LDSCTL_OFF))[F.tid] = 0u;
    __syncthreads();
    const int lo = args.ph_lo, hi = args.ph_hi;
    XcdBarrier bar; bar.bar = F.ctl + CW_BAR + args.li * XCD_BAR_WORDS; bar.x = 0; bar.st = nullptr;
    if (hi - lo > 1) bar = xcd_barrier_post(F.ctl + CW_BAR + args.li * XCD_BAR_WORDS, F.MISC + 8);
#define IN(k) (lo <= (k) && (k) < hi)
#define SEAM(k) do { if (IN(k) && IN((k) + 1)) xcd_barrier(bar); } while (0)

    if (IN(PH_PRO)) { p0_prologue(F); }
    SEAM(PH_PRO);
    if (IN(PH_G1)) {
        pg8::Gemm g{F.xb, F.Wt_in0, M, N1, D}; pg8::StaticOrder S; S.init(M, N1, F.G, (int)blockIdx.x);
        pg8::EpiRowScaleBf16<1> E{F.proj0, N1, F.rstd0};
        pg8::gemm_phase<pg8::EpiRowScaleBf16<1>, pg8::StaticOrder, true, true>(F.lds, g, S, E);
    }
    SEAM(PH_G1);
    float* ytmp = (float*)(ws + WS_STATES); float* sgu_mu = (float*)(ws + WS_SGU_MU); float* sgu_rs = (float*)(ws + WS_SGU_RS);
    if (IN(PH_SSD_A)) { ph_ssd_naive(F, ytmp); ph_sgu_stats_naive(F, sgu_mu, sgu_rs); }
    SEAM(PH_SSD_A);
    if (IN(PH_SSD_B)) { ph_ssd_gate_naive(F, ytmp); ph_sgu_naive(F, sgu_mu, sgu_rs); }
    SEAM(PH_SSD_B);
    SEAM(PH_SSD_C);
    if (IN(PH_G2)) {
        pg8::Gemm g{F.ycat, F.Wt_out0, M, D, MIXW}; pg8::StaticOrder S; S.init(M, D, F.G, (int)blockIdx.x);
        pg8::EpiResid<true> E{F.in[I_X], F.out, F.h1b, F.ssq1, D};
        pg8::gemm_phase<pg8::EpiResid<true>, pg8::StaticOrder, false, true>(F.lds, g, S, E);
    }
    SEAM(PH_G2);
    if (IN(PH_G3)) {
        pg8::Gemm g{F.h1b, F.Wt_in1, M, ODD_IN, D}; pg8::StaticOrder S; S.init(M, ODD_IN, F.G, (int)blockIdx.x);
        pg8::EpiRowScaleBf16<8> E{F.qkvg, ODD_IN, F.ssq1};
        pg8::gemm_phase<pg8::EpiRowScaleBf16<8>, pg8::StaticOrder, true, true>(F.lds, g, S, E);
    }
    SEAM(PH_G3);
    if (IN(PH_ATT)) { attn_phase(F); }
    SEAM(PH_ATT);
    if (IN(PH_G4)) {
        pg8::Gemm g{F.ocat, F.Wt_out1, M, D, MIXW}; pg8::StaticOrder S; S.init(M, D, F.G, (int)blockIdx.x);
        pg8::EpiResid<false> E{F.out, F.out, nullptr, F.ssq2, D};
        pg8::gemm_phase<pg8::EpiResid<false>, pg8::StaticOrder, false, true>(F.lds, g, S, E);
    }
    SEAM(PH_G4);
    if (IN(PH_FIN)) { final_norm(F); }
#undef IN
#undef SEAM
}

__device__ __forceinline__ float block_sum256(float v, float* red) {
    v = wave_sum(v);
    __syncthreads();
    if ((threadIdx.x & 63) == 0) red[threadIdx.x >> 6] = v;
    __syncthreads();
    return red[0] + red[1] + red[2] + red[3];
}
__global__ __launch_bounds__(256) void k_ssd_naive(const bf16* __restrict__ proj0, const float* __restrict__ conv_w, const float* __restrict__ conv_b,
                                                  const float* __restrict__ dt, const float* __restrict__ a_log, const float* __restrict__ d_skip, float* y) {
    constexpr int TB = 32;
    __shared__ float xs_s[TB][64];
    __shared__ float B_s[TB][128];
    __shared__ float C_s[TB][128];
    __shared__ float dt_s[TB];
    const int b = blockIdx.y, hd = blockIdx.x, g = hd >> 2, tid = threadIdx.x;
    const int p = tid >> 2, nq = tid & 3;
    const float a = -__expf(a_log[hd]), Dk = d_skip[hd];
    float h[32];
#pragma unroll
    for (int i = 0; i < 32; ++i) h[i] = 0.f;
    for (int t0 = 0; t0 < S; t0 += TB) {
        for (int idx = tid; idx < TB * 320; idx += 256) {
            const int tt = idx / 320, cc = idx % 320;
            const int ch = cc < 64 ? hd * 64 + cc : (cc < 192 ? 2048 + g * 128 + (cc - 64) : 3072 + g * 128 + (cc - 192));
            const int t = t0 + tt;
            float acc = conv_b[ch];
#pragma unroll
            for (int k = 0; k < 4; ++k) { const int ts = t - 3 + k; if (ts >= 0) acc += conv_w[k * XBC_W + ch] * bf2f(proj0[(size_t)(b * S + ts) * N1 + C_XBC + ch]); }
            const float v = siluf_(acc);
            if (cc < 64) xs_s[tt][cc] = v; else if (cc < 192) B_s[tt][cc - 64] = v; else C_s[tt][cc - 192] = v;
        }
        if (tid < TB) dt_s[tid] = dt[(size_t)(b * S + t0 + tid) * 32 + hd];
        __syncthreads();
        for (int tt = 0; tt < TB; ++tt) {
            const float dtv = dt_s[tt], dA = __expf(dtv * a), xv = xs_s[tt][p], xd = dtv * xv;
            float acc = 0.f;
#pragma unroll
            for (int i = 0; i < 32; ++i) { const int n = i * 4 + nq; h[i] = h[i] * dA + xd * B_s[tt][n]; acc += C_s[tt][n] * h[i]; }
            acc += __shfl_xor(acc, 1); acc += __shfl_xor(acc, 2);
            if (nq == 0) y[(size_t)(b * S + t0 + tt) * 2048 + hd * 64 + p] = acc + Dk * xv;
        }
        __syncthreads();
    }
}
__global__ __launch_bounds__(256) void k_ssd_gate(const float* __restrict__ y, const bf16* __restrict__ proj0, const float* __restrict__ nw, bf16* ycat) {
    const int r = blockIdx.x, t = threadIdx.x;
    float v[8]; float ss = 0.f;
#pragma unroll
    for (int i = 0; i < 8; ++i) { const int ch = t * 8 + i; const float z = bf2f(proj0[(size_t)r * N1 + C_ZA + ch]); v[i] = y[(size_t)r * 2048 + ch] * siluf_(z); ss += v[i] * v[i]; }
#pragma unroll
    for (int o = 1; o < 32; o <<= 1) ss += __shfl_xor(ss, o);
    const float rs = rsqrtf(ss / 256.f + EPS);
#pragma unroll
    for (int i = 0; i < 8; ++i) { const int ch = t * 8 + i; ycat[(size_t)r * MIXW + ch] = f2bf(v[i] * rs * nw[ch]); }
}
__global__ __launch_bounds__(256) void k_sgu_stats(const bf16* __restrict__ proj0, float* mu, float* rs) {
    __shared__ float red[4];
    const int r = blockIdx.x, t = threadIdx.x;
    float v[8]; float s = 0.f;
#pragma unroll
    for (int i = 0; i < 8; ++i) { v[i] = geluf_(bf2f(proj0[(size_t)r * N1 + C_V + t + 256 * i])); s += v[i]; }
    const float mean = block_sum256(s, red) / 2048.f;
    float q = 0.f;
#pragma unroll
    for (int i = 0; i < 8; ++i) { const float d = v[i] - mean; q += d * d; }
    const float var = block_sum256(q, red) / 2048.f;
    if (t == 0) { mu[r] = mean; rs[r] = rsqrtf(var + EPS); }
}
__global__ __launch_bounds__(256) void k_sgu_naive(const bf16* __restrict__ proj0, const float* __restrict__ mu, const float* __restrict__ rs,
                                                  const float* __restrict__ ln_w, const float* __restrict__ ln_b, const float* __restrict__ ws,
                                                  const float* __restrict__ sb, bf16* ycat) {
    __shared__ float vln[128][64];
    const int g = blockIdx.x >> 1, half = blockIdx.x & 1, bn = blockIdx.y, tid = threadIdx.x;
    const int row0 = bn * 128;
    for (int idx = tid; idx < 128 * 64; idx += 256) {
        const int s = idx >> 6, c = idx & 63, ch = g * 128 + half * 64 + c, r = row0 + s;
        const float gv = geluf_(bf2f(proj0[(size_t)r * N1 + C_V + ch]));
        vln[s][c] = (gv - mu[r]) * rs[r] * ln_w[ch] + ln_b[ch];
    }
    __syncthreads();
    const int c = tid & 63, tq = tid >> 6, ch = g * 128 + half * 64 + c;
    for (int t = tq; t < 128; t += 4) {
        const float* wr = ws + ((size_t)g * 128 + t) * 128;
        float acc = 0.f;
        for (int s = 0; s <= t; ++s) acc += wr[s] * vln[s][c];
        acc += sb[g * 128 + t];
        const int r = row0 + t;
        const float u = geluf_(bf2f(proj0[(size_t)r * N1 + C_U + ch])), zb = bf2f(proj0[(size_t)r * N1 + C_ZB + ch]);
        ycat[(size_t)r * MIXW + 2048 + ch] = f2bf(u * acc * siluf_(zb));
    }
}
__global__ __launch_bounds__(128) void k_attn_naive(const bf16* __restrict__ qkvg, const float* __restrict__ lq1, const float* __restrict__ lk1,
                                                   const float* __restrict__ lq2, const float* __restrict__ lk2, const float* __restrict__ subw, bf16* ocat) {
    __shared__ float sc[2][2][S];
    const int w = threadIdx.x >> 6, lane = threadIdx.x & 63;
    const int q = blockIdx.x * 2 + w, hd = blockIdx.y, b = blockIdx.z;
    const size_t row = (size_t)b * S + q;
    float l1 = lq1[lane] * lk1[lane] + lq1[lane + 64] * lk1[lane + 64], l2 = lq2[lane] * lk2[lane] + lq2[lane + 64] * lk2[lane + 64];
    l1 = wave_sum(l1); l2 = wave_sum(l2);
    const float lam = __expf(l1) - __expf(l2) + LAMBDA_INIT;
    const float scale = 0.08838834764831845f;
    const unsigned qa = *(const unsigned*)(qkvg + row * ODD_IN + hd * 256 + 2 * lane);
    const unsigned qb = *(const unsigned*)(qkvg + row * ODD_IN + hd * 256 + 128 + 2 * lane);
    const float q1x = __uint_as_float(qa << 16), q1y = __uint_as_float(qa & 0xffff0000u), q2x = __uint_as_float(qb << 16), q2y = __uint_as_float(qb & 0xffff0000u);
    float m0 = -INFINITY, m1 = -INFINITY;
    for (int key = 0; key <= q; ++key) {
        const size_t kr = ((size_t)b * S + key) * ODD_IN + 4096 + hd * 256;
        const unsigned ka = *(const unsigned*)(qkvg + kr + 2 * lane), kb = *(const unsigned*)(qkvg + kr + 128 + 2 * lane);
        float s0 = q1x * __uint_as_float(ka << 16) + q1y * __uint_as_float(ka & 0xffff0000u);
        float s1 = q2x * __uint_as_float(kb << 16) + q2y * __uint_as_float(kb & 0xffff0000u);
        s0 = wave_sum(s0) * scale; s1 = wave_sum(s1) * scale;
        if (lane == 0) { sc[w][0][key] = s0; sc[w][1][key] = s1; }
        m0 = fmaxf(m0, s0); m1 = fmaxf(m1, s1);
    }
    __syncthreads();
    float e0 = 0.f, e1 = 0.f;
    for (int key = lane; key <= q; key += 64) { const float p0 = __expf(sc[w][0][key] - m0), p1 = __expf(sc[w][1][key] - m1); sc[w][0][key] = p0; sc[w][1][key] = p1; e0 += p0; e1 += p1; }
    e0 = wave_sum(e0); e1 = wave_sum(e1);
    __syncthreads();
    const float i0 = 1.f / e0, i1 = lam / e1;
    float o[4] = {0.f, 0.f, 0.f, 0.f};
    for (int key = 0; key <= q; ++key) {
        const float a = sc[w][0][key] * i0 - sc[w][1][key] * i1;
        const uint2 vv = *(const uint2*)(qkvg + ((size_t)b * S + key) * ODD_IN + 8192 + hd * 256 + 4 * lane);
        o[0] += a * __uint_as_float(vv.x << 16); o[1] += a * __uint_as_float(vv.x & 0xffff0000u);
        o[2] += a * __uint_as_float(vv.y << 16); o[3] += a * __uint_as_float(vv.y & 0xffff0000u);
    }
    float ss = o[0] * o[0] + o[1] * o[1] + o[2] * o[2] + o[3] * o[3];
    ss = wave_sum(ss);
    const float rs = rsqrtf(ss / 256.f + EPS) * (1.f - LAMBDA_INIT);
#pragma unroll
    for (int i = 0; i < 4; ++i) {
        const int dv = 4 * lane + i;
        const float gt = bf2f(qkvg[row * ODD_IN + 12288 + hd * 256 + dv]);
        ocat[row * MIXW + hd * 256 + dv] = f2bf(o[i] * rs * subw[dv] * siluf_(gt));
    }
}

extern "C" void kernel_launch(void* const* d_in, const int* in_sizes, int n_in, void* d_out, int out_size, void* d_ws, size_t ws_size, hipStream_t stream) {
    static int grid = 0;
    if (grid == 0) {
        if (n_in != 22 || ws_size < WS_END || out_size != M * D) { fprintf(stderr, "kernel_launch: unexpected n_in %d / out_size %d / ws_size %zu (< %zu)\n", n_in, out_size, ws_size, (size_t)WS_END); grid = -1; return; }
        int dev = 0, cus = 0, per_cu = 0;
        if (hipGetDevice(&dev) != hipSuccess || hipDeviceGetAttribute(&cus, hipDeviceAttributeMultiprocessorCount, dev) != hipSuccess) { fprintf(stderr, "kernel_launch: device query failed\n"); grid = -1; return; }
        if (hipFuncSetAttribute((const void*)mega, hipFuncAttributeMaxDynamicSharedMemorySize, LDS_BYTES) != hipSuccess) { fprintf(stderr, "kernel_launch: hipFuncSetAttribute failed\n"); grid = -1; return; }
        if (hipOccupancyMaxActiveBlocksPerMultiprocessor(&per_cu, (const void*)mega, NWAVES * 64, LDS_BYTES) != hipSuccess || per_cu < 1) { fprintf(stderr, "kernel_launch: occupancy query says %d blocks/CU\n", per_cu); (void)hipGetLastError(); grid = -1; return; }
        if (cus != 256) { fprintf(stderr, "kernel_launch: built for 256 CUs, device has %d\n", cus); grid = -1; return; }
        grid = cus;
    }
    if (grid < 0) return;
    const float* in[22]; for (int i = 0; i < 22; ++i) in[i] = (const float*)d_in[i];
    float* out = (float*)d_out; unsigned char* ws = (unsigned char*)d_ws;
    bf16* proj0 = (bf16*)(ws + WS_PROJ0); float* ytmp = (float*)(ws + WS_STATES); bf16* ycat = (bf16*)(ws + WS_YCAT);
    float* dt = (float*)(ws + WS_DT); float* mu = (float*)(ws + WS_SGU_MU); float* rs = (float*)(ws + WS_SGU_RS);
    bf16* qkvg = proj0; bf16* ocat = ycat;
    (void)hipMemsetAsync(ws + WS_CTL, 0, CTL_ZERO_BYTES, stream);
    Args a{};
    for (int i = 0; i < 22; ++i) a.in[i] = in[i];
    a.out = out; a.ws = ws;
    auto launch = [&](int lo, int hi, int li) { a.ph_lo = lo; a.ph_hi = hi; a.li = li; hipLaunchKernelGGL(mega, dim3(grid), dim3(NWAVES * 64), LDS_BYTES, stream, a); };
    launch(PH_PRO, PH_N, 0);
}
```

```cpp
#include <hip/hip_runtime.h>
#include <cstdio>
#include <cstdint>

namespace pg8 {
#define PG8_LAS __attribute__((address_space(3)))
typedef unsigned short bf16_t;
typedef short bf16x8 __attribute__((ext_vector_type(8)));
typedef float f32x4 __attribute__((ext_vector_type(4)));
typedef unsigned u32x4 __attribute__((ext_vector_type(4)));
constexpr int BM = 256, BK = 64, HALF = 128, HTB = HALF * BK * 2  , STAGE_BYTES = 8 * HTB, NXCD = 8, WGM = 8;

__host__ __device__ __forceinline__ int lds_byte(int r, int c) { const int st = (r >> 4) * 2 + (c >> 5), rr = r & 15, cc = c & 31, ob = rr * 64 + cc * 2; return st * 1024 + (ob ^ (((ob >> 9) & 1) << 5)); }
__host__ __device__ __forceinline__ void stage_rc(int b, int& R, int& C) { const int st = b / 1024, sb = b % 1024, swz = sb ^ (((sb >> 9) & 1) << 5); R = (st >> 1) * 16 + swz / 64; C = (st & 1) * 32 + (swz % 64) / 2; }
__host__ __device__ __forceinline__ int perm32(int rho) { const int n = rho >> 4, i = rho & 15; return 8 * (i >> 2) + 4 * n + (i & 3); }

struct Unit { int pm, pn; };
struct Gemm { const bf16_t* A; const bf16_t* Bt; int M, N, K; };

struct StaticOrder {
    int nM, nN, nwg, G, c;
    __host__ __device__ void init(int M, int N, int G_, int c_) { nM = M / BM; nN = N / BM; nwg = nM * nN; G = G_; c = c_; }
    __host__ __device__ bool next(int i, Unit& u) const {
        const long L = (long)i * G + c; if (L >= nwg) return false;
        int wgid = (int)L; { const int q = nwg / NXCD, r = nwg % NXCD, xcd = wgid % NXCD, off = wgid / NXCD; wgid = (xcd < r ? xcd * (q + 1) : r * (q + 1) + (xcd - r) * q) + off; }
        const int nig = WGM * nN, gid = wgid / nig, fm = gid * WGM, gsz = (nM - fm) < WGM ? (nM - fm) : WGM;
        u.pm = fm + ((wgid % nig) % gsz); u.pn = (wgid % nig) / gsz; return true;
    }
    __device__ __forceinline__ void a_ready(const Unit&) const {}
    __device__ __forceinline__ void done(const Unit&) const {}
};

__device__ __forceinline__ unsigned cvt_pk_bf16(float lo, float hi) { unsigned r; asm volatile("v_cvt_pk_bf16_f32 %0, %1, %2" : "=v"(r) : "v"(lo), "v"(hi)); return r; }

constexpr float RMS_EPS = 1e-6f;
template <int NP> struct EpiRowScaleBf16 {
    static constexpr bool PERM = true, AFTER_DRAIN = false;
    bf16_t* O; int ldc; const float* rs;
    __device__ __forceinline__ void operator()(const f32x4 (&acc)[2][2][4][2], const Unit& u, int wr, int wc, int fr, int fq) const {
        const int row0 = u.pm * BM + wr * 64 + fr, col0 = u.pn * BM + wc * 32 + 8 * fq;
#pragma unroll
        for (int ai = 0; ai < 2; ++ai)
#pragma unroll
            for (int m = 0; m < 4; ++m) {
                const int row = row0 + ai * HALF + m * 16;
                float sc;
                if (NP == 1) sc = rs[row];
                else { const f32x4 a = *(const f32x4*)(rs + (size_t)row * 8), b = *(const f32x4*)(rs + (size_t)row * 8 + 4);
                       sc = rsqrtf((((a[0] + a[1]) + (a[2] + a[3])) + ((b[0] + b[1]) + (b[2] + b[3]))) * (1.0f / 2048.0f) + RMS_EPS); }
                bf16_t* rowp = O + (size_t)row * ldc + col0;
#pragma unroll
                for (int bj = 0; bj < 2; ++bj) { const f32x4 v0 = acc[ai][bj][m][0] * sc, v1 = acc[ai][bj][m][1] * sc;
                    u32x4 w; w.x = cvt_pk_bf16(v0[0], v0[1]); w.y = cvt_pk_bf16(v0[2], v0[3]); w.z = cvt_pk_bf16(v1[0], v1[1]); w.w = cvt_pk_bf16(v1[2], v1[3]);
                    *(u32x4*)(rowp + bj * HALF) = w; }
            }
    }
};
template <bool WBF> struct EpiResid {
    static constexpr bool PERM = false, AFTER_DRAIN = true;
    const float* base; float* out; bf16_t* hb; float* ssqp; int ldc;
    __device__ __forceinline__ void fused(f32x4 (&acc)[2][2][4][2], const Unit& u, int wr, int wc, int fr, int fq, PG8_LAS unsigned char* lds, int wid, int lane) const {
        typedef unsigned u32x2v __attribute__((ext_vector_type(2)));
        PG8_LAS float* P = (PG8_LAS float*)lds;
        const int col0 = u.pn * BM + wc * 32 + 4 * fq;
#pragma unroll
        for (int ai = 0; ai < 2; ++ai)
#pragma unroll
            for (int m = 0; m < 4; ++m) {
                const int r = ai * HALF + wr * 64 + m * 16 + fr; const size_t off = (size_t)(u.pm * BM + r) * ldc + col0; float ss = 0.f;
#pragma unroll
                for (int bj = 0; bj < 2; ++bj)
#pragma unroll
                    for (int n = 0; n < 2; ++n) {
                        const f32x4 bs = *(const f32x4*)(base + off + bj * HALF + n * 16); const f32x4 h = bs + acc[ai][bj][m][n];
                        *(f32x4*)(out + off + bj * HALF + n * 16) = h;
                        if (WBF) { u32x2v w; w.x = cvt_pk_bf16(h[0], h[1]); w.y = cvt_pk_bf16(h[2], h[3]); *(u32x2v*)(hb + off + bj * HALF + n * 16) = w; }
                        ss += (h[0] * h[0] + h[1] * h[1]) + (h[2] * h[2] + h[3] * h[3]); }
                ss += __shfl_xor(ss, 16); ss += __shfl_xor(ss, 32);
                if (fq == 0) P[r * 4 + wc] = ss;
                if (m & 1) asm volatile("" ::: "memory");
            }
        asm volatile("s_waitcnt lgkmcnt(0)" ::: "memory"); __builtin_amdgcn_s_barrier(); asm volatile("" ::: "memory");
        const int tid = wid * 64 + lane;
        if (tid < 256) { const f32x4 p = *(const PG8_LAS f32x4*)(P + tid * 4); ssqp[(size_t)(u.pm * BM + tid) * 8 + u.pn] = (p[0] + p[1]) + (p[2] + p[3]); }
    }
};
template <class Epi, class Sched, bool ALIGN_EPI = false, bool SP2 = false>
__device__ __forceinline__ void gemm_phase(PG8_LAS unsigned char* lds, const Gemm g, const Sched& S, const Epi& E) {
    const int tid = threadIdx.x, wid = __builtin_amdgcn_readfirstlane(tid >> 6), lane = tid & 63, wr = wid >> 2, wc = wid & 3, fr = lane & 15, fq = lane >> 4;
    const int K = g.K, nt = K / BK;
    unsigned voffA[2], voffB[2];
#pragma unroll
    for (int i = 0; i < 2; ++i) { int R, C; stage_rc(tid * 16 + i * 8192, R, C); const int Rb = Epi::PERM ? ((R & ~31) + perm32(R & 31)) : R;
        voffA[i] = (unsigned)(R * K + C) * 2u; voffB[i] = (unsigned)(Rb * K + C) * 2u; }
    const size_t kstep = (size_t)(BK * 2);
    const size_t hstep = (size_t)HALF * K * 2;
    const size_t tstep = 2 * hstep;
    const unsigned ldsw = (unsigned)wid * 1024u;
    const int aoff = lds_byte(wr * 64 + fr, fq * 8), boff = lds_byte(wc * 32 + fr, fq * 8);
#define PG8_SA(b, h) (((b) * 2 + (h)) * HTB)
#define PG8_SB(b, h) ((4 + (b) * 2 + (h)) * HTB)
#define PG8_STAGE(bufoff, gbase, voff) do { _Pragma("unroll") for (int _i = 0; _i < 2; ++_i) \
        __builtin_amdgcn_global_load_lds((const unsigned*)((const char*)(gbase) + (voff)[_i]), (PG8_LAS unsigned*)(lds + (bufoff) + ldsw + _i * 8192), 16, 0, 0); } while (0)
#define PG8_LDA(dst, b, h) do { _Pragma("unroll") for (int m = 0; m < 4; ++m) _Pragma("unroll") for (int k = 0; k < 2; ++k) dst[m][k] = *(const PG8_LAS bf16x8*)(lds + PG8_SA(b, h) + aoff + m * 2048 + k * 1024); } while (0)
#define PG8_LDB(dst, b, h) do { _Pragma("unroll") for (int n = 0; n < 2; ++n) _Pragma("unroll") for (int k = 0; k < 2; ++k) dst[n][k] = *(const PG8_LAS bf16x8*)(lds + PG8_SB(b, h) + boff + n * 2048 + k * 1024); } while (0)
#define PG8_MMA(ai, bj, At, Bt) do { __builtin_amdgcn_s_setprio(1); _Pragma("unroll") for (int m = 0; m < 4; ++m) _Pragma("unroll") for (int n = 0; n < 2; ++n) _Pragma("unroll") for (int k = 0; k < 2; ++k) \
        acc[ai][bj][m][n] = __builtin_amdgcn_mfma_f32_16x16x32_bf16(Bt[n][k], At[m][k], acc[ai][bj][m][n], 0, 0, 0); __builtin_amdgcn_s_setprio(0); } while (0)
#define PG8_WAIT_V(n) asm volatile("s_waitcnt vmcnt(" #n ")" ::: "memory")
#define PG8_WAIT_L(n) asm volatile("s_waitcnt lgkmcnt(" #n ")" ::: "memory")
#define PG8_BAR __builtin_amdgcn_s_barrier()
#define PG8_SCHED __builtin_amdgcn_sched_barrier(0)
    Unit cur, nxt; int ui = 0;
    if (!S.next(0, cur)) return;
    f32x4 acc[2][2][4][2];
#pragma unroll
    for (int a = 0; a < 2; ++a)
#pragma unroll
        for (int b = 0; b < 2; ++b)
#pragma unroll
            for (int m = 0; m < 4; ++m)
#pragma unroll
                for (int n = 0; n < 2; ++n) acc[a][b][m][n] = (f32x4){0.f, 0.f, 0.f, 0.f};
    bf16x8 At[4][2], B0[2][2], B1[2][2];
    const char* cA = (const char*)g.A + (size_t)cur.pm * tstep; const char* cB = (const char*)g.Bt + (size_t)cur.pn * tstep;
    S.a_ready(cur);
    if constexpr (SP2) {
        PG8_STAGE(PG8_SB(0, 0), cB, voffB); PG8_STAGE(PG8_SB(0, 1), cB + hstep, voffB); PG8_STAGE(PG8_SA(0, 0), cA, voffA); PG8_STAGE(PG8_SA(0, 1), cA + hstep, voffA);
        if (wr == 1) PG8_BAR;
        PG8_WAIT_V(2); PG8_BAR;
        PG8_STAGE(PG8_SB(1, 0), cB + kstep, voffB); PG8_STAGE(PG8_SA(1, 0), cA + kstep, voffA); PG8_STAGE(PG8_SB(1, 1), cB + hstep + kstep, voffB);
        PG8_WAIT_V(6); PG8_BAR;
    } else {
        PG8_STAGE(PG8_SB(0, 0), cB, voffB); PG8_STAGE(PG8_SA(0, 0), cA, voffA); PG8_STAGE(PG8_SB(0, 1), cB + hstep, voffB); PG8_STAGE(PG8_SA(0, 1), cA + hstep, voffA);
        if (wr == 1) PG8_BAR;
        PG8_WAIT_V(4); PG8_BAR;
        PG8_STAGE(PG8_SB(1, 0), cB + kstep, voffB); PG8_STAGE(PG8_SA(1, 0), cA + kstep, voffA); PG8_STAGE(PG8_SB(1, 1), cB + hstep + kstep, voffB);
        PG8_WAIT_V(6); PG8_BAR;
    }
    for (;;) {
        const bool has_next = S.next(ui + 1, nxt);
        const char* nA = has_next ? (const char*)g.A + (size_t)nxt.pm * tstep : cA; const char* nB = has_next ? (const char*)g.Bt + (size_t)nxt.pn * tstep : cB;
        for (int t = 0; t < nt; t += 2) {
            const bool last = (t == nt - 2);
            const char* a1 = cA + (size_t)(t + 1) * kstep;
            const char* a2 = last ? nA : cA + (size_t)(t + 2) * kstep; const char* b2 = last ? nB : cB + (size_t)(t + 2) * kstep;
            const char* a3 = a2 + kstep; const char* b3 = b2 + kstep;
            if (last && has_next) S.a_ready(nxt);
            if constexpr (SP2) {
            PG8_LDB(B0, 0, 0); PG8_LDB(B1, 0, 1); PG8_SCHED; PG8_LDA(At, 0, 0); PG8_STAGE(PG8_SA(1, 1), a1 + hstep, voffA);
            PG8_WAIT_V(8); PG8_WAIT_L(0); PG8_BAR; PG8_MMA(0, 0, At, B0); PG8_MMA(0, 1, At, B1); PG8_BAR; PG8_SCHED;
            PG8_LDA(At, 0, 1); PG8_STAGE(PG8_SB(0, 0), b2, voffB); PG8_STAGE(PG8_SB(0, 1), b2 + hstep, voffB); PG8_STAGE(PG8_SA(0, 0), a2, voffA);
            PG8_WAIT_V(8); PG8_WAIT_L(0); PG8_BAR; PG8_MMA(1, 0, At, B0); PG8_MMA(1, 1, At, B1); PG8_BAR; PG8_SCHED;
            PG8_LDB(B0, 1, 0); PG8_LDB(B1, 1, 1); PG8_SCHED; PG8_LDA(At, 1, 0); PG8_STAGE(PG8_SA(0, 1), a2 + hstep, voffA);
            PG8_WAIT_V(8); PG8_WAIT_L(0); PG8_BAR; PG8_MMA(0, 0, At, B0); PG8_MMA(0, 1, At, B1); PG8_BAR; PG8_SCHED;
            PG8_LDA(At, 1, 1); PG8_STAGE(PG8_SB(1, 0), b3, voffB); PG8_STAGE(PG8_SB(1, 1), b3 + hstep, voffB); PG8_STAGE(PG8_SA(1, 0), a3, voffA);
            PG8_WAIT_V(8); PG8_WAIT_L(0); PG8_BAR; PG8_MMA(1, 0, At, B0); PG8_MMA(1, 1, At, B1); PG8_BAR; PG8_SCHED;
            } else {
            PG8_LDB(B0, 0, 0); PG8_SCHED; PG8_LDA(At, 0, 0); PG8_STAGE(PG8_SA(1, 1), a1 + hstep, voffA);
            PG8_WAIT_L(8); PG8_BAR; PG8_WAIT_L(0); PG8_MMA(0, 0, At, B0); PG8_BAR; PG8_SCHED;
            PG8_LDB(B1, 0, 1); PG8_STAGE(PG8_SB(0, 0), b2, voffB);
            PG8_BAR; PG8_WAIT_L(0); PG8_MMA(0, 1, At, B1); PG8_BAR;
            PG8_LDA(At, 0, 1); PG8_STAGE(PG8_SA(0, 0), a2, voffA);
            PG8_BAR; PG8_WAIT_L(0); PG8_MMA(1, 0, At, B0); PG8_BAR; PG8_SCHED;
            PG8_STAGE(PG8_SB(0, 1), b2 + hstep, voffB);
            PG8_WAIT_V(6); PG8_BAR; PG8_MMA(1, 1, At, B1); PG8_BAR;
            PG8_LDB(B0, 1, 0); PG8_SCHED; PG8_LDA(At, 1, 0); PG8_STAGE(PG8_SA(0, 1), a2 + hstep, voffA);
            PG8_WAIT_L(8); PG8_BAR; PG8_WAIT_L(0); PG8_MMA(0, 0, At, B0); PG8_BAR; PG8_SCHED;
            PG8_LDB(B1, 1, 1); PG8_STAGE(PG8_SB(1, 0), b3, voffB);
            PG8_BAR; PG8_WAIT_L(0); PG8_MMA(0, 1, At, B1); PG8_BAR;
            PG8_LDA(At, 1, 1); PG8_STAGE(PG8_SA(1, 0), a3, voffA);
            PG8_BAR; PG8_WAIT_L(0); PG8_MMA(1, 0, At, B0); PG8_BAR; PG8_SCHED;
            PG8_STAGE(PG8_SB(1, 1), b3 + hstep, voffB);
            PG8_WAIT_V(6); PG8_BAR; PG8_MMA(1, 1, At, B1); PG8_BAR;
            }
        }
        if constexpr (ALIGN_EPI) { if (wr == 0) PG8_BAR; }
        if constexpr (!Epi::AFTER_DRAIN) { E(acc, cur, wr, wc, fr, fq); S.done(cur); }
        if (!has_next) break;
#pragma unroll
        for (int a = 0; a < 2; ++a)
#pragma unroll
            for (int b = 0; b < 2; ++b)
#pragma unroll
                for (int m = 0; m < 4; ++m)
#pragma unroll
                    for (int n = 0; n < 2; ++n) acc[a][b][m][n] = (f32x4){0.f, 0.f, 0.f, 0.f};
        cur = nxt; cA = nA; cB = nB; ++ui;
        if constexpr (ALIGN_EPI) { if (wr == 1) PG8_BAR; }
    }
    PG8_WAIT_V(0);
    if constexpr (!ALIGN_EPI) { if (wr == 0) PG8_BAR; }
    PG8_BAR;
    if constexpr (Epi::AFTER_DRAIN) { E.fused(acc, cur, wr, wc, fr, fq, lds, wid, lane); S.done(cur); }
#undef PG8_SA
#undef PG8_SB
#undef PG8_STAGE
#undef PG8_LDA
#undef PG8_LDB
#undef PG8_MMA
#undef PG8_WAIT_V
#undef PG8_WAIT_L
#undef PG8_BAR
#undef PG8_SCHED
}

}

constexpr int NB = 4, S = 2048, M = NB * S, D = 2048;
constexpr int EVEN_IN = 12320, N1 = 12288;
constexpr int C_ZA = 0, C_XBC = 2048, C_ZB = 6144, C_U = 8192, C_V = 10240;
constexpr int XBC_W = 4096;
constexpr int ODD_IN = 16384, MIXW = 4096;
constexpr float EPS = 1e-6f;
constexpr float LAMBDA_INIT = 0.35550906759096924f;

constexpr size_t MiB = 1u << 20;
constexpr size_t WS_CTL = 0, CTL_ZERO_BYTES = 1 * MiB;
constexpr size_t WS_WIN0 = 1 * MiB;
constexpr size_t WS_WOUT0 = 49 * MiB;
constexpr size_t WS_WIN1 = 65 * MiB;
constexpr size_t WS_WOUT1 = 129 * MiB;
constexpr size_t WS_XB = 145 * MiB;
constexpr size_t WS_PROJ0 = 177 * MiB;
constexpr size_t WS_STATES = 369 * MiB;
constexpr size_t WS_YCAT = 433 * MiB;
constexpr size_t WS_DT = 497 * MiB;
constexpr size_t WS_RSTD0 = 498 * MiB;
constexpr size_t WS_SGU_MU = WS_RSTD0 + 128 * 1024;
constexpr size_t WS_SGU_RS = WS_SGU_MU + 64 * 1024;
constexpr size_t WS_SSQ1 = WS_RSTD0 + 256 * 1024;
constexpr size_t WS_SSQ2 = WS_RSTD0 + 512 * 1024;
constexpr size_t WS_CDEC = WS_RSTD0 + 768 * 1024;
constexpr size_t WS_END = 499 * MiB;
constexpr int CW_BAR = 4096;

#define GAS __attribute__((address_space(1)))
#define LAS __attribute__((address_space(3)))
typedef unsigned short bf16;
typedef unsigned v4u __attribute__((ext_vector_type(4)));
typedef unsigned v2u __attribute__((ext_vector_type(2)));
typedef float f32x4 __attribute__((ext_vector_type(4)));
typedef float f32x16 __attribute__((ext_vector_type(16)));
typedef short bf16x8 __attribute__((ext_vector_type(8)));
#define LDS_WAIT() asm volatile("s_waitcnt lgkmcnt(0)" ::: "memory")
#define VM_WAIT() asm volatile("s_waitcnt vmcnt(0)" ::: "memory")
__device__ __forceinline__ unsigned pk2(float lo, float hi) { return pg8::cvt_pk_bf16(lo, hi); }
__device__ __forceinline__ float bf2f(bf16 v) { return __uint_as_float(((unsigned)v) << 16); }
__device__ __forceinline__ bf16 f2bf(float f) { unsigned u = __float_as_uint(f); return (bf16)((u + 0x7fffu + ((u >> 16) & 1u)) >> 16); }
__device__ __forceinline__ float sigmoidf_(float v) { return 1.f / (1.f + __expf(-v)); }
__device__ __forceinline__ float siluf_(float v) { return v * sigmoidf_(v); }
__device__ __forceinline__ float geluf_(float v) { const float c = 0.7978845608028654f; float t = tanhf(c * (v + 0.044715f * v * v * v)); return 0.5f * v * (1.f + t); }
__device__ __forceinline__ float softplusf_(float v) { return v > 20.f ? v : log1pf(__expf(v)); }
__device__ __forceinline__ float wave_sum(float v) {
#pragma unroll
    for (int o = 1; o < 64; o <<= 1) v += __shfl_xor(v, o);
    return v;
}

#define XB_TMO      128
#define XB_XCNT(j)  (256  + 64 * (j))
#define XB_XSUB(j)  (1280 + 64 * (j))
#define XB_XGEN(j)  (2304 + 64 * (j))
#define XB_TOP      3328
#define XB_TOPGEN   3392
#define XCD_BAR_WORDS 3456
#define XB_SPIN_CAP (1u << 25)

__device__ __forceinline__ unsigned xb_ld(unsigned* p)              { return __hip_atomic_load(p, __ATOMIC_RELAXED, __HIP_MEMORY_SCOPE_AGENT); }
__device__ __forceinline__ unsigned xb_add(unsigned* p, unsigned v) { return __hip_atomic_fetch_add(p, v, __ATOMIC_RELAXED, __HIP_MEMORY_SCOPE_AGENT); }
__device__ __forceinline__ unsigned xb_xcc_id() { return (unsigned)__builtin_amdgcn_s_getreg((3 << 11) | 20) & 0xFu; }
#define XB_SPIN(cond, bar) do { unsigned _sp = 0; while (cond) { __builtin_amdgcn_s_sleep(1); \
    if ((++_sp & 255u) == 0u) { if (xb_ld(&(bar)[XB_TMO])) break; if (_sp > XB_SPIN_CAP) { atomicAdd(&(bar)[XB_TMO], 1u); break; } } } } while (0)

struct XcdBarrier {
    unsigned* bar; unsigned x;
    volatile LAS unsigned* st;
};

__device__ __forceinline__ XcdBarrier xcd_barrier_post(unsigned* bar, volatile LAS unsigned* st) {
    XcdBarrier b; b.bar = bar; b.x = xb_xcc_id(); b.st = st;
    if (threadIdx.x == 0) (void)xb_add(&bar[XB_XCNT(b.x)], 1u);
    return b;
}
__device__ __forceinline__ void xcd_barrier_complete(unsigned* bar, unsigned x, unsigned& nloc, unsigned& nx) {
    const unsigned G = gridDim.x * gridDim.y * gridDim.z;
    unsigned sum, cnt, mine, sp = 0u;
    for (;;) {
        sum = 0u; cnt = 0u; mine = 0u;
#pragma unroll
        for (unsigned j = 0; j < 16; ++j) { const unsigned c = xb_ld(&bar[XB_XCNT(j)]); sum += c; cnt += (c > 0u) ? 1u : 0u; mine = (j == x) ? c : mine; }
        if (sum == G) break;
        __builtin_amdgcn_s_sleep(1);
        if ((++sp & 255u) == 0u) { if (xb_ld(&bar[XB_TMO])) break; if (sp > XB_SPIN_CAP) { atomicAdd(&bar[XB_TMO], 1u); break; } }
    }
    nloc = mine > 0u ? mine : 1u; nx = cnt > 0u ? cnt : 1u;
}

__device__ __forceinline__ void xcd_barrier(const XcdBarrier& b) {
    asm volatile("s_waitcnt vmcnt(0)" ::: "memory");
    __syncthreads();
    if (threadIdx.x == 0) {
        unsigned* bar = b.bar;
        __builtin_amdgcn_s_waitcnt(0);
        unsigned nloc = b.st[0], nx = b.st[1];
        if (nloc == 0u) { xcd_barrier_complete(bar, b.x, nloc, nx); b.st[0] = nloc; b.st[1] = nx; }
        const unsigned old = xb_add(&bar[XB_XSUB(b.x)], 1u);
        const unsigned gen = old / nloc;
        if (old + 1u == (gen + 1u) * nloc) {
            __builtin_amdgcn_fence(__ATOMIC_RELEASE, "agent");
            asm volatile("s_waitcnt vmcnt(0)" ::: "memory");
            const unsigned og = xb_add(&bar[XB_TOP], 1u);
            const unsigned tg = og / nx;
            if (og + 1u == (tg + 1u) * nx) xb_add(&bar[XB_TOPGEN], 1u);
            else XB_SPIN(xb_ld(&bar[XB_TOPGEN]) == tg, bar);
            __builtin_amdgcn_fence(__ATOMIC_ACQUIRE, "agent");
            xb_add(&bar[XB_XGEN(b.x)], 1u);
            asm volatile("s_waitcnt vmcnt(0)" ::: "memory");
        } else {
            XB_SPIN(xb_ld(&bar[XB_XGEN(b.x)]) == gen, bar);
            __builtin_amdgcn_fence(__ATOMIC_ACQUIRE, "agent");
            asm volatile("s_waitcnt vmcnt(0)" ::: "memory");
        }
    }
    __syncthreads();
}


constexpr int NWAVES = 8;
constexpr int LDS_BYTES = 163840;
constexpr int LDSCTL_OFF = LDS_BYTES - 256;
struct Frame {
    LAS unsigned char* lds;
    volatile LAS unsigned* MISC;
    unsigned* ctl;
    int tid, lane, wave, G;
    const float* in[22]; float* out;
    bf16 *Wt_in0, *Wt_out0, *Wt_in1, *Wt_out1, *xb, *proj0, *ycat, *h1b, *qkvg, *ocat;
    float *dt, *rstd0, *ssq1, *ssq2;
};
enum InIdx { I_X = 0, I_NORMW, I_WIN0, I_CONVW, I_CONVB, I_DTB, I_ALOG, I_DSKIP, I_SSDNW, I_LNW, I_LNB, I_SGUWS, I_SGUB, I_WOUT0, I_WIN1, I_LQ1, I_LK1, I_LQ2, I_LK2, I_SUBW, I_WOUT1, I_FW };

__device__ __forceinline__ void p0_transpose_item(const float* W, int ldw, int K, bf16* WT, int nblk, int shift_from, int shift, const float* ksc, LAS float* scr, int item, int lane) {
    const int kb = item / nblk, nb = item % nblk, k0 = 64 * kb, n0 = 32 * nb, ns = n0 + (n0 >= shift_from ? shift : 0);
#pragma unroll 8
    for (int i = 0; i < 32; ++i) { const int kk = 2 * i + (lane >> 5); float v = W[(size_t)(k0 + kk) * ldw + ns + (lane & 31)]; if (ksc) v *= ksc[k0 + kk]; scr[kk * 33 + (lane & 31)] = v; }
    LDS_WAIT(); asm volatile("" ::: "memory");
    const int c = lane & 7;
#pragma unroll
    for (int j = 0; j < 4; ++j) { const int n = (lane >> 3) + 8 * j; const LAS float* s = scr + (8 * c) * 33 + n;
        v4u o; o.x = pk2(s[0 * 33], s[1 * 33]); o.y = pk2(s[2 * 33], s[3 * 33]); o.z = pk2(s[4 * 33], s[5 * 33]); o.w = pk2(s[6 * 33], s[7 * 33]);
        *(GAS v4u*)(WT + (size_t)(n0 + n) * K + k0 + 8 * c) = o; }
    LDS_WAIT(); asm volatile("" ::: "memory");
}
__device__ __forceinline__ void p0_prologue(Frame& F) {
    {
        LAS float* scr = (LAS float*)(F.lds + F.wave * 16384);
        const int gw = (int)blockIdx.x * NWAVES + F.wave, NGW = F.G * NWAVES;
        constexpr int I_A = (D / 64) * (N1 / 32), I_B = (MIXW / 64) * (D / 32), I_C = (D / 64) * (ODD_IN / 32), I_D = I_B;
        constexpr int NITEMS = I_A + I_B + I_C + I_D;
        const float* nw = F.in[I_NORMW];
        for (int it = gw; it < NITEMS; it += NGW) {
            int r = it;
            if (r < I_A) { p0_transpose_item(F.in[I_WIN0], EVEN_IN, D, F.Wt_in0, N1 / 32, 6144, 32, nw, scr, r, F.lane); continue; } r -= I_A;
            if (r < I_B) { p0_transpose_item(F.in[I_WOUT0], D, MIXW, F.Wt_out0, D / 32, 1 << 30, 0, nullptr, scr, r, F.lane); continue; } r -= I_B;
            if (r < I_C) { p0_transpose_item(F.in[I_WIN1], ODD_IN, D, F.Wt_in1, ODD_IN / 32, 1 << 30, 0, nw + D, scr, r, F.lane); continue; } r -= I_C;
            p0_transpose_item(F.in[I_WOUT1], D, MIXW, F.Wt_out1, D / 32, 1 << 30, 0, nullptr, scr, r, F.lane);
        }
    }
    __syncthreads();
    constexpr int TROW = 4112;
    LAS unsigned char* tile = F.lds;
    LAS float* rst = (LAS float*)(F.lds + 32 * TROW);
    const float* x = F.in[I_X]; const float* nw0 = F.in[I_NORMW]; const float* wdt = F.in[I_WIN0] + 6144; const float* dtb = F.in[I_DTB];
    for (int blk = blockIdx.x; blk < M / 32; blk += F.G) {
        for (int i = 0; i < 4; ++i) {
            const int rl = F.wave * 4 + i, row = blk * 32 + rl;
            const GAS f32x4* xr = (const GAS f32x4*)(x + (size_t)row * D) + F.lane;
            f32x4 v[8]; float ss = 0.f;
#pragma unroll
            for (int j = 0; j < 8; ++j) { v[j] = xr[64 * j]; ss += (v[j][0] * v[j][0] + v[j][1] * v[j][1]) + (v[j][2] * v[j][2] + v[j][3] * v[j][3]); }
            ss = wave_sum(ss);
            const float rstd = rsqrtf(ss * (1.0f / D) + EPS);
            if (F.lane == 0) { F.rstd0[row] = rstd; rst[rl] = rstd; }
            GAS v2u* o8 = (GAS v2u*)(F.xb + (size_t)row * D) + F.lane;
#pragma unroll
            for (int j = 0; j < 8; ++j) { v2u w; w.x = pk2(v[j][0], v[j][1]); w.y = pk2(v[j][2], v[j][3]); o8[64 * j] = w; *(LAS v2u*)(tile + rl * TROW + (64 * j + F.lane) * 8) = w; }
        }
        LDS_WAIT(); __syncthreads();
        const int r32 = F.lane & 31, hi = F.lane >> 5;
        f32x16 acc = {};
        for (int ks = 0; ks < 16; ++ks) {
            const int k0 = 256 * F.wave + 16 * ks + 8 * hi;
            const bf16x8 a = *(const LAS bf16x8*)(tile + r32 * TROW + k0 * 2);
            float wv[8];
#pragma unroll
            for (int j = 0; j < 8; ++j) wv[j] = wdt[(size_t)(k0 + j) * EVEN_IN + r32] * nw0[k0 + j];
            v4u bw; bw.x = pk2(wv[0], wv[1]); bw.y = pk2(wv[2], wv[3]); bw.z = pk2(wv[4], wv[5]); bw.w = pk2(wv[6], wv[7]);
            acc = __builtin_amdgcn_mfma_f32_32x32x16_bf16(a, __builtin_bit_cast(bf16x8, bw), acc, 0, 0, 0);
        }
        LDS_WAIT(); __syncthreads();
        LAS float* red = (LAS float*)F.lds;
#pragma unroll
        for (int r = 0; r < 16; ++r) { const int row = (r & 3) + 8 * (r >> 2) + 4 * hi; red[(F.wave * 32 + row) * 33 + r32] = acc[r]; }
        LDS_WAIT(); __syncthreads();
        for (int idx = F.tid; idx < 1024; idx += NWAVES * 64) {
            const int row = idx >> 5, h = idx & 31; float s = 0.f;
#pragma unroll
            for (int w = 0; w < 8; ++w) s += red[(w * 32 + row) * 33 + h];
            F.dt[(size_t)(blk * 32 + row) * 32 + h] = softplusf_(s * rst[row] + dtb[h]);
        }
        LDS_WAIT(); __syncthreads();
    }
}
__device__ __forceinline__ void final_norm(Frame& F) {
    const int gw = (int)blockIdx.x * NWAVES + F.wave, NGW = F.G * NWAVES;
    const GAS f32x4* fw = (const GAS f32x4*)F.in[I_FW] + F.lane;
    for (int row = gw; row < M; row += NGW) {
        GAS f32x4* o = (GAS f32x4*)(F.out + (size_t)row * D) + F.lane;
        const f32x4 a = *(const f32x4*)(F.ssq2 + (size_t)row * 8), b = *(const f32x4*)(F.ssq2 + (size_t)row * 8 + 4);
        const float rs = rsqrtf((((a[0] + a[1]) + (a[2] + a[3])) + ((b[0] + b[1]) + (b[2] + b[3]))) * (1.0f / D) + EPS);
        f32x4 v[8];
#pragma unroll
        for (int j = 0; j < 8; ++j) v[j] = o[64 * j];
#pragma unroll
        for (int j = 0; j < 8; ++j) o[64 * j] = v[j] * rs * fw[64 * j];
    }
}


__device__ __forceinline__ float half_sum256(float v, LAS float* red, int t) {
    v = wave_sum(v);
    __syncthreads();
    if ((t & 63) == 0) red[t >> 6] = v;
    __syncthreads();
    return red[0] + red[1] + red[2] + red[3];
}
__device__ __forceinline__ void ph_ssd_naive(Frame& F, float* y) {
    constexpr int TB = 32;
    const int half = F.tid >> 8, tid = F.tid & 255;
    LAS float* xs_s = (LAS float*)(F.lds + half * 49152); LAS float* B_s = xs_s + TB * 64; LAS float* C_s = B_s + TB * 128; LAS float* dt_s = C_s + TB * 128;
    const bf16* proj0 = F.proj0; const float* conv_w = F.in[I_CONVW]; const float* conv_b = F.in[I_CONVB];
    for (int vb0 = (int)blockIdx.x * 2; vb0 < 128; vb0 += F.G * 2) {
        const int vb = vb0 + half, b = vb >> 5, hd = vb & 31, g = hd >> 2;
        const int p = tid >> 2, nq = tid & 3;
        const float a = -__expf(F.in[I_ALOG][hd]), Dk = F.in[I_DSKIP][hd];
        float h[32];
#pragma unroll
        for (int i = 0; i < 32; ++i) h[i] = 0.f;
        for (int t0 = 0; t0 < S; t0 += TB) {
            for (int idx = tid; idx < TB * 320; idx += 256) {
                const int tt = idx / 320, cc = idx % 320;
                const int ch = cc < 64 ? hd * 64 + cc : (cc < 192 ? 2048 + g * 128 + (cc - 64) : 3072 + g * 128 + (cc - 192));
                const int t = t0 + tt;
                float acc = conv_b[ch];
#pragma unroll
                for (int k = 0; k < 4; ++k) { const int ts = t - 3 + k; if (ts >= 0) acc += conv_w[k * XBC_W + ch] * bf2f(proj0[(size_t)(b * S + ts) * N1 + C_XBC + ch]); }
                const float v = siluf_(acc);
                if (cc < 64) xs_s[tt * 64 + cc] = v; else if (cc < 192) B_s[tt * 128 + cc - 64] = v; else C_s[tt * 128 + cc - 192] = v;
            }
            if (tid < TB) dt_s[tid] = F.dt[(size_t)(b * S + t0 + tid) * 32 + hd];
            __syncthreads();
            for (int tt = 0; tt < TB; ++tt) {
                const float dtv = dt_s[tt], dA = __expf(dtv * a), xv = xs_s[tt * 64 + p], xd = dtv * xv;
                float acc = 0.f;
#pragma unroll
                for (int i = 0; i < 32; ++i) { const int n = i * 4 + nq; h[i] = h[i] * dA + xd * B_s[tt * 128 + n]; acc += C_s[tt * 128 + n] * h[i]; }
                acc += __shfl_xor(acc, 1); acc += __shfl_xor(acc, 2);
                if (nq == 0) y[(size_t)(b * S + t0 + tt) * 2048 + hd * 64 + p] = acc + Dk * xv;
            }
            __syncthreads();
        }
    }
}
__device__ __forceinline__ void ph_sgu_stats_naive(Frame& F, float* mu, float* rs) {
    const int half = F.tid >> 8, t = F.tid & 255;
    LAS float* red = (LAS float*)(F.lds + 131072) + half * 4;
    for (int r0 = (int)blockIdx.x * 2; r0 < M; r0 += F.G * 2) {
        const int r = r0 + half;
        float v[8]; float s = 0.f;
#pragma unroll
        for (int i = 0; i < 8; ++i) { v[i] = geluf_(bf2f(F.proj0[(size_t)r * N1 + C_V + t + 256 * i])); s += v[i]; }
        const float mean = half_sum256(s, red, t) / 2048.f;
        float q = 0.f;
#pragma unroll
        for (int i = 0; i < 8; ++i) { const float d = v[i] - mean; q += d * d; }
        const float var = half_sum256(q, red, t) / 2048.f;
        if (t == 0) { mu[r] = mean; rs[r] = rsqrtf(var + EPS); }
    }
}
__device__ __forceinline__ void ph_ssd_gate_naive(Frame& F, const float* y) {
    const int half = F.tid >> 8, t = F.tid & 255; const float* nw = F.in[I_SSDNW];
    for (int r0 = (int)blockIdx.x * 2; r0 < M; r0 += F.G * 2) {
        const int r = r0 + half;
        float v[8]; float ss = 0.f;
#pragma unroll
        for (int i = 0; i < 8; ++i) { const int ch = t * 8 + i; const float z = bf2f(F.proj0[(size_t)r * N1 + C_ZA + ch]); v[i] = y[(size_t)r * 2048 + ch] * siluf_(z); ss += v[i] * v[i]; }
#pragma unroll
        for (int o = 1; o < 32; o <<= 1) ss += __shfl_xor(ss, o);
        const float rsv = rsqrtf(ss / 256.f + EPS);
#pragma unroll
        for (int i = 0; i < 8; ++i) { const int ch = t * 8 + i; F.ycat[(size_t)r * MIXW + ch] = f2bf(v[i] * rsv * nw[ch]); }
    }
}
__device__ __forceinline__ void ph_sgu_naive(Frame& F, const float* mu, const float* rs) {
    const int half = F.tid >> 8, tid = F.tid & 255;
    LAS float* vln = (LAS float*)(F.lds + half * 32768);
    const float* ln_w = F.in[I_LNW]; const float* ln_b = F.in[I_LNB]; const float* wsg = F.in[I_SGUWS]; const float* sb = F.in[I_SGUB];
    for (int vb0 = (int)blockIdx.x * 2; vb0 < 32 * 64; vb0 += F.G * 2) {
        const int vb = vb0 + half, bx = vb & 31, bn = vb >> 5, g = bx >> 1, hf = bx & 1, row0 = bn * 128;
        for (int idx = tid; idx < 128 * 64; idx += 256) {
            const int s = idx >> 6, c = idx & 63, ch = g * 128 + hf * 64 + c, r = row0 + s;
            const float gv = geluf_(bf2f(F.proj0[(size_t)r * N1 + C_V + ch]));
            vln[s * 64 + c] = (gv - mu[r]) * rs[r] * ln_w[ch] + ln_b[ch];
        }
        __syncthreads();
        const int c = tid & 63, tq = tid >> 6, ch = g * 128 + hf * 64 + c;
        for (int t = tq; t < 128; t += 4) {
            const float* wr = wsg + ((size_t)g * 128 + t) * 128;
            float acc = 0.f;
            for (int s = 0; s <= t; ++s) acc += wr[s] * vln[s * 64 + c];
            acc += sb[g * 128 + t];
            const int r = row0 + t;
            const float u = geluf_(bf2f(F.proj0[(size_t)r * N1 + C_U + ch])), zb = bf2f(F.proj0[(size_t)r * N1 + C_ZB + ch]);
            F.ycat[(size_t)r * MIXW + 2048 + ch] = f2bf(u * acc * siluf_(zb));
        }
        __syncthreads();
    }
}
__device__ __forceinline__ void ph_attn_naive(Frame& F) {
    const int w = F.wave, lane = F.lane;
    LAS float* sc0 = (LAS float*)(F.lds + w * 16384); LAS float* sc1 = sc0 + S;
    const bf16* qkvg = F.qkvg; const float* lq1 = F.in[I_LQ1]; const float* lk1 = F.in[I_LK1]; const float* lq2 = F.in[I_LQ2]; const float* lk2 = F.in[I_LK2]; const float* subw = F.in[I_SUBW];
    float l1 = lq1[lane] * lk1[lane] + lq1[lane + 64] * lk1[lane + 64], l2 = lq2[lane] * lk2[lane] + lq2[lane + 64] * lk2[lane + 64];
    l1 = wave_sum(l1); l2 = wave_sum(l2);
    const float lam = __expf(l1) - __expf(l2) + LAMBDA_INIT;
    const float scale = 0.08838834764831845f;
    for (int vb = (int)blockIdx.x; vb < (S / 8) * 16 * NB; vb += F.G) {
        const int qg = vb % (S / 8), hd = (vb / (S / 8)) & 15, b = vb / ((S / 8) * 16);
        const int q = qg * 8 + w;
        const size_t row = (size_t)b * S + q;
        const unsigned qa = *(const unsigned*)(qkvg + row * ODD_IN + hd * 256 + 2 * lane);
        const unsigned qb = *(const unsigned*)(qkvg + row * ODD_IN + hd * 256 + 128 + 2 * lane);
        const float q1x = __uint_as_float(qa << 16), q1y = __uint_as_float(qa & 0xffff0000u), q2x = __uint_as_float(qb << 16), q2y = __uint_as_float(qb & 0xffff0000u);
        float m0 = -INFINITY, m1 = -INFINITY;
        for (int key = 0; key <= q; ++key) {
            const size_t kr = ((size_t)b * S + key) * ODD_IN + 4096 + hd * 256;
            const unsigned ka = *(const unsigned*)(qkvg + kr + 2 * lane), kb = *(const unsigned*)(qkvg + kr + 128 + 2 * lane);
            float s0 = q1x * __uint_as_float(ka << 16) + q1y * __uint_as_float(ka & 0xffff0000u);
            float s1 = q2x * __uint_as_float(kb << 16) + q2y * __uint_as_float(kb & 0xffff0000u);
            s0 = wave_sum(s0) * scale; s1 = wave_sum(s1) * scale;
            if (lane == 0) { sc0[key] = s0; sc1[key] = s1; }
            m0 = fmaxf(m0, s0); m1 = fmaxf(m1, s1);
        }
        LDS_WAIT();
        float e0 = 0.f, e1 = 0.f;
        for (int key = lane; key <= q; key += 64) { const float p0 = __expf(sc0[key] - m0), p1 = __expf(sc1[key] - m1); sc0[key] = p0; sc1[key] = p1; e0 += p0; e1 += p1; }
        e0 = wave_sum(e0); e1 = wave_sum(e1);
        LDS_WAIT();
        const float i0 = 1.f / e0, i1 = lam / e1;
        float o[4] = {0.f, 0.f, 0.f, 0.f};
        for (int key = 0; key <= q; ++key) {
            const float a = sc0[key] * i0 - sc1[key] * i1;
            const uint2 vv = *(const uint2*)(qkvg + ((size_t)b * S + key) * ODD_IN + 8192 + hd * 256 + 4 * lane);
            o[0] += a * __uint_as_float(vv.x << 16); o[1] += a * __uint_as_float(vv.x & 0xffff0000u);
            o[2] += a * __uint_as_float(vv.y << 16); o[3] += a * __uint_as_float(vv.y & 0xffff0000u);
        }
        float ss = o[0] * o[0] + o[1] * o[1] + o[2] * o[2] + o[3] * o[3];
        ss = wave_sum(ss);
        const float rsv = rsqrtf(ss / 256.f + EPS) * (1.f - LAMBDA_INIT);
#pragma unroll
        for (int i = 0; i < 4; ++i) {
            const int dv = 4 * lane + i;
            const float gt = bf2f(qkvg[row * ODD_IN + 12288 + hd * 256 + dv]);
            F.ocat[row * MIXW + hd * 256 + dv] = f2bf(o[i] * rsv * subw[dv] * siluf_(gt));
        }
        LDS_WAIT();
    }
}


namespace att {
constexpr int STAGE = 65536, KOFF = 16384, VOFF = 32768;
constexpr float CEXP = 0.08838834764831845f * 1.4426950408889634f;
typedef short v4i16_t __attribute__((ext_vector_type(4)));
__device__ __forceinline__ v4i16_t vtr(LAS unsigned char* p) { return __builtin_amdgcn_ds_read_tr16_b64_v4i16((LAS v4i16_t*)p); }
__device__ __forceinline__ float swap_max(float v) { auto rr = __builtin_amdgcn_permlane32_swap(__float_as_uint(v), __float_as_uint(v), false, false); return fmaxf(__uint_as_float(rr[0]), __uint_as_float(rr[1])); }
__device__ __forceinline__ float swap_sum(float v) { auto rr = __builtin_amdgcn_permlane32_swap(__float_as_uint(v), __float_as_uint(v), false, false); return __uint_as_float(rr[0]) + __uint_as_float(rr[1]); }
__device__ __forceinline__ int crow(int r, int hi) { return (r & 3) + 8 * (r >> 2) + 4 * hi; }
}
__device__ __forceinline__ void attn_phase(Frame& F) {
    using namespace att;
    const int w = F.wave, map = w >> 2, sb = w & 3;
    LAS unsigned char* lds = F.lds;
    const bf16* qkvg = F.qkvg;
    const int vcu = ((int)blockIdx.x & 7) * (F.G >> 3) + ((int)blockIdx.x >> 3);
    for (int vu = vcu; vu < 64 * 4; vu += F.G) {
        const int bh = vu >> 2, s4 = vu & 3, b = bh >> 4, h = bh & 15;
        for (int ui = 0; ui < 4; ++ui) {
            const int qb = ui == 0 ? 15 - s4 : (ui == 1 ? 11 - s4 : (ui == 2 ? 4 + s4 : s4));
            const int q0 = qb * 128, NT = (q0 + 128) / 64, rb = q0 / 32 + sb;
            int lane = F.lane; asm volatile("" : "+v"(lane));
            const int r32 = lane & 31, hi = lane >> 5;
            unsigned koff[2];
#pragma unroll
            for (int i = 0; i < 2; ++i) { const int key = 8 * w + 4 * i + (lane >> 4), p = lane & 15, c = p ^ (key & 15); koff[i] = (unsigned)(key * ODD_IN + c * 8); }
            const unsigned voff0 = (unsigned)((lane >> 2) * ODD_IN + 32 * w + 8 * (lane & 3));
            const int kq = 4 * hi + ((lane & 15) >> 2);
            const int kbase = map * KOFF + r32 * 256, kswz = r32 & 15;
            const int vbase = VOFF + kq * 64 + 32 * ((lane >> 4) & 1) + 8 * (lane & 3);
            const bf16* kg = qkvg + (size_t)b * S * ODD_IN + 4096 + h * 256;
            const bf16* vg = qkvg + (size_t)b * S * ODD_IN + 8192 + h * 256;
            bf16x8 qf[8];
            { const bf16* qp = qkvg + ((size_t)b * S + q0 + 32 * sb + r32) * ODD_IN + h * 256 + map * 128 + 8 * hi;
#pragma unroll
              for (int ks = 0; ks < 8; ++ks) qf[ks] = *(const bf16x8*)(qp + 16 * ks); }
            f32x16 O[8];
#pragma unroll
            for (int i = 0; i < 8; ++i) O[i] = (f32x16){};
            float m = -1e30f, l = 0.f;
#define ATT_ISSUE(t, st) do { const size_t _ro = (size_t)(t) * 64 * ODD_IN; \
                _Pragma("unroll") for (int _i = 0; _i < 2; ++_i) { \
                    __builtin_amdgcn_global_load_lds((const unsigned*)(kg + _ro + koff[_i]), (LAS unsigned*)(lds + (st) * STAGE + (2 * w + _i) * 1024), 16, 0, 0); \
                    __builtin_amdgcn_global_load_lds((const unsigned*)(kg + _ro + 128 + koff[_i]), (LAS unsigned*)(lds + (st) * STAGE + KOFF + (2 * w + _i) * 1024), 16, 0, 0); } \
                _Pragma("unroll") for (int _i = 0; _i < 4; ++_i) \
                    __builtin_amdgcn_global_load_lds((const unsigned*)(vg + _ro + voff0 + (size_t)_i * 16 * ODD_IN), (LAS unsigned*)(lds + (st) * STAGE + VOFF + (4 * w + _i) * 1024), 16, 0, 0); } while (0)
            ATT_ISSUE(0, 0);
            for (int t = 0; t < NT; ++t) {
                asm volatile("s_waitcnt vmcnt(0)" ::: "memory"); __syncthreads();
                if (t + 1 < NT) ATT_ISSUE(t + 1, (t + 1) & 1);
                LAS unsigned char* st = lds + (t & 1) * STAGE;
#pragma unroll
                for (int kh = 0; kh < 2; ++kh) {
                    const int hidx = 2 * t + kh;
                    if (hidx <= rb) {
                        f32x16 p = (f32x16){};
#pragma unroll
                        for (int ks = 0; ks < 8; ++ks) {
                            const bf16x8 kf = *(const LAS bf16x8*)(st + kbase + kh * 8192 + (((2 * ks + hi) ^ kswz) << 4));
                            p = __builtin_amdgcn_mfma_f32_32x32x16_bf16(kf, qf[ks], p, 0, 0, 0);
                        }
                        if (hidx == rb) {
#pragma unroll
                            for (int r = 0; r < 16; ++r) if (crow(r, hi) > r32) p[r] = -INFINITY;
                        }
                        float tm = p[0];
#pragma unroll
                        for (int r = 1; r < 16; ++r) tm = fmaxf(tm, p[r]);
                        tm = swap_max(tm);
                        const float mn = fmaxf(m, tm);
                        if (__any(mn > m)) {
                            const float al = __builtin_amdgcn_exp2f((m - mn) * CEXP);
                            l *= al;
#pragma unroll
                            for (int i = 0; i < 8; ++i) O[i] = O[i] * al;
                        }
                        m = mn;
                        const float mc = -mn * CEXP;
                        float ls = 0.f;
#pragma unroll
                        for (int r = 0; r < 16; ++r) { p[r] = __builtin_amdgcn_exp2f(__builtin_fmaf(p[r], CEXP, mc)); ls += p[r]; }
                        l += ls;
                        v4u pw0, pw1;
                        pw0.x = pk2(p[0], p[1]); pw0.y = pk2(p[2], p[3]); pw0.z = pk2(p[4], p[5]); pw0.w = pk2(p[6], p[7]);
                        pw1.x = pk2(p[8], p[9]); pw1.y = pk2(p[10], p[11]); pw1.z = pk2(p[12], p[13]); pw1.w = pk2(p[14], p[15]);
                        const bf16x8 pf0 = __builtin_bit_cast(bf16x8, pw0), pf1 = __builtin_bit_cast(bf16x8, pw1);
#pragma unroll
                        for (int s2 = 0; s2 < 2; ++s2) {
#pragma unroll
                            for (int blk = 0; blk < 8; ++blk) {
                                LAS unsigned char* vp = st + vbase + blk * 4096 + (32 * kh + 16 * s2) * 64;
                                const v4i16_t lo = vtr(vp), hi4 = vtr(vp + 8 * 64);
                                const bf16x8 vf = (bf16x8){lo[0], lo[1], lo[2], lo[3], hi4[0], hi4[1], hi4[2], hi4[3]};
                                O[blk] = __builtin_amdgcn_mfma_f32_32x32x16_bf16(vf, s2 == 0 ? pf0 : pf1, O[blk], 0, 0, 0);
                            }
                        }
                    }
                }
            }
#undef ATT_ISSUE
            const float ltot = swap_sum(l);
            float lam = 1.0f;
            if (map == 1) { const float* lq1 = F.in[I_LQ1]; const float* lk1 = F.in[I_LK1]; const float* lq2 = F.in[I_LQ2]; const float* lk2 = F.in[I_LK2];
                float l1 = lq1[lane] * lk1[lane] + lq1[lane + 64] * lk1[lane + 64], l2 = lq2[lane] * lk2[lane] + lq2[lane + 64] * lk2[lane + 64];
                l1 = wave_sum(l1); l2 = wave_sum(l2); lam = __expf(l1) - __expf(l2) + LAMBDA_INIT; }
            const float inv = lam / ltot;
            LDS_WAIT(); __syncthreads();
            LAS float* X = (LAS float*)(lds + sb * 32768);
            if (map == 1) {
#pragma unroll
                for (int blk = 0; blk < 8; ++blk)
#pragma unroll
                    for (int r = 0; r < 16; ++r) X[(32 * blk + crow(r, hi)) * 32 + r32] = O[blk][r] * inv;
            }
            LDS_WAIT(); __syncthreads();
            if (map == 0) {
                float ss = 0.f;
#pragma unroll
                for (int blk = 0; blk < 8; ++blk)
#pragma unroll
                    for (int r = 0; r < 16; ++r) { const float o = O[blk][r] * inv - X[(32 * blk + crow(r, hi)) * 32 + r32]; O[blk][r] = o; ss += o * o; }
                ss = swap_sum(ss);
                const float rsv = rsqrtf(ss * (1.0f / 256.0f) + EPS) * (1.0f - LAMBDA_INIT);
                LDS_WAIT();
                LAS unsigned char* T = lds + sb * 32768;
#pragma unroll
                for (int blk = 0; blk < 8; ++blk)
#pragma unroll
                    for (int g4 = 0; g4 < 4; ++g4) {
                        v2u pk; pk.x = pk2(O[blk][4 * g4] * rsv, O[blk][4 * g4 + 1] * rsv); pk.y = pk2(O[blk][4 * g4 + 2] * rsv, O[blk][4 * g4 + 3] * rsv);
                        *(LAS v2u*)(T + r32 * 528 + (32 * blk + 8 * g4 + 4 * hi) * 2) = pk;
                    }
                LDS_WAIT();
                const int ch = lane & 31;
                const float* subw = F.in[I_SUBW];
                const f32x4 sw0 = *(const f32x4*)(subw + ch * 8), sw1 = *(const f32x4*)(subw + ch * 8 + 4);
#pragma unroll 4
                for (int it = 0; it < 16; ++it) {
                    const int row = it * 2 + (lane >> 5);
                    const size_t grow = (size_t)b * S + q0 + 32 * sb + row;
                    const v4u ov = *(const LAS v4u*)(T + row * 528 + ch * 16);
                    const v4u gv = *(const v4u*)(qkvg + grow * ODD_IN + 12288 + h * 256 + ch * 8);
                    float o8[8], g8[8];
                    o8[0] = __uint_as_float(ov.x << 16); o8[1] = __uint_as_float(ov.x & 0xffff0000u); o8[2] = __uint_as_float(ov.y << 16); o8[3] = __uint_as_float(ov.y & 0xffff0000u);
                    o8[4] = __uint_as_float(ov.z << 16); o8[5] = __uint_as_float(ov.z & 0xffff0000u); o8[6] = __uint_as_float(ov.w << 16); o8[7] = __uint_as_float(ov.w & 0xffff0000u);
                    g8[0] = __uint_as_float(gv.x << 16); g8[1] = __uint_as_float(gv.x & 0xffff0000u); g8[2] = __uint_as_float(gv.y << 16); g8[3] = __uint_as_float(gv.y & 0xffff0000u);
                    g8[4] = __uint_as_float(gv.z << 16); g8[5] = __uint_as_float(gv.z & 0xffff0000u); g8[6] = __uint_as_float(gv.w << 16); g8[7] = __uint_as_float(gv.w & 0xffff0000u);
                    v4u res;
                    res.x = pk2(o8[0] * sw0[0] * siluf_(g8[0]), o8[1] * sw0[1] * siluf_(g8[1]));
                    res.y = pk2(o8[2] * sw0[2] * siluf_(g8[2]), o8[3] * sw0[3] * siluf_(g8[3]));
                    res.z = pk2(o8[4] * sw1[0] * siluf_(g8[4]), o8[5] * sw1[1] * siluf_(g8[5]));
                    res.w = pk2(o8[6] * sw1[2] * siluf_(g8[6]), o8[7] * sw1[3] * siluf_(g8[7]));
                    *(v4u*)(F.ocat + grow * MIXW + h * 256 + ch * 8) = res;
                }
            }
            LDS_WAIT(); __syncthreads();
        }
    }
}


__device__ __forceinline__ float gelu_fast(float v) { const float z = 0.7978845608028654f * (v + 0.044715f * v * v * v); return v * __builtin_amdgcn_rcpf(1.0f + __expf(-2.0f * z)); }
__device__ __forceinline__ float silu_fast(float v) { return v * __builtin_amdgcn_rcpf(1.0f + __expf(-v)); }
__device__ __forceinline__ void unpack8(const v4u r, float (&f)[8]) {
    f[0] = __uint_as_float(r.x << 16); f[1] = __uint_as_float(r.x & 0xffff0000u); f[2] = __uint_as_float(r.y << 16); f[3] = __uint_as_float(r.y & 0xffff0000u);
    f[4] = __uint_as_float(r.z << 16); f[5] = __uint_as_float(r.z & 0xffff0000u); f[6] = __uint_as_float(r.w << 16); f[7] = __uint_as_float(r.w & 0xffff0000u);
}
__device__ __forceinline__ void sgu_stats_phase(Frame& F, float* mu, float* rs) {
    const int gw = (int)blockIdx.x * NWAVES + F.wave, NGW = F.G * NWAVES, lane = F.lane;
    for (int row = gw; row < M; row += NGW) {
        const v4u* vp = (const v4u*)(F.proj0 + (size_t)row * N1 + C_V) + lane;
        float g[32]; float sm = 0.f;
#pragma unroll
        for (int i = 0; i < 4; ++i) { float f[8]; unpack8(vp[64 * i], f);
#pragma unroll
            for (int j = 0; j < 8; ++j) { g[8 * i + j] = gelu_fast(f[j]); sm += g[8 * i + j]; } }
        const float mean = wave_sum(sm) * (1.0f / 2048.0f);
        float q = 0.f;
#pragma unroll
        for (int i = 0; i < 32; ++i) { const float d = g[i] - mean; q += d * d; }
        const float var = wave_sum(q) * (1.0f / 2048.0f);
        if (lane == 0) { mu[row] = mean; rs[row] = rsqrtf(var + EPS); }
    }
}
__device__ __forceinline__ void sgu_phase(Frame& F, const float* mu, const float* rs) {
    const int tid = F.tid, lane = F.lane, w = F.wave, r32 = lane & 31, hi = lane >> 5;
    LAS unsigned char* lds = F.lds;
    LAS unsigned char* VIMG = lds;
    LAS float* MT = (LAS float*)(lds + 32768);
    const bf16* proj0 = F.proj0; const float* ln_w = F.in[I_LNW]; const float* ln_b = F.in[I_LNB]; const float* wsg = F.in[I_SGUWS]; const float* sb = F.in[I_SGUB];
    const int ck = tid & 15;
    for (int item = (int)blockIdx.x; item < 64 * 16; item += F.G) {
        const int g = item & 15, row0 = (item >> 4) * 128;
        const int chb = g * 128 + ck * 8;
        v4u ur[4], zr[4];
        { float lw[8], lb[8];
#pragma unroll
          for (int j = 0; j < 8; ++j) { lw[j] = ln_w[chb + j]; lb[j] = ln_b[chb + j]; }
#pragma unroll
          for (int i = 0; i < 4; ++i) {
              const int s = (tid >> 4) + 32 * i; const size_t ro = (size_t)(row0 + s) * N1;
              const v4u vr = *(const v4u*)(proj0 + ro + C_V + chb);
              ur[i] = *(const v4u*)(proj0 + ro + C_U + chb); zr[i] = *(const v4u*)(proj0 + ro + C_ZB + chb);
              const float m_ = mu[row0 + s], r_ = rs[row0 + s];
              float f[8]; unpack8(vr, f);
#pragma unroll
              for (int j = 0; j < 8; ++j) f[j] = (gelu_fast(f[j]) - m_) * r_ * lw[j] + lb[j];
              v4u o; o.x = pk2(f[0], f[1]); o.y = pk2(f[2], f[3]); o.z = pk2(f[4], f[5]); o.w = pk2(f[6], f[7]);
              *(LAS v4u*)(VIMG + (ck >> 2) * 8192 + s * 64 + (ck & 3) * 16) = o;
          } }
        LDS_WAIT(); __syncthreads();
        { const int tb = w >> 1, cb0 = 2 * (w & 1), t = 32 * tb + r32;
          f32x16 acc0 = {}, acc1 = {};
          const float* wrow = wsg + ((size_t)g * 128 + t) * 128 + 8 * hi;
          LAS unsigned char* vb = VIMG + cb0 * 8192 + (8 * hi + ((lane & 15) >> 2)) * 64 + 32 * ((lane >> 4) & 1) + 8 * (lane & 3);
          for (int ks = 0; ks < 2 * tb + 2; ++ks) {
              const f32x4 w0 = *(const f32x4*)(wrow + 16 * ks), w1 = *(const f32x4*)(wrow + 16 * ks + 4);
              const int s0 = 16 * ks + 8 * hi;
              float wv[8] = {w0[0], w0[1], w0[2], w0[3], w1[0], w1[1], w1[2], w1[3]};
#pragma unroll
              for (int j = 0; j < 8; ++j) wv[j] = (s0 + j <= t) ? wv[j] : 0.f;
              v4u aw; aw.x = pk2(wv[0], wv[1]); aw.y = pk2(wv[2], wv[3]); aw.z = pk2(wv[4], wv[5]); aw.w = pk2(wv[6], wv[7]);
              const bf16x8 af = __builtin_bit_cast(bf16x8, aw);
              LAS unsigned char* vp = vb + ks * 16 * 64;
              const att::v4i16_t b0l = att::vtr(vp), b0h = att::vtr(vp + 4 * 64), b1l = att::vtr(vp + 8192), b1h = att::vtr(vp + 8192 + 4 * 64);
              const bf16x8 bf0 = (bf16x8){b0l[0], b0l[1], b0l[2], b0l[3], b0h[0], b0h[1], b0h[2], b0h[3]};
              const bf16x8 bf1 = (bf16x8){b1l[0], b1l[1], b1l[2], b1l[3], b1h[0], b1h[1], b1h[2], b1h[3]};
              acc0 = __builtin_amdgcn_mfma_f32_32x32x16_bf16(af, bf0, acc0, 0, 0, 0);
              acc1 = __builtin_amdgcn_mfma_f32_32x32x16_bf16(af, bf1, acc1, 0, 0, 0);
          }
          const float* bp = sb + g * 128 + 32 * tb + 4 * hi;
#pragma unroll
          for (int q4 = 0; q4 < 4; ++q4) { const f32x4 bv = *(const f32x4*)(bp + 8 * q4);
#pragma unroll
              for (int i = 0; i < 4; ++i) { const int r = 4 * q4 + i, tt = 32 * tb + att::crow(r, hi);
                  MT[tt * 132 + 32 * cb0 + r32] = acc0[r] + bv[i]; MT[tt * 132 + 32 * cb0 + 32 + r32] = acc1[r] + bv[i]; } }
        }
        LDS_WAIT(); __syncthreads();
#pragma unroll
        for (int i = 0; i < 4; ++i) {
            const int t = (tid >> 4) + 32 * i;
            const f32x4 m0 = *(const LAS f32x4*)(MT + t * 132 + ck * 8), m1 = *(const LAS f32x4*)(MT + t * 132 + ck * 8 + 4);
            float u[8], z[8]; unpack8(ur[i], u); unpack8(zr[i], z);
            const float mm[8] = {m0[0], m0[1], m0[2], m0[3], m1[0], m1[1], m1[2], m1[3]};
            float y[8];
#pragma unroll
            for (int j = 0; j < 8; ++j) y[j] = gelu_fast(u[j]) * mm[j] * silu_fast(z[j]);
            v4u o; o.x = pk2(y[0], y[1]); o.y = pk2(y[2], y[3]); o.z = pk2(y[4], y[5]); o.w = pk2(y[6], y[7]);
            *(v4u*)(F.ycat + (size_t)(row0 + t) * MIXW + 2048 + chb) = o;
        }
    }
    LDS_WAIT(); __syncthreads();
}


namespace ssd {
constexpr int XIMG = 0, BIMG = 65536, CIMG = 98304, CSOFF = 135168, DTOFF = CSOFF + 2048, YT = 65536, YT_PITCH = 528;
__device__ __forceinline__ void dt_scan(Frame& F, int row0, int g) {
    if (F.wave < 4) {
        const int hl = F.wave, hg = 4 * g + hl, lane = F.lane, t0 = 2 * lane;
        LAS float* CS = (LAS float*)(F.lds + CSOFF) + hl * 128; LAS float* DTS = (LAS float*)(F.lds + DTOFF) + hl * 128;
        const float a = -__expf(F.in[I_ALOG][hg]);
        const float d0 = F.dt[(size_t)(row0 + t0) * 32 + hg], d1 = F.dt[(size_t)(row0 + t0 + 1) * 32 + hg];
        const float x0 = d0 * a, x1 = d1 * a; float sc = x0 + x1;
#pragma unroll
        for (int o = 1; o < 64; o <<= 1) { const float v = __shfl_up(sc, o); if (lane >= o) sc += v; }
        CS[t0] = sc - x1; CS[t0 + 1] = sc; DTS[t0] = d0; DTS[t0 + 1] = d1;
    }
}
template <bool WITH_C, class Sink>
__device__ __forceinline__ void conv_tile(Frame& F, int row0, int g, bool has_halo, const Sink& sink) {
    const int chunk = F.lane, seg = F.wave;
    if (!WITH_C && chunk >= 48) return;
    const int ch = chunk < 32 ? g * 256 + chunk * 8 : (chunk < 48 ? 2048 + g * 128 + (chunk - 32) * 8 : 3072 + g * 128 + (chunk - 48) * 8);
    const float* cw = F.in[I_CONVW] + ch; const float* cb = F.in[I_CONVB] + ch;
    float w0[8], w1[8], w2[8], w3[8], bs[8];
#pragma unroll
    for (int j = 0; j < 8; ++j) { w0[j] = cw[j]; w1[j] = cw[XBC_W + j]; w2[j] = cw[2 * XBC_W + j]; w3[j] = cw[3 * XBC_W + j]; bs[j] = cb[j]; }
    const bf16* src = F.proj0 + (size_t)row0 * N1 + C_XBC + ch;
    const int t0 = 16 * seg;
    float r0[8], r1[8], r2[8];
    if (t0 > 0 || has_halo) { unpack8(*(const v4u*)(src + (ptrdiff_t)(t0 - 3) * N1), r0); unpack8(*(const v4u*)(src + (ptrdiff_t)(t0 - 2) * N1), r1); unpack8(*(const v4u*)(src + (ptrdiff_t)(t0 - 1) * N1), r2); }
    else {
#pragma unroll
        for (int j = 0; j < 8; ++j) { r0[j] = 0.f; r1[j] = 0.f; r2[j] = 0.f; } }
#pragma unroll
    for (int hb = 0; hb < 2; ++hb) {
        v4u raw[8];
#pragma unroll
        for (int i = 0; i < 8; ++i) raw[i] = *(const v4u*)(src + (size_t)(t0 + 8 * hb + i) * N1);
#pragma unroll
        for (int i = 0; i < 8; ++i) {
            float cur[8], o[8]; unpack8(raw[i], cur);
#pragma unroll
            for (int j = 0; j < 8; ++j) { const float a = bs[j] + w0[j] * r0[j] + w1[j] * r1[j] + w2[j] * r2[j] + w3[j] * cur[j]; o[j] = silu_fast(a); r0[j] = r1[j]; r1[j] = r2[j]; r2[j] = cur[j]; }
            sink(t0 + 8 * hb + i, 8 * hb + i, chunk, o);
        }
        asm volatile("" ::: "memory");
    }
}
}
__device__ __forceinline__ void ssd_phase_a(Frame& F, float* states, float* cdec) {
    using namespace ssd;
    const int lane = F.lane, w = F.wave, r32 = lane & 31, hi = lane >> 5;
    LAS unsigned char* lds = F.lds;
    for (int item = (int)blockIdx.x; item < NB * 16 * 8; item += F.G) {
        const int g = item & 7, c = (item >> 3) & 15, b = item >> 7, row0 = b * S + c * 128;
        dt_scan(F, row0, g);
        LDS_WAIT(); __syncthreads();
        { LAS float* CS = (LAS float*)(lds + CSOFF); LAS float* DTS = (LAS float*)(lds + DTOFF);
          if (F.tid < 4) cdec[(b * 16 + c) * 32 + 4 * g + F.tid] = __expf(CS[F.tid * 128 + 127]);
          const bool isx = lane < 32; const int hl = isx ? (lane >> 3) : 0;
          const int abase = isx ? (XIMG + (lane >> 2) * 8192 + (lane & 3) * 16) : (BIMG + ((lane - 32) >> 2) * 8192 + ((lane - 32) & 3) * 16);
          const float csend = CS[hl * 128 + 127];
          conv_tile<false>(F, row0, g, c > 0, [&](int t, int t15, int chunk, float (&o)[8]) {
              const float wt = isx ? DTS[hl * 128 + t] * __expf(csend - CS[hl * 128 + t]) : 1.0f;
              v4u pk; pk.x = pk2(o[0] * wt, o[1] * wt); pk.y = pk2(o[2] * wt, o[3] * wt); pk.z = pk2(o[4] * wt, o[5] * wt); pk.w = pk2(o[6] * wt, o[7] * wt);
              *(LAS v4u*)(lds + abase + t * 64) = pk; }); }
        LDS_WAIT(); __syncthreads();
        { f32x16 acc[4];
#pragma unroll
          for (int i = 0; i < 4; ++i) acc[i] = (f32x16){};
          LAS unsigned char* ab = lds + XIMG + w * 8192 + (8 * hi + ((lane & 15) >> 2)) * 64 + 32 * ((lane >> 4) & 1) + 8 * (lane & 3);
          LAS unsigned char* bb = lds + BIMG + (8 * hi + ((lane & 15) >> 2)) * 64 + 32 * ((lane >> 4) & 1) + 8 * (lane & 3);
#pragma unroll 2
          for (int ks = 0; ks < 8; ++ks) {
              const att::v4i16_t al = att::vtr(ab + ks * 1024), ah = att::vtr(ab + ks * 1024 + 256);
              const bf16x8 af = (bf16x8){al[0], al[1], al[2], al[3], ah[0], ah[1], ah[2], ah[3]};
#pragma unroll
              for (int nb = 0; nb < 4; ++nb) {
                  const att::v4i16_t bl = att::vtr(bb + nb * 8192 + ks * 1024), bh = att::vtr(bb + nb * 8192 + ks * 1024 + 256);
                  const bf16x8 bfr = (bf16x8){bl[0], bl[1], bl[2], bl[3], bh[0], bh[1], bh[2], bh[3]};
                  acc[nb] = __builtin_amdgcn_mfma_f32_32x32x16_bf16(af, bfr, acc[nb], 0, 0, 0);
              }
          }
          float* sp = states + ((size_t)((b * 16 + c) * 32 + 4 * g + (w >> 1)) * 64 + 32 * (w & 1)) * 128;
#pragma unroll
          for (int nb = 0; nb < 4; ++nb)
#pragma unroll
              for (int r = 0; r < 16; ++r) sp[att::crow(r, hi) * 128 + 32 * nb + r32] = acc[nb][r];
        }
        LDS_WAIT(); __syncthreads();
    }
}
__device__ __forceinline__ void ssd_phase_b(Frame& F, const float* states, const float* cdec, bf16* prev) {
    for (int gid = (int)blockIdx.x * (NWAVES * 64) + F.tid; gid < NB * 32 * 64 * 16; gid += F.G * NWAVES * 64) {
        const int nck = gid & 15, p = (gid >> 4) & 63, hg = (gid >> 10) & 31, b = gid >> 15;
        f32x4 h0 = {0.f, 0.f, 0.f, 0.f}, h1 = {0.f, 0.f, 0.f, 0.f};
#pragma unroll 5
        for (int c = 0; c < 15; ++c) {
            const size_t off = ((size_t)((b * 16 + c) * 32 + hg) * 64 + p) * 128 + nck * 8;
            const f32x4 s0 = *(const f32x4*)(states + off), s1 = *(const f32x4*)(states + off + 4);
            const float cd = cdec[(b * 16 + c) * 32 + hg];
            h0 = h0 * cd + s0; h1 = h1 * cd + s1;
            v4u pk; pk.x = pk2(h0[0], h0[1]); pk.y = pk2(h0[2], h0[3]); pk.z = pk2(h1[0], h1[1]); pk.w = pk2(h1[2], h1[3]);
            *(v4u*)(prev + off + (size_t)32 * 64 * 128) = pk;
        }
    }
}
__device__ __forceinline__ void ssd_phase_c(Frame& F, const bf16* prev) {
    using namespace ssd;
    const int lane = F.lane, w = F.wave, tid = F.tid, r32 = lane & 31, hi = lane >> 5;
    LAS unsigned char* lds = F.lds;
    const float* dsk = F.in[I_DSKIP]; const float* nw = F.in[I_SSDNW];
    for (int item = (int)blockIdx.x; item < NB * 16 * 8; item += F.G) {
        const int g = item & 7, c = (item >> 3) & 15, b = item >> 7, row0 = b * S + c * 128;
        dt_scan(F, row0, g);
        { const bool isx = lane < 32; const int cc = (lane - 32) & 15;
          const int xbase = XIMG + (lane >> 2) * 8192 + (lane & 3) * 16, bcbase = lane < 48 ? BIMG : CIMG;
          conv_tile<true>(F, row0, g, c > 0, [&](int t, int t15, int chunk, float (&o)[8]) {
              v4u pk; pk.x = pk2(o[0], o[1]); pk.y = pk2(o[2], o[3]); pk.z = pk2(o[4], o[5]); pk.w = pk2(o[6], o[7]);
              const int addr = isx ? (xbase + t * 64) : (bcbase + t * 256 + ((cc ^ t15) << 4));
              *(LAS v4u*)(lds + addr) = pk; }); }
        LDS_WAIT(); __syncthreads();
        {
            const int lb = w & 3, hp = w >> 2, l = 32 * lb + r32;
            LAS float* CS = (LAS float*)(lds + CSOFF); LAS float* DTS = (LAS float*)(lds + DTOFF);
            f32x16 acc[2][2];
#pragma unroll
            for (int j = 0; j < 2; ++j)
#pragma unroll
                for (int pb = 0; pb < 2; ++pb) acc[j][pb] = (f32x16){};
            bf16x8 cf[8];
#pragma unroll
            for (int ks = 0; ks < 8; ++ks) cf[ks] = *(const LAS bf16x8*)(lds + CIMG + l * 256 + (((2 * ks + hi) ^ (l & 15)) << 4));
            float csl[2];
#pragma unroll
            for (int j = 0; j < 2; ++j) csl[j] = CS[(2 * hp + j) * 128 + l];
            if (c > 0) {
#pragma unroll
                for (int j = 0; j < 2; ++j) {
                    const bf16* pp = prev + ((size_t)((b * 16 + c) * 32 + 4 * g + 2 * hp + j) * 64 + r32) * 128 + 8 * hi;
#pragma unroll
                    for (int pb = 0; pb < 2; ++pb) {
#pragma unroll
                        for (int ks = 0; ks < 8; ++ks) {
                            const bf16x8 pf = *(const bf16x8*)(pp + (size_t)pb * 32 * 128 + 16 * ks);
                            acc[j][pb] = __builtin_amdgcn_mfma_f32_32x32x16_bf16(pf, cf[ks], acc[j][pb], 0, 0, 0);
                        }
                    }
                    const float e = __expf(csl[j]);
                    acc[j][0] = acc[j][0] * e; acc[j][1] = acc[j][1] * e;
                }
            }
            LAS unsigned char* xb0 = lds + XIMG + (4 * hi + ((lane & 15) >> 2)) * 64 + 32 * ((lane >> 4) & 1) + 8 * (lane & 3);
            for (int sbk = 0; sbk <= lb; ++sbk) {
                f32x16 X = (f32x16){};
                const int srow = 32 * sbk + r32;
#pragma unroll
                for (int ks = 0; ks < 8; ++ks) {
                    const bf16x8 bfr = *(const LAS bf16x8*)(lds + BIMG + srow * 256 + (((2 * ks + hi) ^ (srow & 15)) << 4));
                    X = __builtin_amdgcn_mfma_f32_32x32x16_bf16(bfr, cf[ks], X, 0, 0, 0);
                }
#pragma unroll
                for (int j = 0; j < 2; ++j) {
                    const int hl = 2 * hp + j;
                    float xh[16];
#pragma unroll
                    for (int q4 = 0; q4 < 4; ++q4) {
                        const f32x4 cs4 = *(const LAS f32x4*)(CS + hl * 128 + 32 * sbk + 8 * q4 + 4 * hi), dt4 = *(const LAS f32x4*)(DTS + hl * 128 + 32 * sbk + 8 * q4 + 4 * hi);
#pragma unroll
                        for (int i = 0; i < 4; ++i) { const int r = 4 * q4 + i, s_ = 32 * sbk + 8 * q4 + 4 * hi + i;
                            const float v = X[r] * __expf(csl[j] - cs4[i]) * dt4[i]; xh[r] = (s_ <= l) ? v : 0.f; }
                    }
                    v4u p0, p1;
                    p0.x = pk2(xh[0], xh[1]); p0.y = pk2(xh[2], xh[3]); p0.z = pk2(xh[4], xh[5]); p0.w = pk2(xh[6], xh[7]);
                    p1.x = pk2(xh[8], xh[9]); p1.y = pk2(xh[10], xh[11]); p1.z = pk2(xh[12], xh[13]); p1.w = pk2(xh[14], xh[15]);
                    const bf16x8 pf0 = __builtin_bit_cast(bf16x8, p0), pf1 = __builtin_bit_cast(bf16x8, p1);
#pragma unroll
                    for (int s2 = 0; s2 < 2; ++s2)
#pragma unroll
                        for (int pb = 0; pb < 2; ++pb) {
                            LAS unsigned char* xp = xb0 + (2 * hl + pb) * 8192 + (32 * sbk + 16 * s2) * 64;
                            const att::v4i16_t lo = att::vtr(xp), hi4 = att::vtr(xp + 8 * 64);
                            const bf16x8 xf = (bf16x8){lo[0], lo[1], lo[2], lo[3], hi4[0], hi4[1], hi4[2], hi4[3]};
                            acc[j][pb] = __builtin_amdgcn_mfma_f32_32x32x16_bf16(xf, s2 == 0 ? pf0 : pf1, acc[j][pb], 0, 0, 0);
                        }
                }
            }
            LDS_WAIT(); __syncthreads();
#pragma unroll
            for (int j = 0; j < 2; ++j)
#pragma unroll
                for (int pb = 0; pb < 2; ++pb)
#pragma unroll
                    for (int q4 = 0; q4 < 4; ++q4) {
                        v2u pk; pk.x = pk2(acc[j][pb][4 * q4], acc[j][pb][4 * q4 + 1]); pk.y = pk2(acc[j][pb][4 * q4 + 2], acc[j][pb][4 * q4 + 3]);
                        *(LAS v2u*)(lds + YT + l * YT_PITCH + ((2 * hp + j) * 64 + 32 * pb + 8 * q4 + 4 * hi) * 2) = pk;
                    }
        }
        LDS_WAIT(); __syncthreads();
        {
            const int ckk = tid & 31, chg = g * 256 + ckk * 8;
            const float Dk = dsk[4 * g + (ckk >> 3)];
            float nwv[8];
#pragma unroll
            for (int j = 0; j < 8; ++j) nwv[j] = nw[chg + j];
#pragma unroll 2
            for (int i = 0; i < 8; ++i) {
                const int t = (tid >> 5) + 16 * i;
                const v4u yr = *(const LAS v4u*)(lds + YT + t * YT_PITCH + ckk * 16);
                const v4u xr = *(const LAS v4u*)(lds + XIMG + (ckk >> 2) * 8192 + t * 64 + (ckk & 3) * 16);
                const v4u zr = *(const v4u*)(F.proj0 + (size_t)(row0 + t) * N1 + C_ZA + chg);
                float y[8], x[8], z[8]; unpack8(yr, y); unpack8(xr, x); unpack8(zr, z);
                float v[8]; float ss = 0.f;
#pragma unroll
                for (int j = 0; j < 8; ++j) { v[j] = (y[j] + Dk * x[j]) * silu_fast(z[j]); ss += v[j] * v[j]; }
#pragma unroll
                for (int o = 1; o < 32; o <<= 1) ss += __shfl_xor(ss, o);
                const float rsv = rsqrtf(ss * (1.0f / 256.0f) + EPS);
                v4u o; o.x = pk2(v[0] * rsv * nwv[0], v[1] * rsv * nwv[1]); o.y = pk2(v[2] * rsv * nwv[2], v[3] * rsv * nwv[3]);
                o.z = pk2(v[4] * rsv * nwv[4], v[5] * rsv * nwv[5]); o.w = pk2(v[6] * rsv * nwv[6], v[7] * rsv * nwv[7]);
                *(v4u*)(F.ycat + (size_t)(row0 + t) * MIXW + chg) = o;
            }
        }
        LDS_WAIT(); __syncthreads();
    }
}

enum Phase { PH_PRO = 0, PH_G1, PH_SSD_A, PH_SSD_B, PH_SSD_C, PH_G2, PH_G3, PH_ATT, PH_G4, PH_FIN, PH_N };
struct Args { const float* in[22]; float* out; unsigned char* ws; int ph_lo, ph_hi, li, pad; };
__global__ void __launch_bounds__(NWAVES * 64, 2) mega(Args args) {
    extern __shared__ __attribute__((aligned(16))) unsigned char lds[];
    Frame F;
    F.lds = (LAS unsigned char*)lds;
    F.MISC = (volatile LAS unsigned*)(F.lds + LDSCTL_OFF);
    F.tid = threadIdx.x; F.lane = F.tid & 63; F.wave = __builtin_amdgcn_readfirstlane(F.tid >> 6); F.G = gridDim.x;
    unsigned char* ws = args.ws;
    F.ctl = (unsigned*)(ws + WS_CTL);
#pragma unroll
    for (int i = 0; i < 22; ++i) F.in[i] = args.in[i];
    F.out = args.out;
    F.Wt_in0 = (bf16*)(ws + WS_WIN0); F.Wt_out0 = (bf16*)(ws + WS_WOUT0); F.Wt_in1 = (bf16*)(ws + WS_WIN1); F.Wt_out1 = (bf16*)(ws + WS_WOUT1);
    F.xb = (bf16*)(ws + WS_XB); F.proj0 = (bf16*)(ws + WS_PROJ0); F.ycat = (bf16*)(ws + WS_YCAT); F.h1b = F.xb; F.qkvg = F.proj0; F.ocat = F.ycat;
    F.dt = (float*)(ws + WS_DT); F.rstd0 = (float*)(ws + WS_RSTD0); F.ssq1 = (float*)(ws + WS_SSQ1); F.ssq2 = (float*)(ws + WS_SSQ2);
    if (F.tid < 64) ((LAS unsigned*)(F.lds + LDSCTL_OFF))[F.tid] = 0u;
    __syncthreads();
    const int lo = args.ph_lo, hi = args.ph_hi;
    XcdBarrier bar; bar.bar = F.ctl + CW_BAR + args.li * XCD_BAR_WORDS; bar.x = 0; bar.st = nullptr;
    if (hi - lo > 1) bar = xcd_barrier_post(F.ctl + CW_BAR + args.li * XCD_BAR_WORDS, F.MISC + 8);
#define IN(k) (lo <= (k) && (k) < hi)
#define SEAM(k) do { if (IN(k) && IN((k) + 1)) xcd_barrier(bar); } while (0)

    if (IN(PH_PRO)) { p0_prologue(F); }
    SEAM(PH_PRO);
    if (IN(PH_G1)) {
        pg8::Gemm g{F.xb, F.Wt_in0, M, N1, D}; pg8::StaticOrder S; S.init(M, N1, F.G, (int)blockIdx.x);
        pg8::EpiRowScaleBf16<1> E{F.proj0, N1, F.rstd0};
        pg8::gemm_phase<pg8::EpiRowScaleBf16<1>, pg8::StaticOrder, true, true>(F.lds, g, S, E);
    }
    SEAM(PH_G1);
    float* ytmp = (float*)(ws + WS_STATES); float* sgu_mu = (float*)(ws + WS_SGU_MU); float* sgu_rs = (float*)(ws + WS_SGU_RS);
    float* states = (float*)(ws + WS_STATES); float* cdec = (float*)(ws + WS_CDEC); bf16* prevb = (bf16*)(ws + WS_XB);
    if (IN(PH_SSD_A)) { ssd_phase_a(F, states, cdec); sgu_stats_phase(F, sgu_mu, sgu_rs); }
    SEAM(PH_SSD_A);
    if (IN(PH_SSD_B)) { ssd_phase_b(F, states, cdec, prevb); sgu_phase(F, sgu_mu, sgu_rs); }
    SEAM(PH_SSD_B);
    if (IN(PH_SSD_C)) { ssd_phase_c(F, prevb); }
    SEAM(PH_SSD_C);
    if (IN(PH_G2)) {
        pg8::Gemm g{F.ycat, F.Wt_out0, M, D, MIXW}; pg8::StaticOrder S; S.init(M, D, F.G, (int)blockIdx.x);
        pg8::EpiResid<true> E{F.in[I_X], F.out, F.h1b, F.ssq1, D};
        pg8::gemm_phase<pg8::EpiResid<true>, pg8::StaticOrder, false, true>(F.lds, g, S, E);
    }
    SEAM(PH_G2);
    if (IN(PH_G3)) {
        pg8::Gemm g{F.h1b, F.Wt_in1, M, ODD_IN, D}; pg8::StaticOrder S; S.init(M, ODD_IN, F.G, (int)blockIdx.x);
        pg8::EpiRowScaleBf16<8> E{F.qkvg, ODD_IN, F.ssq1};
        pg8::gemm_phase<pg8::EpiRowScaleBf16<8>, pg8::StaticOrder, true, true>(F.lds, g, S, E);
    }
    SEAM(PH_G3);
    if (IN(PH_ATT)) { attn_phase(F); }
    SEAM(PH_ATT);
    if (IN(PH_G4)) {
        pg8::Gemm g{F.ocat, F.Wt_out1, M, D, MIXW}; pg8::StaticOrder S; S.init(M, D, F.G, (int)blockIdx.x);
        pg8::EpiResid<false> E{F.out, F.out, nullptr, F.ssq2, D};
        pg8::gemm_phase<pg8::EpiResid<false>, pg8::StaticOrder, false, true>(F.lds, g, S, E);
    }
    SEAM(PH_G4);
    if (IN(PH_FIN)) { final_norm(F); }
#undef IN
#undef SEAM
}

__device__ __forceinline__ float block_sum256(float v, float* red) {
    v = wave_sum(v);
    __syncthreads();
    if ((threadIdx.x & 63) == 0) red[threadIdx.x >> 6] = v;
    __syncthreads();
    return red[0] + red[1] + red[2] + red[3];
}
__global__ __launch_bounds__(256) void k_ssd_naive(const bf16* __restrict__ proj0, const float* __restrict__ conv_w, const float* __restrict__ conv_b,
                                                  const float* __restrict__ dt, const float* __restrict__ a_log, const float* __restrict__ d_skip, float* y) {
    constexpr int TB = 32;
    __shared__ float xs_s[TB][64];
    __shared__ float B_s[TB][128];
    __shared__ float C_s[TB][128];
    __shared__ float dt_s[TB];
    const int b = blockIdx.y, hd = blockIdx.x, g = hd >> 2, tid = threadIdx.x;
    const int p = tid >> 2, nq = tid & 3;
    const float a = -__expf(a_log[hd]), Dk = d_skip[hd];
    float h[32];
#pragma unroll
    for (int i = 0; i < 32; ++i) h[i] = 0.f;
    for (int t0 = 0; t0 < S; t0 += TB) {
        for (int idx = tid; idx < TB * 320; idx += 256) {
            const int tt = idx / 320, cc = idx % 320;
            const int ch = cc < 64 ? hd * 64 + cc : (cc < 192 ? 2048 + g * 128 + (cc - 64) : 3072 + g * 128 + (cc - 192));
            const int t = t0 + tt;
            float acc = conv_b[ch];
#pragma unroll
            for (int k = 0; k < 4; ++k) { const int ts = t - 3 + k; if (ts >= 0) acc += conv_w[k * XBC_W + ch] * bf2f(proj0[(size_t)(b * S + ts) * N1 + C_XBC + ch]); }
            const float v = siluf_(acc);
            if (cc < 64) xs_s[tt][cc] = v; else if (cc < 192) B_s[tt][cc - 64] = v; else C_s[tt][cc - 192] = v;
        }
        if (tid < TB) dt_s[tid] = dt[(size_t)(b * S + t0 + tid) * 32 + hd];
        __syncthreads();
        for (int tt = 0; tt < TB; ++tt) {
            const float dtv = dt_s[tt], dA = __expf(dtv * a), xv = xs_s[tt][p], xd = dtv * xv;
            float acc = 0.f;
#pragma unroll
            for (int i = 0; i < 32; ++i) { const int n = i * 4 + nq; h[i] = h[i] * dA + xd * B_s[tt][n]; acc += C_s[tt][n] * h[i]; }
            acc += __shfl_xor(acc, 1); acc += __shfl_xor(acc, 2);
            if (nq == 0) y[(size_t)(b * S + t0 + tt) * 2048 + hd * 64 + p] = acc + Dk * xv;
        }
        __syncthreads();
    }
}
__global__ __launch_bounds__(256) void k_ssd_gate(const float* __restrict__ y, const bf16* __restrict__ proj0, const float* __restrict__ nw, bf16* ycat) {
    const int r = blockIdx.x, t = threadIdx.x;
    float v[8]; float ss = 0.f;
#pragma unroll
    for (int i = 0; i < 8; ++i) { const int ch = t * 8 + i; const float z = bf2f(proj0[(size_t)r * N1 + C_ZA + ch]); v[i] = y[(size_t)r * 2048 + ch] * siluf_(z); ss += v[i] * v[i]; }
#pragma unroll
    for (int o = 1; o < 32; o <<= 1) ss += __shfl_xor(ss, o);
    const float rs = rsqrtf(ss / 256.f + EPS);
#pragma unroll
    for (int i = 0; i < 8; ++i) { const int ch = t * 8 + i; ycat[(size_t)r * MIXW + ch] = f2bf(v[i] * rs * nw[ch]); }
}
__global__ __launch_bounds__(256) void k_sgu_stats(const bf16* __restrict__ proj0, float* mu, float* rs) {
    __shared__ float red[4];
    const int r = blockIdx.x, t = threadIdx.x;
    float v[8]; float s = 0.f;
#pragma unroll
    for (int i = 0; i < 8; ++i) { v[i] = geluf_(bf2f(proj0[(size_t)r * N1 + C_V + t + 256 * i])); s += v[i]; }
    const float mean = block_sum256(s, red) / 2048.f;
    float q = 0.f;
#pragma unroll
    for (int i = 0; i < 8; ++i) { const float d = v[i] - mean; q += d * d; }
    const float var = block_sum256(q, red) / 2048.f;
    if (t == 0) { mu[r] = mean; rs[r] = rsqrtf(var + EPS); }
}
__global__ __launch_bounds__(256) void k_sgu_naive(const bf16* __restrict__ proj0, const float* __restrict__ mu, const float* __restrict__ rs,
                                                  const float* __restrict__ ln_w, const float* __restrict__ ln_b, const float* __restrict__ ws,
                                                  const float* __restrict__ sb, bf16* ycat) {
    __shared__ float vln[128][64];
    const int g = blockIdx.x >> 1, half = blockIdx.x & 1, bn = blockIdx.y, tid = threadIdx.x;
    const int row0 = bn * 128;
    for (int idx = tid; idx < 128 * 64; idx += 256) {
        const int s = idx >> 6, c = idx & 63, ch = g * 128 + half * 64 + c, r = row0 + s;
        const float gv = geluf_(bf2f(proj0[(size_t)r * N1 + C_V + ch]));
        vln[s][c] = (gv - mu[r]) * rs[r] * ln_w[ch] + ln_b[ch];
    }
    __syncthreads();
    const int c = tid & 63, tq = tid >> 6, ch = g * 128 + half * 64 + c;
    for (int t = tq; t < 128; t += 4) {
        const float* wr = ws + ((size_t)g * 128 + t) * 128;
        float acc = 0.f;
        for (int s = 0; s <= t; ++s) acc += wr[s] * vln[s][c];
        acc += sb[g * 128 + t];
        const int r = row0 + t;
        const float u = geluf_(bf2f(proj0[(size_t)r * N1 + C_U + ch])), zb = bf2f(proj0[(size_t)r * N1 + C_ZB + ch]);
        ycat[(size_t)r * MIXW + 2048 + ch] = f2bf(u * acc * siluf_(zb));
    }
}
__global__ __launch_bounds__(128) void k_attn_naive(const bf16* __restrict__ qkvg, const float* __restrict__ lq1, const float* __restrict__ lk1,
                                                   const float* __restrict__ lq2, const float* __restrict__ lk2, const float* __restrict__ subw, bf16* ocat) {
    __shared__ float sc[2][2][S];
    const int w = threadIdx.x >> 6, lane = threadIdx.x & 63;
    const int q = blockIdx.x * 2 + w, hd = blockIdx.y, b = blockIdx.z;
    const size_t row = (size_t)b * S + q;
    float l1 = lq1[lane] * lk1[lane] + lq1[lane + 64] * lk1[lane + 64], l2 = lq2[lane] * lk2[lane] + lq2[lane + 64] * lk2[lane + 64];
    l1 = wave_sum(l1); l2 = wave_sum(l2);
    const float lam = __expf(l1) - __expf(l2) + LAMBDA_INIT;
    const float scale = 0.08838834764831845f;
    const unsigned qa = *(const unsigned*)(qkvg + row * ODD_IN + hd * 256 + 2 * lane);
    const unsigned qb = *(const unsigned*)(qkvg + row * ODD_IN + hd * 256 + 128 + 2 * lane);
    const float q1x = __uint_as_float(qa << 16), q1y = __uint_as_float(qa & 0xffff0000u), q2x = __uint_as_float(qb << 16), q2y = __uint_as_float(qb & 0xffff0000u);
    float m0 = -INFINITY, m1 = -INFINITY;
    for (int key = 0; key <= q; ++key) {
        const size_t kr = ((size_t)b * S + key) * ODD_IN + 4096 + hd * 256;
        const unsigned ka = *(const unsigned*)(qkvg + kr + 2 * lane), kb = *(const unsigned*)(qkvg + kr + 128 + 2 * lane);
        float s0 = q1x * __uint_as_float(ka << 16) + q1y * __uint_as_float(ka & 0xffff0000u);
        float s1 = q2x * __uint_as_float(kb << 16) + q2y * __uint_as_float(kb & 0xffff0000u);
        s0 = wave_sum(s0) * scale; s1 = wave_sum(s1) * scale;
        if (lane == 0) { sc[w][0][key] = s0; sc[w][1][key] = s1; }
        m0 = fmaxf(m0, s0); m1 = fmaxf(m1, s1);
    }
    __syncthreads();
    float e0 = 0.f, e1 = 0.f;
    for (int key = lane; key <= q; key += 64) { const float p0 = __expf(sc[w][0][key] - m0), p1 = __expf(sc[w][1][key] - m1); sc[w][0][key] = p0; sc[w][1][key] = p1; e0 += p0; e1 += p1; }
    e0 = wave_sum(e0); e1 = wave_sum(e1);
    __syncthreads();
    const float i0 = 1.f / e0, i1 = lam / e1;
    float o[4] = {0.f, 0.f, 0.f, 0.f};
    for (int key = 0; key <= q; ++key) {
        const float a = sc[w][0][key] * i0 - sc[w][1][key] * i1;
        const uint2 vv = *(const uint2*)(qkvg + ((size_t)b * S + key) * ODD_IN + 8192 + hd * 256 + 4 * lane);
        o[0] += a * __uint_as_float(vv.x << 16); o[1] += a * __uint_as_float(vv.x & 0xffff0000u);
        o[2] += a * __uint_as_float(vv.y << 16); o[3] += a * __uint_as_float(vv.y & 0xffff0000u);
    }
    float ss = o[0] * o[0] + o[1] * o[1] + o[2] * o[2] + o[3] * o[3];
    ss = wave_sum(ss);
    const float rs = rsqrtf(ss / 256.f + EPS) * (1.f - LAMBDA_INIT);
#pragma unroll
    for (int i = 0; i < 4; ++i) {
        const int dv = 4 * lane + i;
        const float gt = bf2f(qkvg[row * ODD_IN + 12288 + hd * 256 + dv]);
        ocat[row * MIXW + hd * 256 + dv] = f2bf(o[i] * rs * subw[dv] * siluf_(gt));
    }
}

extern "C" void kernel_launch(void* const* d_in, const int* in_sizes, int n_in, void* d_out, int out_size, void* d_ws, size_t ws_size, hipStream_t stream) {
    static int grid = 0;
    if (grid == 0) {
        if (n_in != 22 || ws_size < WS_END || out_size != M * D) { fprintf(stderr, "kernel_launch: unexpected n_in %d / out_size %d / ws_size %zu (< %zu)\n", n_in, out_size, ws_size, (size_t)WS_END); grid = -1; return; }
        int dev = 0, cus = 0, per_cu = 0;
        if (hipGetDevice(&dev) != hipSuccess || hipDeviceGetAttribute(&cus, hipDeviceAttributeMultiprocessorCount, dev) != hipSuccess) { fprintf(stderr, "kernel_launch: device query failed\n"); grid = -1; return; }
        if (hipFuncSetAttribute((const void*)mega, hipFuncAttributeMaxDynamicSharedMemorySize, LDS_BYTES) != hipSuccess) { fprintf(stderr, "kernel_launch: hipFuncSetAttribute failed\n"); grid = -1; return; }
        if (hipOccupancyMaxActiveBlocksPerMultiprocessor(&per_cu, (const void*)mega, NWAVES * 64, LDS_BYTES) != hipSuccess || per_cu < 1) { fprintf(stderr, "kernel_launch: occupancy query says %d blocks/CU\n", per_cu); (void)hipGetLastError(); grid = -1; return; }
        if (cus != 256) { fprintf(stderr, "kernel_launch: built for 256 CUs, device has %d\n", cus); grid = -1; return; }
        grid = cus;
    }
    if (grid < 0) return;
    const float* in[22]; for (int i = 0; i < 22; ++i) in[i] = (const float*)d_in[i];
    float* out = (float*)d_out; unsigned char* ws = (unsigned char*)d_ws;
    bf16* proj0 = (bf16*)(ws + WS_PROJ0); float* ytmp = (float*)(ws + WS_STATES); bf16* ycat = (bf16*)(ws + WS_YCAT);
    float* dt = (float*)(ws + WS_DT); float* mu = (float*)(ws + WS_SGU_MU); float* rs = (float*)(ws + WS_SGU_RS);
    bf16* qkvg = proj0; bf16* ocat = ycat;
    (void)hipMemsetAsync(ws + WS_CTL, 0, CTL_ZERO_BYTES, stream);
    Args a{};
    for (int i = 0; i < 22; ++i) a.in[i] = in[i];
    a.out = out; a.ws = ws;
    auto launch = [&](int lo, int hi, int li) { a.ph_lo = lo; a.ph_hi = hi; a.li = li; hipLaunchKernelGGL(mega, dim3(grid), dim3(NWAVES * 64), LDS_BYTES, stream, a); };
    launch(PH_PRO, PH_N, 0);
}
```

```cpp
#include <hip/hip_runtime.h>
#include <cstdio>
#include <cstdint>

namespace pg8 {
#define PG8_LAS __attribute__((address_space(3)))
typedef unsigned short bf16_t;
typedef short bf16x8 __attribute__((ext_vector_type(8)));
typedef float f32x4 __attribute__((ext_vector_type(4)));
typedef unsigned u32x4 __attribute__((ext_vector_type(4)));
constexpr int BM = 256, BK = 64, HALF = 128, HTB = HALF * BK * 2  , STAGE_BYTES = 8 * HTB, NXCD = 8, WGM = 8;

__host__ __device__ __forceinline__ int lds_byte(int r, int c) { const int st = (r >> 4) * 2 + (c >> 5), rr = r & 15, cc = c & 31, ob = rr * 64 + cc * 2; return st * 1024 + (ob ^ (((ob >> 9) & 1) << 5)); }
__host__ __device__ __forceinline__ void stage_rc(int b, int& R, int& C) { const int st = b / 1024, sb = b % 1024, swz = sb ^ (((sb >> 9) & 1) << 5); R = (st >> 1) * 16 + swz / 64; C = (st & 1) * 32 + (swz % 64) / 2; }
__host__ __device__ __forceinline__ int perm32(int rho) { const int n = rho >> 4, i = rho & 15; return 8 * (i >> 2) + 4 * n + (i & 3); }

struct Unit { int pm, pn; };
struct Gemm { const bf16_t* A; const bf16_t* Bt; int M, N, K; };

struct StaticOrder {
    int nM, nN, nwg, G, c;
    __host__ __device__ void init(int M, int N, int G_, int c_) { nM = M / BM; nN = N / BM; nwg = nM * nN; G = G_; c = c_; }
    __host__ __device__ bool next(int i, Unit& u) const {
        const long L = (long)i * G + c; if (L >= nwg) return false;
        int wgid = (int)L; { const int q = nwg / NXCD, r = nwg % NXCD, xcd = wgid % NXCD, off = wgid / NXCD; wgid = (xcd < r ? xcd * (q + 1) : r * (q + 1) + (xcd - r) * q) + off; }
        const int nig = WGM * nN, gid = wgid / nig, fm = gid * WGM, gsz = (nM - fm) < WGM ? (nM - fm) : WGM;
        u.pm = fm + ((wgid % nig) % gsz); u.pn = (wgid % nig) / gsz; return true;
    }
    __device__ __forceinline__ void a_ready(const Unit&) const {}
    __device__ __forceinline__ void done(const Unit&) const {}
};

__device__ __forceinline__ unsigned cvt_pk_bf16(float lo, float hi) { unsigned r; asm volatile("v_cvt_pk_bf16_f32 %0, %1, %2" : "=v"(r) : "v"(lo), "v"(hi)); return r; }

constexpr float RMS_EPS = 1e-6f;
template <int NP> struct EpiRowScaleBf16 {
    static constexpr bool PERM = true, AFTER_DRAIN = false;
    bf16_t* O; int ldc; const float* rs;
    __device__ __forceinline__ void operator()(const f32x4 (&acc)[2][2][4][2], const Unit& u, int wr, int wc, int fr, int fq) const {
        const int row0 = u.pm * BM + wr * 64 + fr, col0 = u.pn * BM + wc * 32 + 8 * fq;
#pragma unroll
        for (int ai = 0; ai < 2; ++ai)
#pragma unroll
            for (int m = 0; m < 4; ++m) {
                const int row = row0 + ai * HALF + m * 16;
                float sc;
                if (NP == 1) sc = rs[row];
                else { const f32x4 a = *(const f32x4*)(rs + (size_t)row * 8), b = *(const f32x4*)(rs + (size_t)row * 8 + 4);
                       sc = rsqrtf((((a[0] + a[1]) + (a[2] + a[3])) + ((b[0] + b[1]) + (b[2] + b[3]))) * (1.0f / 2048.0f) + RMS_EPS); }
                bf16_t* rowp = O + (size_t)row * ldc + col0;
#pragma unroll
                for (int bj = 0; bj < 2; ++bj) { const f32x4 v0 = acc[ai][bj][m][0] * sc, v1 = acc[ai][bj][m][1] * sc;
                    u32x4 w; w.x = cvt_pk_bf16(v0[0], v0[1]); w.y = cvt_pk_bf16(v0[2], v0[3]); w.z = cvt_pk_bf16(v1[0], v1[1]); w.w = cvt_pk_bf16(v1[2], v1[3]);
                    *(u32x4*)(rowp + bj * HALF) = w; }
            }
    }
};
template <bool WBF> struct EpiResid {
    static constexpr bool PERM = false, AFTER_DRAIN = true;
    const float* base; float* out; bf16_t* hb; float* ssqp; int ldc;
    __device__ __forceinline__ void fused(f32x4 (&acc)[2][2][4][2], const Unit& u, int wr, int wc, int fr, int fq, PG8_LAS unsigned char* lds, int wid, int lane) const {
        typedef unsigned u32x2v __attribute__((ext_vector_type(2)));
        PG8_LAS float* P = (PG8_LAS float*)lds;
        const int col0 = u.pn * BM + wc * 32 + 4 * fq;
#pragma unroll
        for (int ai = 0; ai < 2; ++ai)
#pragma unroll
            for (int m = 0; m < 4; ++m) {
                const int r = ai * HALF + wr * 64 + m * 16 + fr; const size_t off = (size_t)(u.pm * BM + r) * ldc + col0; float ss = 0.f;
#pragma unroll
                for (int bj = 0; bj < 2; ++bj)
#pragma unroll
                    for (int n = 0; n < 2; ++n) {
                        const f32x4 bs = *(const f32x4*)(base + off + bj * HALF + n * 16); const f32x4 h = bs + acc[ai][bj][m][n];
                        *(f32x4*)(out + off + bj * HALF + n * 16) = h;
                        if (WBF) { u32x2v w; w.x = cvt_pk_bf16(h[0], h[1]); w.y = cvt_pk_bf16(h[2], h[3]); *(u32x2v*)(hb + off + bj * HALF + n * 16) = w; }
                        ss += (h[0] * h[0] + h[1] * h[1]) + (h[2] * h[2] + h[3] * h[3]); }
                ss += __shfl_xor(ss, 16); ss += __shfl_xor(ss, 32);
                if (fq == 0) P[r * 4 + wc] = ss;
                if (m & 1) asm volatile("" ::: "memory");
            }
        asm volatile("s_waitcnt lgkmcnt(0)" ::: "memory"); __builtin_amdgcn_s_barrier(); asm volatile("" ::: "memory");
        const int tid = wid * 64 + lane;
        if (tid < 256) { const f32x4 p = *(const PG8_LAS f32x4*)(P + tid * 4); ssqp[(size_t)(u.pm * BM + tid) * 8 + u.pn] = (p[0] + p[1]) + (p[2] + p[3]); }
    }
};
template <class Epi, class Sched, bool ALIGN_EPI = false, bool SP2 = false>
__device__ __forceinline__ void gemm_phase(PG8_LAS unsigned char* lds, const Gemm g, const Sched& S, const Epi& E) {
    const int tid = threadIdx.x, wid = __builtin_amdgcn_readfirstlane(tid >> 6), lane = tid & 63, wr = wid >> 2, wc = wid & 3, fr = lane & 15, fq = lane >> 4;
    const int K = g.K, nt = K / BK;
    unsigned voffA[2], voffB[2];
#pragma unroll
    for (int i = 0; i < 2; ++i) { int R, C; stage_rc(tid * 16 + i * 8192, R, C); const int Rb = Epi::PERM ? ((R & ~31) + perm32(R & 31)) : R;
        voffA[i] = (unsigned)(R * K + C) * 2u; voffB[i] = (unsigned)(Rb * K + C) * 2u; }
    const size_t kstep = (size_t)(BK * 2);
    const size_t hstep = (size_t)HALF * K * 2;
    const size_t tstep = 2 * hstep;
    const unsigned ldsw = (unsigned)wid * 1024u;
    const int aoff = lds_byte(wr * 64 + fr, fq * 8), boff = lds_byte(wc * 32 + fr, fq * 8);
#define PG8_SA(b, h) (((b) * 2 + (h)) * HTB)
#define PG8_SB(b, h) ((4 + (b) * 2 + (h)) * HTB)
#define PG8_STAGE(bufoff, gbase, voff) do { _Pragma("unroll") for (int _i = 0; _i < 2; ++_i) \
        __builtin_amdgcn_global_load_lds((const unsigned*)((const char*)(gbase) + (voff)[_i]), (PG8_LAS unsigned*)(lds + (bufoff) + ldsw + _i * 8192), 16, 0, 0); } while (0)
#define PG8_LDA(dst, b, h) do { _Pragma("unroll") for (int m = 0; m < 4; ++m) _Pragma("unroll") for (int k = 0; k < 2; ++k) dst[m][k] = *(const PG8_LAS bf16x8*)(lds + PG8_SA(b, h) + aoff + m * 2048 + k * 1024); } while (0)
#define PG8_LDB(dst, b, h) do { _Pragma("unroll") for (int n = 0; n < 2; ++n) _Pragma("unroll") for (int k = 0; k < 2; ++k) dst[n][k] = *(const PG8_LAS bf16x8*)(lds + PG8_SB(b, h) + boff + n * 2048 + k * 1024); } while (0)
#define PG8_MMA(ai, bj, At, Bt) do { __builtin_amdgcn_s_setprio(1); _Pragma("unroll") for (int m = 0; m < 4; ++m) _Pragma("unroll") for (int n = 0; n < 2; ++n) _Pragma("unroll") for (int k = 0; k < 2; ++k) \
        acc[ai][bj][m][n] = __builtin_amdgcn_mfma_f32_16x16x32_bf16(Bt[n][k], At[m][k], acc[ai][bj][m][n], 0, 0, 0); __builtin_amdgcn_s_setprio(0); } while (0)
#define PG8_WAIT_V(n) asm volatile("s_waitcnt vmcnt(" #n ")" ::: "memory")
#define PG8_WAIT_L(n) asm volatile("s_waitcnt lgkmcnt(" #n ")" ::: "memory")
#define PG8_BAR __builtin_amdgcn_s_barrier()
#define PG8_SCHED __builtin_amdgcn_sched_barrier(0)
    Unit cur, nxt; int ui = 0;
    if (!S.next(0, cur)) return;
    f32x4 acc[2][2][4][2];
#pragma unroll
    for (int a = 0; a < 2; ++a)
#pragma unroll
        for (int b = 0; b < 2; ++b)
#pragma unroll
            for (int m = 0; m < 4; ++m)
#pragma unroll
                for (int n = 0; n < 2; ++n) acc[a][b][m][n] = (f32x4){0.f, 0.f, 0.f, 0.f};
    bf16x8 At[4][2], B0[2][2], B1[2][2];
    const char* cA = (const char*)g.A + (size_t)cur.pm * tstep; const char* cB = (const char*)g.Bt + (size_t)cur.pn * tstep;
    S.a_ready(cur);
    if constexpr (SP2) {
        PG8_STAGE(PG8_SB(0, 0), cB, voffB); PG8_STAGE(PG8_SB(0, 1), cB + hstep, voffB); PG8_STAGE(PG8_SA(0, 0), cA, voffA); PG8_STAGE(PG8_SA(0, 1), cA + hstep, voffA);
        if (wr == 1) PG8_BAR;
        PG8_WAIT_V(2); PG8_BAR;
        PG8_STAGE(PG8_SB(1, 0), cB + kstep, voffB); PG8_STAGE(PG8_SA(1, 0), cA + kstep, voffA); PG8_STAGE(PG8_SB(1, 1), cB + hstep + kstep, voffB);
        PG8_WAIT_V(6); PG8_BAR;
    } else {
        PG8_STAGE(PG8_SB(0, 0), cB, voffB); PG8_STAGE(PG8_SA(0, 0), cA, voffA); PG8_STAGE(PG8_SB(0, 1), cB + hstep, voffB); PG8_STAGE(PG8_SA(0, 1), cA + hstep, voffA);
        if (wr == 1) PG8_BAR;
        PG8_WAIT_V(4); PG8_BAR;
        PG8_STAGE(PG8_SB(1, 0), cB + kstep, voffB); PG8_STAGE(PG8_SA(1, 0), cA + kstep, voffA); PG8_STAGE(PG8_SB(1, 1), cB + hstep + kstep, voffB);
        PG8_WAIT_V(6); PG8_BAR;
    }
    for (;;) {
        const bool has_next = S.next(ui + 1, nxt);
        const char* nA = has_next ? (const char*)g.A + (size_t)nxt.pm * tstep : cA; const char* nB = has_next ? (const char*)g.Bt + (size_t)nxt.pn * tstep : cB;
        for (int t = 0; t < nt; t += 2) {
            const bool last = (t == nt - 2);
            const char* a1 = cA + (size_t)(t + 1) * kstep;
            const char* a2 = last ? nA : cA + (size_t)(t + 2) * kstep; const char* b2 = last ? nB : cB + (size_t)(t + 2) * kstep;
            const char* a3 = a2 + kstep; const char* b3 = b2 + kstep;
            if (last && has_next) S.a_ready(nxt);
            if constexpr (SP2) {
            PG8_LDB(B0, 0, 0); PG8_LDB(B1, 0, 1); PG8_SCHED; PG8_LDA(At, 0, 0); PG8_STAGE(PG8_SA(1, 1), a1 + hstep, voffA);
            PG8_WAIT_V(8); PG8_WAIT_L(0); PG8_BAR; PG8_MMA(0, 0, At, B0); PG8_MMA(0, 1, At, B1); PG8_BAR; PG8_SCHED;
            PG8_LDA(At, 0, 1); PG8_STAGE(PG8_SB(0, 0), b2, voffB); PG8_STAGE(PG8_SB(0, 1), b2 + hstep, voffB); PG8_STAGE(PG8_SA(0, 0), a2, voffA);
            PG8_WAIT_V(8); PG8_WAIT_L(0); PG8_BAR; PG8_MMA(1, 0, At, B0); PG8_MMA(1, 1, At, B1); PG8_BAR; PG8_SCHED;
            PG8_LDB(B0, 1, 0); PG8_LDB(B1, 1, 1); PG8_SCHED; PG8_LDA(At, 1, 0); PG8_STAGE(PG8_SA(0, 1), a2 + hstep, voffA);
            PG8_WAIT_V(8); PG8_WAIT_L(0); PG8_BAR; PG8_MMA(0, 0, At, B0); PG8_MMA(0, 1, At, B1); PG8_BAR; PG8_SCHED;
            PG8_LDA(At, 1, 1); PG8_STAGE(PG8_SB(1, 0), b3, voffB); PG8_STAGE(PG8_SB(1, 1), b3 + hstep, voffB); PG8_STAGE(PG8_SA(1, 0), a3, voffA);
            PG8_WAIT_V(8); PG8_WAIT_L(0); PG8_BAR; PG8_MMA(1, 0, At, B0); PG8_MMA(1, 1, At, B1); PG8_BAR; PG8_SCHED;
            } else {
            PG8_LDB(B0, 0, 0); PG8_SCHED; PG8_LDA(At, 0, 0); PG8_STAGE(PG8_SA(1, 1), a1 + hstep, voffA);
            PG8_WAIT_L(8); PG8_BAR; PG8_WAIT_L(0); PG8_MMA(0, 0, At, B0); PG8_BAR; PG8_SCHED;
            PG8_LDB(B1, 0, 1); PG8_STAGE(PG8_SB(0, 0), b2, voffB);
            PG8_BAR; PG8_WAIT_L(0); PG8_MMA(0, 1, At, B1); PG8_BAR;
            PG8_LDA(At, 0, 1); PG8_STAGE(PG8_SA(0, 0), a2, voffA);
            PG8_BAR; PG8_WAIT_L(0); PG8_MMA(1, 0, At, B0); PG8_BAR; PG8_SCHED;
            PG8_STAGE(PG8_SB(0, 1), b2 + hstep, voffB);
            PG8_WAIT_V(6); PG8_BAR; PG8_MMA(1, 1, At, B1); PG8_BAR;
            PG8_LDB(B0, 1, 0); PG8_SCHED; PG8_LDA(At, 1, 0); PG8_STAGE(PG8_SA(0, 1), a2 + hstep, voffA);
            PG8_WAIT_L(8); PG8_BAR; PG8_WAIT_L(0); PG8_MMA(0, 0, At, B0); PG8_BAR; PG8_SCHED;
            PG8_LDB(B1, 1, 1); PG8_STAGE(PG8_SB(1, 0), b3, voffB);
            PG8_BAR; PG8_WAIT_L(0); PG8_MMA(0, 1, At, B1); PG8_BAR;
            PG8_LDA(At, 1, 1); PG8_STAGE(PG8_SA(1, 0), a3, voffA);
            PG8_BAR; PG8_WAIT_L(0); PG8_MMA(1, 0, At, B0); PG8_BAR; PG8_SCHED;
            PG8_STAGE(PG8_SB(1, 1), b3 + hstep, voffB);
            PG8_WAIT_V(6); PG8_BAR; PG8_MMA(1, 1, At, B1); PG8_BAR;
            }
        }
        if constexpr (ALIGN_EPI) { if (wr == 0) PG8_BAR; }
        if constexpr (!Epi::AFTER_DRAIN) { E(acc, cur, wr, wc, fr, fq); S.done(cur); }
        if (!has_next) break;
#pragma unroll
        for (int a = 0; a < 2; ++a)
#pragma unroll
            for (int b = 0; b < 2; ++b)
#pragma unroll
                for (int m = 0; m < 4; ++m)
#pragma unroll
                    for (int n = 0; n < 2; ++n) acc[a][b][m][n] = (f32x4){0.f, 0.f, 0.f, 0.f};
        cur = nxt; cA = nA; cB = nB; ++ui;
        if constexpr (ALIGN_EPI) { if (wr == 1) PG8_BAR; }
    }
    PG8_WAIT_V(0);
    if constexpr (!ALIGN_EPI) { if (wr == 0) PG8_BAR; }
    PG8_BAR;
    if constexpr (Epi::AFTER_DRAIN) { E.fused(acc, cur, wr, wc, fr, fq, lds, wid, lane); S.done(cur); }
#undef PG8_SA
#undef PG8_SB
#undef PG8_STAGE
#undef PG8_LDA
#undef PG8_LDB
#undef PG8_MMA
#undef PG8_WAIT_V
#undef PG8_WAIT_L
#undef PG8_BAR
#undef PG8_SCHED
}

}

constexpr int NB = 4, S = 2048, M = NB * S, D = 2048;
constexpr int EVEN_IN = 12320, N1 = 12288;
constexpr int C_ZA = 0, C_XBC = 2048, C_ZB = 6144, C_U = 8192, C_V = 10240;
constexpr int XBC_W = 4096;
constexpr int ODD_IN = 16384, MIXW = 4096;
constexpr float EPS = 1e-6f;
constexpr float LAMBDA_INIT = 0.35550906759096924f;

constexpr size_t MiB = 1u << 20;
constexpr size_t WS_CTL = 0, CTL_ZERO_BYTES = 1 * MiB;
constexpr size_t WS_WIN0 = 1 * MiB;
constexpr size_t WS_WOUT0 = 49 * MiB;
constexpr size_t WS_WIN1 = 65 * MiB;
constexpr size_t WS_WOUT1 = 129 * MiB;
constexpr size_t WS_XB = 145 * MiB;
constexpr size_t WS_PROJ0 = 177 * MiB;
constexpr size_t WS_STATES = 369 * MiB;
constexpr size_t WS_YCAT = 433 * MiB;
constexpr size_t WS_DT = 497 * MiB;
constexpr size_t WS_RSTD0 = 498 * MiB;
constexpr size_t WS_SGU_MU = WS_RSTD0 + 128 * 1024;
constexpr size_t WS_SGU_RS = WS_SGU_MU + 64 * 1024;
constexpr size_t WS_SSQ1 = WS_RSTD0 + 256 * 1024;
constexpr size_t WS_SSQ2 = WS_RSTD0 + 512 * 1024;
constexpr size_t WS_CDEC = WS_RSTD0 + 768 * 1024;
constexpr size_t WS_END = 499 * MiB;
constexpr int CW_BAR = 4096;

#define GAS __attribute__((address_space(1)))
#define LAS __attribute__((address_space(3)))
typedef unsigned short bf16;
typedef unsigned v4u __attribute__((ext_vector_type(4)));
typedef unsigned v2u __attribute__((ext_vector_type(2)));
typedef float f32x4 __attribute__((ext_vector_type(4)));
typedef float f32x16 __attribute__((ext_vector_type(16)));
typedef short bf16x8 __attribute__((ext_vector_type(8)));
#define LDS_WAIT() asm volatile("s_waitcnt lgkmcnt(0)" ::: "memory")
#define VM_WAIT() asm volatile("s_waitcnt vmcnt(0)" ::: "memory")
__device__ __forceinline__ unsigned pk2(float lo, float hi) { return pg8::cvt_pk_bf16(lo, hi); }
__device__ __forceinline__ float bf2f(bf16 v) { return __uint_as_float(((unsigned)v) << 16); }
__device__ __forceinline__ bf16 f2bf(float f) { unsigned u = __float_as_uint(f); return (bf16)((u + 0x7fffu + ((u >> 16) & 1u)) >> 16); }
__device__ __forceinline__ float sigmoidf_(float v) { return 1.f / (1.f + __expf(-v)); }
__device__ __forceinline__ float siluf_(float v) { return v * sigmoidf_(v); }
__device__ __forceinline__ float geluf_(float v) { const float c = 0.7978845608028654f; float t = tanhf(c * (v + 0.044715f * v * v * v)); return 0.5f * v * (1.f + t); }
__device__ __forceinline__ float softplusf_(float v) { return v > 20.f ? v : log1pf(__expf(v)); }
__device__ __forceinline__ float wave_sum(float v) {
#pragma unroll
    for (int o = 1; o < 64; o <<= 1) v += __shfl_xor(v, o);
    return v;
}

#define XB_TMO      128
#define XB_XCNT(j)  (256  + 64 * (j))
#define XB_XSUB(j)  (1280 + 64 * (j))
#define XB_XGEN(j)  (2304 + 64 * (j))
#define XB_TOP      3328
#define XB_TOPGEN   3392
#define XCD_BAR_WORDS 3456
#define XB_SPIN_CAP (1u << 25)

__device__ __forceinline__ unsigned xb_ld(unsigned* p)              { return __hip_atomic_load(p, __ATOMIC_RELAXED, __HIP_MEMORY_SCOPE_AGENT); }
__device__ __forceinline__ unsigned xb_add(unsigned* p, unsigned v) { return __hip_atomic_fetch_add(p, v, __ATOMIC_RELAXED, __HIP_MEMORY_SCOPE_AGENT); }
__device__ __forceinline__ unsigned xb_xcc_id() { return (unsigned)__builtin_amdgcn_s_getreg((3 << 11) | 20) & 0xFu; }
#define XB_SPIN(cond, bar) do { unsigned _sp = 0; while (cond) { __builtin_amdgcn_s_sleep(1); \
    if ((++_sp & 255u) == 0u) { if (xb_ld(&(bar)[XB_TMO])) break; if (_sp > XB_SPIN_CAP) { atomicAdd(&(bar)[XB_TMO], 1u); break; } } } } while (0)

struct XcdBarrier {
    unsigned* bar; unsigned x;
    volatile LAS unsigned* st;
};

__device__ __forceinline__ XcdBarrier xcd_barrier_post(unsigned* bar, volatile LAS unsigned* st) {
    XcdBarrier b; b.bar = bar; b.x = xb_xcc_id(); b.st = st;
    if (threadIdx.x == 0) (void)xb_add(&bar[XB_XCNT(b.x)], 1u);
    return b;
}
__device__ __forceinline__ void xcd_barrier_complete(unsigned* bar, unsigned x, unsigned& nloc, unsigned& nx) {
    const unsigned G = gridDim.x * gridDim.y * gridDim.z;
    unsigned sum, cnt, mine, sp = 0u;
    for (;;) {
        sum = 0u; cnt = 0u; mine = 0u;
#pragma unroll
        for (unsigned j = 0; j < 16; ++j) { const unsigned c = xb_ld(&bar[XB_XCNT(j)]); sum += c; cnt += (c > 0u) ? 1u : 0u; mine = (j == x) ? c : mine; }
        if (sum == G) break;
        __builtin_amdgcn_s_sleep(1);
        if ((++sp & 255u) == 0u) { if (xb_ld(&bar[XB_TMO])) break; if (sp > XB_SPIN_CAP) { atomicAdd(&bar[XB_TMO], 1u); break; } }
    }
    nloc = mine > 0u ? mine : 1u; nx = cnt > 0u ? cnt : 1u;
}

__device__ __forceinline__ void xcd_barrier(const XcdBarrier& b) {
    asm volatile("s_waitcnt vmcnt(0)" ::: "memory");
    __syncthreads();
    if (threadIdx.x == 0) {
        unsigned* bar = b.bar;
        __builtin_amdgcn_s_waitcnt(0);
        unsigned nloc = b.st[0], nx = b.st[1];
        if (nloc == 0u) { xcd_barrier_complete(bar, b.x, nloc, nx); b.st[0] = nloc; b.st[1] = nx; }
        const unsigned old = xb_add(&bar[XB_XSUB(b.x)], 1u);
        const unsigned gen = old / nloc;
        if (old + 1u == (gen + 1u) * nloc) {
            __builtin_amdgcn_fence(__ATOMIC_RELEASE, "agent");
            asm volatile("s_waitcnt vmcnt(0)" ::: "memory");
            const unsigned og = xb_add(&bar[XB_TOP], 1u);
            const unsigned tg = og / nx;
            if (og + 1u == (tg + 1u) * nx) xb_add(&bar[XB_TOPGEN], 1u);
            else XB_SPIN(xb_ld(&bar[XB_TOPGEN]) == tg, bar);
            __builtin_amdgcn_fence(__ATOMIC_ACQUIRE, "agent");
            xb_add(&bar[XB_XGEN(b.x)], 1u);
            asm volatile("s_waitcnt vmcnt(0)" ::: "memory");
        } else {
            XB_SPIN(xb_ld(&bar[XB_XGEN(b.x)]) == gen, bar);
            __builtin_amdgcn_fence(__ATOMIC_ACQUIRE, "agent");
            asm volatile("s_waitcnt vmcnt(0)" ::: "memory");
        }
    }
    __syncthreads();
}


__device__ __forceinline__ int lane_id() { int l; asm volatile("v_mbcnt_lo_u32_b32 %0, -1, 0\n\tv_mbcnt_hi_u32_b32 %0, -1, %0" : "=v"(l)); return l; }
#define F_LANE lane_id()
#define F_TID (F.wave * 64 + lane_id())
constexpr int NWAVES = 8;
constexpr int LDS_BYTES = 163840;
constexpr int LDSCTL_OFF = LDS_BYTES - 256;
struct Frame {
    LAS unsigned char* lds;
    volatile LAS unsigned* MISC;
    unsigned* ctl;
    int wave, G;
    const float* in[22]; float* out;
    bf16 *Wt_in0, *Wt_out0, *Wt_in1, *Wt_out1, *xb, *proj0, *ycat, *h1b, *qkvg, *ocat;
    float *dt, *rstd0, *ssq1, *ssq2;
};
enum InIdx { I_X = 0, I_NORMW, I_WIN0, I_CONVW, I_CONVB, I_DTB, I_ALOG, I_DSKIP, I_SSDNW, I_LNW, I_LNB, I_SGUWS, I_SGUB, I_WOUT0, I_WIN1, I_LQ1, I_LK1, I_LQ2, I_LK2, I_SUBW, I_WOUT1, I_FW };

__device__ __forceinline__ void p0_transpose_item(const float* W, int ldw, int K, bf16* WT, int nblk, int shift_from, int shift, const float* ksc, LAS float* scr, int item, int lane) {
    const int kb = item / nblk, nb = item % nblk, k0 = 64 * kb, n0 = 32 * nb, ns = n0 + (n0 >= shift_from ? shift : 0);
#pragma unroll 8
    for (int i = 0; i < 32; ++i) { const int kk = 2 * i + (lane >> 5); float v = W[(size_t)(k0 + kk) * ldw + ns + (lane & 31)]; if (ksc) v *= ksc[k0 + kk]; scr[kk * 33 + (lane & 31)] = v; }
    LDS_WAIT(); asm volatile("" ::: "memory");
    const int c = lane & 7;
#pragma unroll
    for (int j = 0; j < 4; ++j) { const int n = (lane >> 3) + 8 * j; const LAS float* s = scr + (8 * c) * 33 + n;
        v4u o; o.x = pk2(s[0 * 33], s[1 * 33]); o.y = pk2(s[2 * 33], s[3 * 33]); o.z = pk2(s[4 * 33], s[5 * 33]); o.w = pk2(s[6 * 33], s[7 * 33]);
        *(GAS v4u*)(WT + (size_t)(n0 + n) * K + k0 + 8 * c) = o; }
    LDS_WAIT(); asm volatile("" ::: "memory");
}
__device__ __forceinline__ void p0_prologue(Frame& F) {
    const int lane0 = F_LANE, tid0 = F.wave * 64 + lane0;
    {
        LAS float* scr = (LAS float*)(F.lds + F.wave * 16384);
        const int gw = (int)blockIdx.x * NWAVES + F.wave, NGW = F.G * NWAVES;
        constexpr int I_A = (D / 64) * (N1 / 32), I_B = (MIXW / 64) * (D / 32), I_C = (D / 64) * (ODD_IN / 32), I_D = I_B;
        constexpr int NITEMS = I_A + I_B + I_C + I_D;
        const float* nw = F.in[I_NORMW];
        for (int it = gw; it < NITEMS; it += NGW) {
            int r = it;
            if (r < I_A) { p0_transpose_item(F.in[I_WIN0], EVEN_IN, D, F.Wt_in0, N1 / 32, 6144, 32, nw, scr, r, lane0); continue; } r -= I_A;
            if (r < I_B) { p0_transpose_item(F.in[I_WOUT0], D, MIXW, F.Wt_out0, D / 32, 1 << 30, 0, nullptr, scr, r, lane0); continue; } r -= I_B;
            if (r < I_C) { p0_transpose_item(F.in[I_WIN1], ODD_IN, D, F.Wt_in1, ODD_IN / 32, 1 << 30, 0, nw + D, scr, r, lane0); continue; } r -= I_C;
            p0_transpose_item(F.in[I_WOUT1], D, MIXW, F.Wt_out1, D / 32, 1 << 30, 0, nullptr, scr, r, lane0);
        }
    }
    __syncthreads();
    constexpr int TROW = 4112;
    LAS unsigned char* tile = F.lds;
    LAS float* rst = (LAS float*)(F.lds + 32 * TROW);
    const float* x = F.in[I_X]; const float* nw0 = F.in[I_NORMW]; const float* wdt = F.in[I_WIN0] + 6144; const float* dtb = F.in[I_DTB];
    for (int blk = blockIdx.x; blk < M / 32; blk += F.G) {
        for (int i = 0; i < 4; ++i) {
            const int rl = F.wave * 4 + i, row = blk * 32 + rl;
            const GAS f32x4* xr = (const GAS f32x4*)(x + (size_t)row * D) + lane0;
            f32x4 v[8]; float ss = 0.f;
#pragma unroll
            for (int j = 0; j < 8; ++j) { v[j] = xr[64 * j]; ss += (v[j][0] * v[j][0] + v[j][1] * v[j][1]) + (v[j][2] * v[j][2] + v[j][3] * v[j][3]); }
            ss = wave_sum(ss);
            const float rstd = rsqrtf(ss * (1.0f / D) + EPS);
            if (lane0 == 0) { F.rstd0[row] = rstd; rst[rl] = rstd; }
            GAS v2u* o8 = (GAS v2u*)(F.xb + (size_t)row * D) + lane0;
#pragma unroll
            for (int j = 0; j < 8; ++j) { v2u w; w.x = pk2(v[j][0], v[j][1]); w.y = pk2(v[j][2], v[j][3]); o8[64 * j] = w; *(LAS v2u*)(tile + rl * TROW + (64 * j + lane0) * 8) = w; }
        }
        LDS_WAIT(); __syncthreads();
        const int r32 = lane0 & 31, hi = lane0 >> 5;
        f32x16 acc = {};
        for (int ks = 0; ks < 16; ++ks) {
            const int k0 = 256 * F.wave + 16 * ks + 8 * hi;
            const bf16x8 a = *(const LAS bf16x8*)(tile + r32 * TROW + k0 * 2);
            float wv[8];
#pragma unroll
            for (int j = 0; j < 8; ++j) wv[j] = wdt[(size_t)(k0 + j) * EVEN_IN + r32] * nw0[k0 + j];
            v4u bw; bw.x = pk2(wv[0], wv[1]); bw.y = pk2(wv[2], wv[3]); bw.z = pk2(wv[4], wv[5]); bw.w = pk2(wv[6], wv[7]);
            acc = __builtin_amdgcn_mfma_f32_32x32x16_bf16(a, __builtin_bit_cast(bf16x8, bw), acc, 0, 0, 0);
        }
        LDS_WAIT(); __syncthreads();
        LAS float* red = (LAS float*)F.lds;
#pragma unroll
        for (int r = 0; r < 16; ++r) { const int row = (r & 3) + 8 * (r >> 2) + 4 * hi; red[(F.wave * 32 + row) * 33 + r32] = acc[r]; }
        LDS_WAIT(); __syncthreads();
        for (int idx = tid0; idx < 1024; idx += NWAVES * 64) {
            const int row = idx >> 5, h = idx & 31; float s = 0.f;
#pragma unroll
            for (int w = 0; w < 8; ++w) s += red[(w * 32 + row) * 33 + h];
            F.dt[(size_t)(blk * 32 + row) * 32 + h] = softplusf_(s * rst[row] + dtb[h]);
        }
        LDS_WAIT(); __syncthreads();
    }
}
__device__ __forceinline__ void final_norm(Frame& F) {
    const int gw = (int)blockIdx.x * NWAVES + F.wave, NGW = F.G * NWAVES;
    const int lane0 = F_LANE;
    const GAS f32x4* fw = (const GAS f32x4*)F.in[I_FW] + lane0;
    for (int row = gw; row < M; row += NGW) {
        GAS f32x4* o = (GAS f32x4*)(F.out + (size_t)row * D) + lane0;
        const f32x4 a = *(const f32x4*)(F.ssq2 + (size_t)row * 8), b = *(const f32x4*)(F.ssq2 + (size_t)row * 8 + 4);
        const float rs = rsqrtf((((a[0] + a[1]) + (a[2] + a[3])) + ((b[0] + b[1]) + (b[2] + b[3]))) * (1.0f / D) + EPS);
        f32x4 v[8];
#pragma unroll
        for (int j = 0; j < 8; ++j) v[j] = o[64 * j];
#pragma unroll
        for (int j = 0; j < 8; ++j) o[64 * j] = v[j] * rs * fw[64 * j];
    }
}


namespace att {
constexpr int STAGE = 32768, KOFF = 8192, VOFF = 16384, NSTG = 4;
constexpr float CEXP = 0.08838834764831845f * 1.4426950408889634f;
typedef short v4i16_t __attribute__((ext_vector_type(4)));
__device__ __forceinline__ v4i16_t vtr(LAS unsigned char* p) { return __builtin_amdgcn_ds_read_tr16_b64_v4i16((LAS v4i16_t*)p); }
__device__ __forceinline__ float swap_max(float v) { auto rr = __builtin_amdgcn_permlane32_swap(__float_as_uint(v), __float_as_uint(v), false, false); return fmaxf(__uint_as_float(rr[0]), __uint_as_float(rr[1])); }
__device__ __forceinline__ float swap_sum(float v) { auto rr = __builtin_amdgcn_permlane32_swap(__float_as_uint(v), __float_as_uint(v), false, false); return __uint_as_float(rr[0]) + __uint_as_float(rr[1]); }
__device__ __forceinline__ int crow(int r, int hi) { return (r & 3) + 8 * (r >> 2) + 4 * hi; }
__device__ __forceinline__ void glds16(const void* gsrc, unsigned lds_dst) { unsigned keep;
    asm volatile("s_mov_b32 %0, m0\n\ts_mov_b32 m0, %2\n\ts_nop 0\n\tglobal_load_lds_dwordx4 %1, off\n\ts_mov_b32 m0, %0" : "=&s"(keep) : "v"(gsrc), "s"(lds_dst) : "memory"); }
}
__device__ __forceinline__ void attn_phase(Frame& F) {
    using namespace att;
    const int w = F.wave, map = w >> 2, sb = w & 3;
    LAS unsigned char* lds = F.lds;
    const bf16* qkvg = F.qkvg;
    const int vcu = ((int)blockIdx.x & 7) * (F.G >> 3) + ((int)blockIdx.x >> 3);
    for (int vu = vcu; vu < 64 * 4; vu += F.G) {
        const int bh = vu >> 2, s4 = vu & 3, b = bh >> 4, h = bh & 15;
        for (int ui = 0; ui < 4; ++ui) {
            const int qb = ui == 0 ? 15 - s4 : (ui == 1 ? 11 - s4 : (ui == 2 ? 4 + s4 : s4));
            const int q0 = qb * 128, NH = (q0 + 128) / 32, rb = q0 / 32 + sb;
            const int lane = F_LANE;
            const int r32 = lane & 31, hi = lane >> 5;
            const unsigned koff = (unsigned)((4 * w + (lane >> 4)) * ODD_IN + (((lane & 15) ^ ((4 * w + (lane >> 4)) & 15)) * 8));
            const unsigned voff0 = (unsigned)((lane >> 2) * ODD_IN + 32 * w + 8 * (lane & 3));
            const int kq = 4 * hi + ((lane & 15) >> 2);
            const int kbase = map * KOFF + r32 * 256, kswz = r32 & 15;
            const int vbase = VOFF + kq * 64 + 32 * ((lane >> 4) & 1) + 8 * (lane & 3);
            const bf16* kg = qkvg + (size_t)b * S * ODD_IN + 4096 + h * 256;
            const bf16* vg = qkvg + (size_t)b * S * ODD_IN + 8192 + h * 256;
            bf16x8 qf[8];
            { const bf16* qp = qkvg + ((size_t)b * S + q0 + 32 * sb + r32) * ODD_IN + h * 256 + map * 128 + 8 * hi;
#pragma unroll
              for (int ks = 0; ks < 8; ++ks) qf[ks] = *(const bf16x8*)(qp + 16 * ks); }
            asm volatile("s_waitcnt vmcnt(0)" ::: "memory");
#pragma unroll
            for (int ks = 0; ks < 8; ++ks) asm volatile("" : "+v"(qf[ks]));
            f32x16 O[8];
#pragma unroll
            for (int i = 0; i < 8; ++i) O[i] = (f32x16){};
            float m = -1e30f, l = 0.f;
            const unsigned lds0 = (unsigned)(uintptr_t)lds;
#define ATT_ISSUE(i_) do { const size_t _ro = (size_t)(i_) * 32 * ODD_IN; const unsigned _sb = lds0 + (unsigned)(((i_) & (NSTG - 1)) * STAGE); \
                glds16(kg + _ro + koff, (unsigned)__builtin_amdgcn_readfirstlane(_sb + w * 1024)); \
                glds16(kg + _ro + 128 + koff, (unsigned)__builtin_amdgcn_readfirstlane(_sb + KOFF + w * 1024)); \
                glds16(vg + _ro + voff0, (unsigned)__builtin_amdgcn_readfirstlane(_sb + VOFF + (2 * w) * 1024)); \
                glds16(vg + _ro + voff0 + (size_t)16 * ODD_IN, (unsigned)__builtin_amdgcn_readfirstlane(_sb + VOFF + (2 * w + 1) * 1024)); } while (0)
            ATT_ISSUE(0); ATT_ISSUE(1); ATT_ISSUE(2);
            for (int hidx = 0; hidx < NH; ++hidx) {
                if (hidx + 2 < NH) asm volatile("s_waitcnt vmcnt(8)" ::: "memory"); else if (hidx + 1 < NH) asm volatile("s_waitcnt vmcnt(4)" ::: "memory"); else asm volatile("s_waitcnt vmcnt(0)" ::: "memory");
                asm volatile("s_waitcnt lgkmcnt(0)" ::: "memory"); __builtin_amdgcn_s_barrier(); asm volatile("" ::: "memory");
                if (hidx + 3 < NH) ATT_ISSUE(hidx + 3);
                LAS unsigned char* st = lds + (hidx & (NSTG - 1)) * STAGE;
                {
                    if (hidx <= rb) {
                        f32x16 p = (f32x16){};
                        bf16x8 kf[8];
#pragma unroll
                        for (int ks = 0; ks < 8; ++ks) kf[ks] = *(const LAS bf16x8*)(st + kbase + (((2 * ks + hi) ^ kswz) << 4));
                        __builtin_amdgcn_sched_barrier(0);
#pragma unroll
                        for (int ks = 0; ks < 8; ++ks) p = __builtin_amdgcn_mfma_f32_32x32x16_bf16(kf[ks], qf[ks], p, 0, 0, 0);
#define ATT_VLOAD(dst, vp_, b0) _Pragma("unroll") for (int _b = 0; _b < 4; ++_b) { dst[_b][0] = vtr((vp_) + ((b0) + _b) * 2048); dst[_b][1] = vtr((vp_) + ((b0) + _b) * 2048 + 8 * 64); }
#define ATT_VFRAG(src, i) ((bf16x8){src[i][0][0], src[i][0][1], src[i][0][2], src[i][0][3], src[i][1][0], src[i][1][1], src[i][1][2], src[i][1][3]})
                        LAS unsigned char* vp0 = st + vbase;
                        att::v4i16_t va[4][2];
                        ATT_VLOAD(va, vp0, 0);
                        __builtin_amdgcn_sched_barrier(0);
                        if (hidx == rb) {
#pragma unroll
                            for (int r = 0; r < 16; ++r) if (crow(r, hi) > r32) p[r] = -INFINITY;
                        }
                        float tm = p[0];
#pragma unroll
                        for (int r = 1; r < 16; ++r) tm = fmaxf(tm, p[r]);
                        tm = swap_max(tm);
                        if (__any((tm - m) * CEXP > 8.0f)) {
                            const float mn = fmaxf(m, tm);
                            const float al = __builtin_amdgcn_exp2f((m - mn) * CEXP);
                            l *= al;
#pragma unroll
                            for (int i = 0; i < 8; ++i) O[i] = O[i] * al;
                            m = mn;
                        }
                        const float mc = -m * CEXP;
                        float ls = 0.f;
#pragma unroll
                        for (int r = 0; r < 16; ++r) { p[r] = __builtin_amdgcn_exp2f(__builtin_fmaf(p[r], CEXP, mc)); ls += p[r]; }
                        l += ls;
                        v4u pw0, pw1;
                        pw0.x = pk2(p[0], p[1]); pw0.y = pk2(p[2], p[3]); pw0.z = pk2(p[4], p[5]); pw0.w = pk2(p[6], p[7]);
                        pw1.x = pk2(p[8], p[9]); pw1.y = pk2(p[10], p[11]); pw1.z = pk2(p[12], p[13]); pw1.w = pk2(p[14], p[15]);
                        const bf16x8 pf0 = __builtin_bit_cast(bf16x8, pw0), pf1 = __builtin_bit_cast(bf16x8, pw1);
                        __builtin_amdgcn_sched_barrier(0);
                        { att::v4i16_t vb2[4][2];
                          ATT_VLOAD(vb2, vp0, 4);
#pragma unroll
                          for (int blk = 0; blk < 4; ++blk) O[blk] = __builtin_amdgcn_mfma_f32_32x32x16_bf16(ATT_VFRAG(va, blk), pf0, O[blk], 0, 0, 0);
                          __builtin_amdgcn_sched_barrier(0);
                          ATT_VLOAD(va, vp0 + 16 * 64, 0);
#pragma unroll
                          for (int blk = 0; blk < 4; ++blk) O[4 + blk] = __builtin_amdgcn_mfma_f32_32x32x16_bf16(ATT_VFRAG(vb2, blk), pf0, O[4 + blk], 0, 0, 0);
                          __builtin_amdgcn_sched_barrier(0);
                          ATT_VLOAD(vb2, vp0 + 16 * 64, 4);
#pragma unroll
                          for (int blk = 0; blk < 4; ++blk) O[blk] = __builtin_amdgcn_mfma_f32_32x32x16_bf16(ATT_VFRAG(va, blk), pf1, O[blk], 0, 0, 0);
                          __builtin_amdgcn_sched_barrier(0);
#pragma unroll
                          for (int blk = 0; blk < 4; ++blk) O[4 + blk] = __builtin_amdgcn_mfma_f32_32x32x16_bf16(ATT_VFRAG(vb2, blk), pf1, O[4 + blk], 0, 0, 0);
                        }
#undef ATT_VLOAD
#undef ATT_VFRAG
                        __builtin_amdgcn_sched_barrier(0);
                    }
                }
            }
#undef ATT_ISSUE
            const float ltot = swap_sum(l);
            float lam = 1.0f;
            if (map == 1) { const float* lq1 = F.in[I_LQ1]; const float* lk1 = F.in[I_LK1]; const float* lq2 = F.in[I_LQ2]; const float* lk2 = F.in[I_LK2];
                float l1 = lq1[lane] * lk1[lane] + lq1[lane + 64] * lk1[lane + 64], l2 = lq2[lane] * lk2[lane] + lq2[lane + 64] * lk2[lane + 64];
                l1 = wave_sum(l1); l2 = wave_sum(l2); lam = __expf(l1) - __expf(l2) + LAMBDA_INIT; }
            const float inv = lam / ltot;
            LDS_WAIT(); __syncthreads();
            LAS float* X = (LAS float*)(lds + sb * 32768);
            if (map == 1) {
#pragma unroll
                for (int blk = 0; blk < 8; ++blk)
#pragma unroll
                    for (int r = 0; r < 16; ++r) X[(32 * blk + crow(r, hi)) * 32 + r32] = O[blk][r] * inv;
            }
            LDS_WAIT(); __syncthreads();
            if (map == 0) {
                float ss = 0.f;
#pragma unroll
                for (int blk = 0; blk < 8; ++blk)
#pragma unroll
                    for (int r = 0; r < 16; ++r) { const float o = O[blk][r] * inv - X[(32 * blk + crow(r, hi)) * 32 + r32]; O[blk][r] = o; ss += o * o; }
                ss = swap_sum(ss);
                const float rsv = rsqrtf(ss * (1.0f / 256.0f) + EPS) * (1.0f - LAMBDA_INIT);
                LDS_WAIT();
                LAS unsigned char* T = lds + sb * 32768;
#pragma unroll
                for (int blk = 0; blk < 8; ++blk)
#pragma unroll
                    for (int g4 = 0; g4 < 4; ++g4) {
                        v2u pk; pk.x = pk2(O[blk][4 * g4] * rsv, O[blk][4 * g4 + 1] * rsv); pk.y = pk2(O[blk][4 * g4 + 2] * rsv, O[blk][4 * g4 + 3] * rsv);
                        *(LAS v2u*)(T + r32 * 528 + (32 * blk + 8 * g4 + 4 * hi) * 2) = pk;
                    }
                LDS_WAIT();
                const int ch = lane & 31;
                const float* subw = F.in[I_SUBW];
                const f32x4 sw0 = *(const f32x4*)(subw + ch * 8), sw1 = *(const f32x4*)(subw + ch * 8 + 4);
#pragma unroll 4
                for (int it = 0; it < 16; ++it) {
                    const int row = it * 2 + (lane >> 5);
                    const size_t grow = (size_t)b * S + q0 + 32 * sb + row;
                    const v4u ov = *(const LAS v4u*)(T + row * 528 + ch * 16);
                    const v4u gv = *(const v4u*)(qkvg + grow * ODD_IN + 12288 + h * 256 + ch * 8);
                    float o8[8], g8[8];
                    o8[0] = __uint_as_float(ov.x << 16); o8[1] = __uint_as_float(ov.x & 0xffff0000u); o8[2] = __uint_as_float(ov.y << 16); o8[3] = __uint_as_float(ov.y & 0xffff0000u);
                    o8[4] = __uint_as_float(ov.z << 16); o8[5] = __uint_as_float(ov.z & 0xffff0000u); o8[6] = __uint_as_float(ov.w << 16); o8[7] = __uint_as_float(ov.w & 0xffff0000u);
                    g8[0] = __uint_as_float(gv.x << 16); g8[1] = __uint_as_float(gv.x & 0xffff0000u); g8[2] = __uint_as_float(gv.y << 16); g8[3] = __uint_as_float(gv.y & 0xffff0000u);
                    g8[4] = __uint_as_float(gv.z << 16); g8[5] = __uint_as_float(gv.z & 0xffff0000u); g8[6] = __uint_as_float(gv.w << 16); g8[7] = __uint_as_float(gv.w & 0xffff0000u);
                    v4u res;
                    res.x = pk2(o8[0] * sw0[0] * siluf_(g8[0]), o8[1] * sw0[1] * siluf_(g8[1]));
                    res.y = pk2(o8[2] * sw0[2] * siluf_(g8[2]), o8[3] * sw0[3] * siluf_(g8[3]));
                    res.z = pk2(o8[4] * sw1[0] * siluf_(g8[4]), o8[5] * sw1[1] * siluf_(g8[5]));
                    res.w = pk2(o8[6] * sw1[2] * siluf_(g8[6]), o8[7] * sw1[3] * siluf_(g8[7]));
                    *(v4u*)(F.ocat + grow * MIXW + h * 256 + ch * 8) = res;
                }
            }
            LDS_WAIT(); __syncthreads();
        }
    }
}


__device__ __forceinline__ float gelu_fast(float v) { const float z = 0.7978845608028654f * (v + 0.044715f * v * v * v); return v * __builtin_amdgcn_rcpf(1.0f + __expf(-2.0f * z)); }
__device__ __forceinline__ float silu_fast(float v) { return v * __builtin_amdgcn_rcpf(1.0f + __expf(-v)); }
__device__ __forceinline__ void unpack8(const v4u r, float (&f)[8]) {
    f[0] = __uint_as_float(r.x << 16); f[1] = __uint_as_float(r.x & 0xffff0000u); f[2] = __uint_as_float(r.y << 16); f[3] = __uint_as_float(r.y & 0xffff0000u);
    f[4] = __uint_as_float(r.z << 16); f[5] = __uint_as_float(r.z & 0xffff0000u); f[6] = __uint_as_float(r.w << 16); f[7] = __uint_as_float(r.w & 0xffff0000u);
}
__device__ __forceinline__ void sgu_stats_phase(Frame& F, float* mu, float* rs) {
    const int gw = (int)blockIdx.x * NWAVES + F.wave, NGW = F.G * NWAVES, lane = F_LANE;
    for (int row = gw; row < M; row += NGW) {
        const v4u* vp = (const v4u*)(F.proj0 + (size_t)row * N1 + C_V) + lane;
        float g[32]; float sm = 0.f;
#pragma unroll
        for (int i = 0; i < 4; ++i) { float f[8]; unpack8(vp[64 * i], f);
#pragma unroll
            for (int j = 0; j < 8; ++j) { g[8 * i + j] = gelu_fast(f[j]); sm += g[8 * i + j]; } }
        const float mean = wave_sum(sm) * (1.0f / 2048.0f);
        float q = 0.f;
#pragma unroll
        for (int i = 0; i < 32; ++i) { const float d = g[i] - mean; q += d * d; }
        const float var = wave_sum(q) * (1.0f / 2048.0f);
        if (lane == 0) { mu[row] = mean; rs[row] = rsqrtf(var + EPS); }
    }
}
__device__ __forceinline__ void sgu_phase(Frame& F, const float* mu, const float* rs) {
    const int lane = F_LANE, tid = F.wave * 64 + lane, w = F.wave, r32 = lane & 31, hi = lane >> 5;
    LAS unsigned char* lds = F.lds;
    LAS unsigned char* VIMG = lds;
    LAS float* MT = (LAS float*)(lds + 32768);
    const bf16* proj0 = F.proj0; const float* ln_w = F.in[I_LNW]; const float* ln_b = F.in[I_LNB]; const float* wsg = F.in[I_SGUWS]; const float* sb = F.in[I_SGUB];
    const int ck = tid & 15;
    for (int item = (int)blockIdx.x; item < 64 * 16; item += F.G) {
        const int g = item & 15, row0 = (item >> 4) * 128;
        const int chb = g * 128 + ck * 8;
        v4u ur[4], zr[4];
        { float lw[8], lb[8];
#pragma unroll
          for (int j = 0; j < 8; ++j) { lw[j] = ln_w[chb + j]; lb[j] = ln_b[chb + j]; }
#pragma unroll
          for (int i = 0; i < 4; ++i) {
              const int s = (tid >> 4) + 32 * i; const size_t ro = (size_t)(row0 + s) * N1;
              const v4u vr = *(const v4u*)(proj0 + ro + C_V + chb);
              ur[i] = *(const v4u*)(proj0 + ro + C_U + chb); zr[i] = *(const v4u*)(proj0 + ro + C_ZB + chb);
              const float m_ = mu[row0 + s], r_ = rs[row0 + s];
              float f[8]; unpack8(vr, f);
#pragma unroll
              for (int j = 0; j < 8; ++j) f[j] = (gelu_fast(f[j]) - m_) * r_ * lw[j] + lb[j];
              v4u o; o.x = pk2(f[0], f[1]); o.y = pk2(f[2], f[3]); o.z = pk2(f[4], f[5]); o.w = pk2(f[6], f[7]);
              *(LAS v4u*)(VIMG + (ck >> 2) * 8192 + s * 64 + (ck & 3) * 16) = o;
          } }
        LDS_WAIT(); __syncthreads();
        { const int tb = w >> 1, cb0 = 2 * (w & 1), t = 32 * tb + r32;
          f32x16 acc0 = {}, acc1 = {};
          const float* wrow = wsg + ((size_t)g * 128 + t) * 128 + 8 * hi;
          LAS unsigned char* vb = VIMG + cb0 * 8192 + (8 * hi + ((lane & 15) >> 2)) * 64 + 32 * ((lane >> 4) & 1) + 8 * (lane & 3);
          for (int ks = 0; ks < 2 * tb + 2; ++ks) {
              const f32x4 w0 = *(const f32x4*)(wrow + 16 * ks), w1 = *(const f32x4*)(wrow + 16 * ks + 4);
              const int s0 = 16 * ks + 8 * hi;
              float wv[8] = {w0[0], w0[1], w0[2], w0[3], w1[0], w1[1], w1[2], w1[3]};
#pragma unroll
              for (int j = 0; j < 8; ++j) wv[j] = (s0 + j <= t) ? wv[j] : 0.f;
              v4u aw; aw.x = pk2(wv[0], wv[1]); aw.y = pk2(wv[2], wv[3]); aw.z = pk2(wv[4], wv[5]); aw.w = pk2(wv[6], wv[7]);
              const bf16x8 af = __builtin_bit_cast(bf16x8, aw);
              LAS unsigned char* vp = vb + ks * 16 * 64;
              const att::v4i16_t b0l = att::vtr(vp), b0h = att::vtr(vp + 4 * 64), b1l = att::vtr(vp + 8192), b1h = att::vtr(vp + 8192 + 4 * 64);
              const bf16x8 bf0 = (bf16x8){b0l[0], b0l[1], b0l[2], b0l[3], b0h[0], b0h[1], b0h[2], b0h[3]};
              const bf16x8 bf1 = (bf16x8){b1l[0], b1l[1], b1l[2], b1l[3], b1h[0], b1h[1], b1h[2], b1h[3]};
              acc0 = __builtin_amdgcn_mfma_f32_32x32x16_bf16(af, bf0, acc0, 0, 0, 0);
              acc1 = __builtin_amdgcn_mfma_f32_32x32x16_bf16(af, bf1, acc1, 0, 0, 0);
          }
          const float* bp = sb + g * 128 + 32 * tb + 4 * hi;
#pragma unroll
          for (int q4 = 0; q4 < 4; ++q4) { const f32x4 bv = *(const f32x4*)(bp + 8 * q4);
#pragma unroll
              for (int i = 0; i < 4; ++i) { const int r = 4 * q4 + i, tt = 32 * tb + att::crow(r, hi);
                  MT[tt * 132 + 32 * cb0 + r32] = acc0[r] + bv[i]; MT[tt * 132 + 32 * cb0 + 32 + r32] = acc1[r] + bv[i]; } }
        }
        LDS_WAIT(); __syncthreads();
#pragma unroll
        for (int i = 0; i < 4; ++i) {
            const int t = (tid >> 4) + 32 * i;
            const f32x4 m0 = *(const LAS f32x4*)(MT + t * 132 + ck * 8), m1 = *(const LAS f32x4*)(MT + t * 132 + ck * 8 + 4);
            float u[8], z[8]; unpack8(ur[i], u); unpack8(zr[i], z);
            const float mm[8] = {m0[0], m0[1], m0[2], m0[3], m1[0], m1[1], m1[2], m1[3]};
            float y[8];
#pragma unroll
            for (int j = 0; j < 8; ++j) y[j] = gelu_fast(u[j]) * mm[j] * silu_fast(z[j]);
            v4u o; o.x = pk2(y[0], y[1]); o.y = pk2(y[2], y[3]); o.z = pk2(y[4], y[5]); o.w = pk2(y[6], y[7]);
            *(v4u*)(F.ycat + (size_t)(row0 + t) * MIXW + 2048 + chb) = o;
        }
    }
    LDS_WAIT(); __syncthreads();
}


namespace ssd {
constexpr int XIMG = 0, BIMG = 65536, CIMG = 98304, CSOFF = 135168, DTOFF = CSOFF + 2048, YT = 65536, YT_PITCH = 528;
__device__ __forceinline__ void dt_scan(Frame& F, int row0, int g) {
    if (F.wave < 4) {
        const int hl = F.wave, hg = 4 * g + hl, lane = F_LANE, t0 = 2 * lane;
        LAS float* CS = (LAS float*)(F.lds + CSOFF) + hl * 128; LAS float* DTS = (LAS float*)(F.lds + DTOFF) + hl * 128;
        const float a = -__expf(F.in[I_ALOG][hg]);
        const float d0 = F.dt[(size_t)(row0 + t0) * 32 + hg], d1 = F.dt[(size_t)(row0 + t0 + 1) * 32 + hg];
        const float x0 = d0 * a, x1 = d1 * a; float sc = x0 + x1;
#pragma unroll
        for (int o = 1; o < 64; o <<= 1) { const float v = __shfl_up(sc, o); if (lane >= o) sc += v; }
        CS[t0] = sc - x1; CS[t0 + 1] = sc; DTS[t0] = d0; DTS[t0 + 1] = d1;
    }
}
template <bool WITH_C, class Sink>
__device__ __forceinline__ void conv_tile(Frame& F, int row0, int g, bool has_halo, const Sink& sink) {
    const int chunk = F_LANE, seg = F.wave;
    if (!WITH_C && chunk >= 48) return;
    const int ch = chunk < 32 ? g * 256 + chunk * 8 : (chunk < 48 ? 2048 + g * 128 + (chunk - 32) * 8 : 3072 + g * 128 + (chunk - 48) * 8);
    const float* cw = F.in[I_CONVW] + ch; const float* cb = F.in[I_CONVB] + ch;
    float w0[8], w1[8], w2[8], w3[8], bs[8];
#pragma unroll
    for (int j = 0; j < 8; ++j) { w0[j] = cw[j]; w1[j] = cw[XBC_W + j]; w2[j] = cw[2 * XBC_W + j]; w3[j] = cw[3 * XBC_W + j]; bs[j] = cb[j]; }
    const bf16* src = F.proj0 + (size_t)row0 * N1 + C_XBC + ch;
    const int t0 = 16 * seg;
    float r0[8], r1[8], r2[8];
    if (t0 > 0 || has_halo) { unpack8(*(const v4u*)(src + (ptrdiff_t)(t0 - 3) * N1), r0); unpack8(*(const v4u*)(src + (ptrdiff_t)(t0 - 2) * N1), r1); unpack8(*(const v4u*)(src + (ptrdiff_t)(t0 - 1) * N1), r2); }
    else {
#pragma unroll
        for (int j = 0; j < 8; ++j) { r0[j] = 0.f; r1[j] = 0.f; r2[j] = 0.f; } }
#pragma unroll
    for (int hb = 0; hb < 2; ++hb) {
        v4u raw[8];
#pragma unroll
        for (int i = 0; i < 8; ++i) raw[i] = *(const v4u*)(src + (size_t)(t0 + 8 * hb + i) * N1);
#pragma unroll
        for (int i = 0; i < 8; ++i) {
            float cur[8], o[8]; unpack8(raw[i], cur);
#pragma unroll
            for (int j = 0; j < 8; ++j) { const float a = bs[j] + w0[j] * r0[j] + w1[j] * r1[j] + w2[j] * r2[j] + w3[j] * cur[j]; o[j] = silu_fast(a); r0[j] = r1[j]; r1[j] = r2[j]; r2[j] = cur[j]; }
            sink(t0 + 8 * hb + i, 8 * hb + i, chunk, o);
        }
        asm volatile("" ::: "memory");
    }
}
}
__device__ __forceinline__ void ssd_phase_a(Frame& F, float* states, float* cdec) {
    using namespace ssd;
    const int lane = F_LANE, w = F.wave, r32 = lane & 31, hi = lane >> 5;
    LAS unsigned char* lds = F.lds;
    for (int item = (int)blockIdx.x; item < NB * 16 * 8; item += F.G) {
        const int g = item & 7, c = (item >> 3) & 15, b = item >> 7, row0 = b * S + c * 128;
        dt_scan(F, row0, g);
        LDS_WAIT(); __syncthreads();
        { LAS float* CS = (LAS float*)(lds + CSOFF); LAS float* DTS = (LAS float*)(lds + DTOFF);
          if (w == 0 && lane < 4) cdec[(b * 16 + c) * 32 + 4 * g + lane] = __expf(CS[lane * 128 + 127]);
          const bool isx = lane < 32; const int hl = isx ? (lane >> 3) : 0;
          const int abase = isx ? (XIMG + (lane >> 2) * 8192 + (lane & 3) * 16) : (BIMG + ((lane - 32) >> 2) * 8192 + ((lane - 32) & 3) * 16);
          const float csend = CS[hl * 128 + 127];
          conv_tile<false>(F, row0, g, c > 0, [&](int t, int t15, int chunk, float (&o)[8]) {
              const float wt = isx ? DTS[hl * 128 + t] * __expf(csend - CS[hl * 128 + t]) : 1.0f;
              v4u pk; pk.x = pk2(o[0] * wt, o[1] * wt); pk.y = pk2(o[2] * wt, o[3] * wt); pk.z = pk2(o[4] * wt, o[5] * wt); pk.w = pk2(o[6] * wt, o[7] * wt);
              *(LAS v4u*)(lds + abase + t * 64) = pk; }); }
        LDS_WAIT(); __syncthreads();
        { f32x16 acc[4];
#pragma unroll
          for (int i = 0; i < 4; ++i) acc[i] = (f32x16){};
          LAS unsigned char* ab = lds + XIMG + w * 8192 + (8 * hi + ((lane & 15) >> 2)) * 64 + 32 * ((lane >> 4) & 1) + 8 * (lane & 3);
          LAS unsigned char* bb = lds + BIMG + (8 * hi + ((lane & 15) >> 2)) * 64 + 32 * ((lane >> 4) & 1) + 8 * (lane & 3);
#pragma unroll 2
          for (int ks = 0; ks < 8; ++ks) {
              const att::v4i16_t al = att::vtr(ab + ks * 1024), ah = att::vtr(ab + ks * 1024 + 256);
              const bf16x8 af = (bf16x8){al[0], al[1], al[2], al[3], ah[0], ah[1], ah[2], ah[3]};
#pragma unroll
              for (int nb = 0; nb < 4; ++nb) {
                  const att::v4i16_t bl = att::vtr(bb + nb * 8192 + ks * 1024), bh = att::vtr(bb + nb * 8192 + ks * 1024 + 256);
                  const bf16x8 bfr = (bf16x8){bl[0], bl[1], bl[2], bl[3], bh[0], bh[1], bh[2], bh[3]};
                  acc[nb] = __builtin_amdgcn_mfma_f32_32x32x16_bf16(af, bfr, acc[nb], 0, 0, 0);
              }
          }
          float* sp = states + ((size_t)((b * 16 + c) * 32 + 4 * g + (w >> 1)) * 64 + 32 * (w & 1)) * 128;
#pragma unroll
          for (int nb = 0; nb < 4; ++nb)
#pragma unroll
              for (int r = 0; r < 16; ++r) sp[att::crow(r, hi) * 128 + 32 * nb + r32] = acc[nb][r];
        }
        LDS_WAIT(); __syncthreads();
    }
}
__device__ __forceinline__ void ssd_phase_b(Frame& F, const float* states, const float* cdec, bf16* prev) {
    for (int gid = (int)blockIdx.x * (NWAVES * 64) + F_TID; gid < NB * 32 * 64 * 16; gid += F.G * NWAVES * 64) {
        const int nck = gid & 15, p = (gid >> 4) & 63, hg = (gid >> 10) & 31, b = gid >> 15;
        f32x4 h0 = {0.f, 0.f, 0.f, 0.f}, h1 = {0.f, 0.f, 0.f, 0.f};
#pragma unroll 5
        for (int c = 0; c < 15; ++c) {
            const size_t off = ((size_t)((b * 16 + c) * 32 + hg) * 64 + p) * 128 + nck * 8;
            const f32x4 s0 = *(const f32x4*)(states + off), s1 = *(const f32x4*)(states + off + 4);
            const float cd = cdec[(b * 16 + c) * 32 + hg];
            h0 = h0 * cd + s0; h1 = h1 * cd + s1;
            v4u pk; pk.x = pk2(h0[0], h0[1]); pk.y = pk2(h0[2], h0[3]); pk.z = pk2(h1[0], h1[1]); pk.w = pk2(h1[2], h1[3]);
            *(v4u*)(prev + off + (size_t)32 * 64 * 128) = pk;
        }
    }
}
__device__ __forceinline__ void ssd_phase_c(Frame& F, const bf16* prev) {
    using namespace ssd;
    const int lane = F_LANE, w = F.wave, tid = w * 64 + lane, r32 = lane & 31, hi = lane >> 5;
    LAS unsigned char* lds = F.lds;
    const float* dsk = F.in[I_DSKIP]; const float* nw = F.in[I_SSDNW];
    for (int item = (int)blockIdx.x; item < NB * 16 * 8; item += F.G) {
        const int g = item & 7, c = (item >> 3) & 15, b = item >> 7, row0 = b * S + c * 128;
        dt_scan(F, row0, g);
        { const bool isx = lane < 32; const int cc = (lane - 32) & 15;
          const int xbase = XIMG + (lane >> 2) * 8192 + (lane & 3) * 16, bcbase = lane < 48 ? BIMG : CIMG;
          conv_tile<true>(F, row0, g, c > 0, [&](int t, int t15, int chunk, float (&o)[8]) {
              v4u pk; pk.x = pk2(o[0], o[1]); pk.y = pk2(o[2], o[3]); pk.z = pk2(o[4], o[5]); pk.w = pk2(o[6], o[7]);
              const int addr = isx ? (xbase + t * 64) : (bcbase + t * 256 + ((cc ^ t15) << 4));
              *(LAS v4u*)(lds + addr) = pk; }); }
        LDS_WAIT(); __syncthreads();
        {
            const int lb = w & 3, hp = w >> 2, l = 32 * lb + r32;
            LAS float* CS = (LAS float*)(lds + CSOFF); LAS float* DTS = (LAS float*)(lds + DTOFF);
            f32x16 acc[2][2];
#pragma unroll
            for (int j = 0; j < 2; ++j)
#pragma unroll
                for (int pb = 0; pb < 2; ++pb) acc[j][pb] = (f32x16){};
            bf16x8 cf[8];
#pragma unroll
            for (int ks = 0; ks < 8; ++ks) cf[ks] = *(const LAS bf16x8*)(lds + CIMG + l * 256 + (((2 * ks + hi) ^ (l & 15)) << 4));
            float csl[2];
#pragma unroll
            for (int j = 0; j < 2; ++j) csl[j] = CS[(2 * hp + j) * 128 + l];
            if (c > 0) {
#pragma unroll
                for (int j = 0; j < 2; ++j) {
                    const bf16* pp = prev + ((size_t)((b * 16 + c) * 32 + 4 * g + 2 * hp + j) * 64 + r32) * 128 + 8 * hi;
#pragma unroll
                    for (int pb = 0; pb < 2; ++pb) {
#pragma unroll
                        for (int ks = 0; ks < 8; ++ks) {
                            const bf16x8 pf = *(const bf16x8*)(pp + (size_t)pb * 32 * 128 + 16 * ks);
                            acc[j][pb] = __builtin_amdgcn_mfma_f32_32x32x16_bf16(pf, cf[ks], acc[j][pb], 0, 0, 0);
                        }
                    }
                    const float e = __expf(csl[j]);
                    acc[j][0] = acc[j][0] * e; acc[j][1] = acc[j][1] * e;
                }
            }
            LAS unsigned char* xb0 = lds + XIMG + (4 * hi + ((lane & 15) >> 2)) * 64 + 32 * ((lane >> 4) & 1) + 8 * (lane & 3);
            for (int sbk = 0; sbk <= lb; ++sbk) {
                f32x16 X = (f32x16){};
                const int srow = 32 * sbk + r32;
#pragma unroll
                for (int ks = 0; ks < 8; ++ks) {
                    const bf16x8 bfr = *(const LAS bf16x8*)(lds + BIMG + srow * 256 + (((2 * ks + hi) ^ (srow & 15)) << 4));
                    X = __builtin_amdgcn_mfma_f32_32x32x16_bf16(bfr, cf[ks], X, 0, 0, 0);
                }
#pragma unroll
                for (int j = 0; j < 2; ++j) {
                    const int hl = 2 * hp + j;
                    float xh[16];
#pragma unroll
                    for (int q4 = 0; q4 < 4; ++q4) {
                        const f32x4 cs4 = *(const LAS f32x4*)(CS + hl * 128 + 32 * sbk + 8 * q4 + 4 * hi), dt4 = *(const LAS f32x4*)(DTS + hl * 128 + 32 * sbk + 8 * q4 + 4 * hi);
#pragma unroll
                        for (int i = 0; i < 4; ++i) { const int r = 4 * q4 + i, s_ = 32 * sbk + 8 * q4 + 4 * hi + i;
                            const float v = X[r] * __expf(csl[j] - cs4[i]) * dt4[i]; xh[r] = (s_ <= l) ? v : 0.f; }
                    }
                    v4u p0, p1;
                    p0.x = pk2(xh[0], xh[1]); p0.y = pk2(xh[2], xh[3]); p0.z = pk2(xh[4], xh[5]); p0.w = pk2(xh[6], xh[7]);
                    p1.x = pk2(xh[8], xh[9]); p1.y = pk2(xh[10], xh[11]); p1.z = pk2(xh[12], xh[13]); p1.w = pk2(xh[14], xh[15]);
                    const bf16x8 pf0 = __builtin_bit_cast(bf16x8, p0), pf1 = __builtin_bit_cast(bf16x8, p1);
#pragma unroll
                    for (int s2 = 0; s2 < 2; ++s2)
#pragma unroll
                        for (int pb = 0; pb < 2; ++pb) {
                            LAS unsigned char* xp = xb0 + (2 * hl + pb) * 8192 + (32 * sbk + 16 * s2) * 64;
                            const att::v4i16_t lo = att::vtr(xp), hi4 = att::vtr(xp + 8 * 64);
                            const bf16x8 xf = (bf16x8){lo[0], lo[1], lo[2], lo[3], hi4[0], hi4[1], hi4[2], hi4[3]};
                            acc[j][pb] = __builtin_amdgcn_mfma_f32_32x32x16_bf16(xf, s2 == 0 ? pf0 : pf1, acc[j][pb], 0, 0, 0);
                        }
                }
            }
            LDS_WAIT(); __syncthreads();
#pragma unroll
            for (int j = 0; j < 2; ++j)
#pragma unroll
                for (int pb = 0; pb < 2; ++pb)
#pragma unroll
                    for (int q4 = 0; q4 < 4; ++q4) {
                        v2u pk; pk.x = pk2(acc[j][pb][4 * q4], acc[j][pb][4 * q4 + 1]); pk.y = pk2(acc[j][pb][4 * q4 + 2], acc[j][pb][4 * q4 + 3]);
                        *(LAS v2u*)(lds + YT + l * YT_PITCH + ((2 * hp + j) * 64 + 32 * pb + 8 * q4 + 4 * hi) * 2) = pk;
                    }
        }
        LDS_WAIT(); __syncthreads();
        {
            const int ckk = tid & 31, chg = g * 256 + ckk * 8;
            const float Dk = dsk[4 * g + (ckk >> 3)];
            float nwv[8];
#pragma unroll
            for (int j = 0; j < 8; ++j) nwv[j] = nw[chg + j];
#pragma unroll 2
            for (int i = 0; i < 8; ++i) {
                const int t = (tid >> 5) + 16 * i;
                const v4u yr = *(const LAS v4u*)(lds + YT + t * YT_PITCH + ckk * 16);
                const v4u xr = *(const LAS v4u*)(lds + XIMG + (ckk >> 2) * 8192 + t * 64 + (ckk & 3) * 16);
                const v4u zr = *(const v4u*)(F.proj0 + (size_t)(row0 + t) * N1 + C_ZA + chg);
                float y[8], x[8], z[8]; unpack8(yr, y); unpack8(xr, x); unpack8(zr, z);
                float v[8]; float ss = 0.f;
#pragma unroll
                for (int j = 0; j < 8; ++j) { v[j] = (y[j] + Dk * x[j]) * silu_fast(z[j]); ss += v[j] * v[j]; }
#pragma unroll
                for (int o = 1; o < 32; o <<= 1) ss += __shfl_xor(ss, o);
                const float rsv = rsqrtf(ss * (1.0f / 256.0f) + EPS);
                v4u o; o.x = pk2(v[0] * rsv * nwv[0], v[1] * rsv * nwv[1]); o.y = pk2(v[2] * rsv * nwv[2], v[3] * rsv * nwv[3]);
                o.z = pk2(v[4] * rsv * nwv[4], v[5] * rsv * nwv[5]); o.w = pk2(v[6] * rsv * nwv[6], v[7] * rsv * nwv[7]);
                *(v4u*)(F.ycat + (size_t)(row0 + t) * MIXW + chg) = o;
            }
        }
        LDS_WAIT(); __syncthreads();
    }
}

enum Phase { PH_PRO = 0, PH_G1, PH_SSD_A, PH_SSD_B, PH_SSD_C, PH_G2, PH_G3, PH_ATT, PH_G4, PH_FIN, PH_N };
struct Args { const float* in[22]; float* out; unsigned char* ws; int ph_lo, ph_hi, li, pad; };
__global__ void __launch_bounds__(NWAVES * 64, 2) mega(Args args) {
    extern __shared__ __attribute__((aligned(16))) unsigned char lds[];
    Frame F;
    F.lds = (LAS unsigned char*)lds;
    F.MISC = (volatile LAS unsigned*)(F.lds + LDSCTL_OFF);
    F.wave = __builtin_amdgcn_readfirstlane((int)threadIdx.x >> 6); F.G = gridDim.x;
    unsigned char* ws = args.ws;
    F.ctl = (unsigned*)(ws + WS_CTL);
#pragma unroll
    for (int i = 0; i < 22; ++i) F.in[i] = args.in[i];
    F.out = args.out;
    F.Wt_in0 = (bf16*)(ws + WS_WIN0); F.Wt_out0 = (bf16*)(ws + WS_WOUT0); F.Wt_in1 = (bf16*)(ws + WS_WIN1); F.Wt_out1 = (bf16*)(ws + WS_WOUT1);
    F.xb = (bf16*)(ws + WS_XB); F.proj0 = (bf16*)(ws + WS_PROJ0); F.ycat = (bf16*)(ws + WS_YCAT); F.h1b = F.xb; F.qkvg = F.proj0; F.ocat = F.ycat;
    F.dt = (float*)(ws + WS_DT); F.rstd0 = (float*)(ws + WS_RSTD0); F.ssq1 = (float*)(ws + WS_SSQ1); F.ssq2 = (float*)(ws + WS_SSQ2);
    if (threadIdx.x < 64) ((LAS unsigned*)(F.lds + LDSCTL_OFF))[threadIdx.x] = 0u;
    __syncthreads();
    const int lo = args.ph_lo, hi = args.ph_hi;
    XcdBarrier bar; bar.bar = F.ctl + CW_BAR + args.li * XCD_BAR_WORDS; bar.x = 0; bar.st = nullptr;
    if (hi - lo > 1) bar = xcd_barrier_post(F.ctl + CW_BAR + args.li * XCD_BAR_WORDS, F.MISC + 8);
#define IN(k) (lo <= (k) && (k) < hi)
#define SEAM(k) do { if (IN(k) && IN((k) + 1)) xcd_barrier(bar); } while (0)

    if (IN(PH_PRO)) { p0_prologue(F); }
    SEAM(PH_PRO);
    if (IN(PH_G1)) {
        pg8::Gemm g{F.xb, F.Wt_in0, M, N1, D}; pg8::StaticOrder S; S.init(M, N1, F.G, (int)blockIdx.x);
        pg8::EpiRowScaleBf16<1> E{F.proj0, N1, F.rstd0};
        pg8::gemm_phase<pg8::EpiRowScaleBf16<1>, pg8::StaticOrder, true, true>(F.lds, g, S, E);
    }
    SEAM(PH_G1);
    float* sgu_mu = (float*)(ws + WS_SGU_MU); float* sgu_rs = (float*)(ws + WS_SGU_RS);
    float* states = (float*)(ws + WS_STATES); float* cdec = (float*)(ws + WS_CDEC); bf16* prevb = (bf16*)(ws + WS_XB);
    if (IN(PH_SSD_A)) { ssd_phase_a(F, states, cdec); sgu_stats_phase(F, sgu_mu, sgu_rs); }
    SEAM(PH_SSD_A);
    if (IN(PH_SSD_B)) { ssd_phase_b(F, states, cdec, prevb); sgu_phase(F, sgu_mu, sgu_rs); }
    SEAM(PH_SSD_B);
    if (IN(PH_SSD_C)) { ssd_phase_c(F, prevb); }
    SEAM(PH_SSD_C);
    if (IN(PH_G2)) {
        pg8::Gemm g{F.ycat, F.Wt_out0, M, D, MIXW}; pg8::StaticOrder S; S.init(M, D, F.G, (int)blockIdx.x);
        pg8::EpiResid<true> E{F.in[I_X], F.out, F.h1b, F.ssq1, D};
        pg8::gemm_phase<pg8::EpiResid<true>, pg8::StaticOrder, false, true>(F.lds, g, S, E);
    }
    SEAM(PH_G2);
    if (IN(PH_G3)) {
        pg8::Gemm g{F.h1b, F.Wt_in1, M, ODD_IN, D}; pg8::StaticOrder S; S.init(M, ODD_IN, F.G, (int)blockIdx.x);
        pg8::EpiRowScaleBf16<8> E{F.qkvg, ODD_IN, F.ssq1};
        pg8::gemm_phase<pg8::EpiRowScaleBf16<8>, pg8::StaticOrder, true, true>(F.lds, g, S, E);
    }
    SEAM(PH_G3);
    if (IN(PH_ATT)) { attn_phase(F); }
    SEAM(PH_ATT);
    if (IN(PH_G4)) {
        pg8::Gemm g{F.ocat, F.Wt_out1, M, D, MIXW}; pg8::StaticOrder S; S.init(M, D, F.G, (int)blockIdx.x);
        pg8::EpiResid<false> E{F.out, F.out, nullptr, F.ssq2, D};
        pg8::gemm_phase<pg8::EpiResid<false>, pg8::StaticOrder, false, true>(F.lds, g, S, E);
    }
    SEAM(PH_G4);
    if (IN(PH_FIN)) { final_norm(F); }
#undef IN
#undef SEAM
}

extern "C" void kernel_launch(void* const* d_in, const int* in_sizes, int n_in, void* d_out, int out_size, void* d_ws, size_t ws_size, hipStream_t stream) {
    static int grid = 0;
    if (grid == 0) {
        if (n_in != 22 || ws_size < WS_END || out_size != M * D) { fprintf(stderr, "kernel_launch: unexpected n_in %d / out_size %d / ws_size %zu (< %zu)\n", n_in, out_size, ws_size, (size_t)WS_END); grid = -1; return; }
        int dev = 0, cus = 0, per_cu = 0;
        if (hipGetDevice(&dev) != hipSuccess || hipDeviceGetAttribute(&cus, hipDeviceAttributeMultiprocessorCount, dev) != hipSuccess) { fprintf(stderr, "kernel_launch: device query failed\n"); grid = -1; return; }
        if (hipFuncSetAttribute((const void*)mega, hipFuncAttributeMaxDynamicSharedMemorySize, LDS_BYTES) != hipSuccess) { fprintf(stderr, "kernel_launch: hipFuncSetAttribute failed\n"); grid = -1; return; }
        if (hipOccupancyMaxActiveBlocksPerMultiprocessor(&per_cu, (const void*)mega, NWAVES * 64, LDS_BYTES) != hipSuccess || per_cu < 1) { fprintf(stderr, "kernel_launch: occupancy query says %d blocks/CU\n", per_cu); (void)hipGetLastError(); grid = -1; return; }
        if (cus != 256) { fprintf(stderr, "kernel_launch: built for 256 CUs, device has %d\n", cus); grid = -1; return; }
        grid = cus;
    }
    if (grid < 0) return;
    const float* in[22]; for (int i = 0; i < 22; ++i) in[i] = (const float*)d_in[i];
    float* out = (float*)d_out; unsigned char* ws = (unsigned char*)d_ws;
    (void)hipMemsetAsync(ws + WS_CTL, 0, CTL_ZERO_BYTES, stream);
    Args a{};
    for (int i = 0; i < 22; ++i) a.in[i] = in[i];
    a.out = out; a.ws = ws;
    auto launch = [&](int lo, int hi, int li) { a.ph_lo = lo; a.ph_hi = hi; a.li = li; hipLaunchKernelGGL(mega, dim3(grid), dim3(NWAVES * 64), LDS_BYTES, stream, a); };
    launch(PH_PRO, PH_N, 0);
#if defined(EXTRA_LO)
    launch(EXTRA_LO, EXTRA_HI, 1);
#endif
#if defined(EXTRA2_LO)
    launch(EXTRA2_LO, EXTRA2_HI, 2);
#endif
}
```

```cpp
#include <hip/hip_runtime.h>
#include <cstdio>
#include <cstdint>

namespace pg8 {
#define PG8_LAS __attribute__((address_space(3)))
typedef unsigned short bf16_t;
typedef short bf16x8 __attribute__((ext_vector_type(8)));
typedef float f32x4 __attribute__((ext_vector_type(4)));
typedef unsigned u32x4 __attribute__((ext_vector_type(4)));
constexpr int BM = 256, BK = 64, HALF = 128, HTB = HALF * BK * 2  , STAGE_BYTES = 8 * HTB, NXCD = 8, WGM = 8;

__host__ __device__ __forceinline__ int lds_byte(int r, int c) { const int st = (r >> 4) * 2 + (c >> 5), rr = r & 15, cc = c & 31, ob = rr * 64 + cc * 2; return st * 1024 + (ob ^ (((ob >> 9) & 1) << 5)); }
__host__ __device__ __forceinline__ void stage_rc(int b, int& R, int& C) { const int st = b / 1024, sb = b % 1024, swz = sb ^ (((sb >> 9) & 1) << 5); R = (st >> 1) * 16 + swz / 64; C = (st & 1) * 32 + (swz % 64) / 2; }
__host__ __device__ __forceinline__ int perm32(int rho) { const int n = rho >> 4, i = rho & 15; return 8 * (i >> 2) + 4 * n + (i & 3); }

struct Unit { int pm, pn; };
struct Gemm { const bf16_t* A; const bf16_t* Bt; int M, N, K; };

struct StaticOrder {
    int nM, nN, nwg, G, c;
    __host__ __device__ void init(int M, int N, int G_, int c_) { nM = M / BM; nN = N / BM; nwg = nM * nN; G = G_; c = c_; }
    __host__ __device__ bool next(int i, Unit& u) const {
        const long L = (long)i * G + c; if (L >= nwg) return false;
        int wgid = (int)L; { const int q = nwg / NXCD, r = nwg % NXCD, xcd = wgid % NXCD, off = wgid / NXCD; wgid = (xcd < r ? xcd * (q + 1) : r * (q + 1) + (xcd - r) * q) + off; }
        const int nig = WGM * nN, gid = wgid / nig, fm = gid * WGM, gsz = (nM - fm) < WGM ? (nM - fm) : WGM;
        u.pm = fm + ((wgid % nig) % gsz); u.pn = (wgid % nig) / gsz; return true;
    }
    __device__ __forceinline__ void a_ready(const Unit&) const {}
    __device__ __forceinline__ void done(const Unit&) const {}
};

__device__ __forceinline__ unsigned cvt_pk_bf16(float lo, float hi) { unsigned r; asm volatile("v_cvt_pk_bf16_f32 %0, %1, %2" : "=v"(r) : "v"(lo), "v"(hi)); return r; }

constexpr float RMS_EPS = 1e-6f;
template <int NP> struct EpiRowScaleBf16 {
    static constexpr bool PERM = true, AFTER_DRAIN = false;
    bf16_t* O; int ldc; const float* rs;
    __device__ __forceinline__ void operator()(const f32x4 (&acc)[2][2][4][2], const Unit& u, int wr, int wc, int fr, int fq) const {
        const int row0 = u.pm * BM + wr * 64 + fr, col0 = u.pn * BM + wc * 32 + 8 * fq;
#pragma unroll
        for (int ai = 0; ai < 2; ++ai)
#pragma unroll
            for (int m = 0; m < 4; ++m) {
                const int row = row0 + ai * HALF + m * 16;
                float sc;
                if (NP == 1) sc = rs[row];
                else { const f32x4 a = *(const f32x4*)(rs + (size_t)row * 8), b = *(const f32x4*)(rs + (size_t)row * 8 + 4);
                       sc = rsqrtf((((a[0] + a[1]) + (a[2] + a[3])) + ((b[0] + b[1]) + (b[2] + b[3]))) * (1.0f / 2048.0f) + RMS_EPS); }
                bf16_t* rowp = O + (size_t)row * ldc + col0;
#pragma unroll
                for (int bj = 0; bj < 2; ++bj) { const f32x4 v0 = acc[ai][bj][m][0] * sc, v1 = acc[ai][bj][m][1] * sc;
                    u32x4 w; w.x = cvt_pk_bf16(v0[0], v0[1]); w.y = cvt_pk_bf16(v0[2], v0[3]); w.z = cvt_pk_bf16(v1[0], v1[1]); w.w = cvt_pk_bf16(v1[2], v1[3]);
                    *(u32x4*)(rowp + bj * HALF) = w; }
            }
    }
};
template <bool WBF> struct EpiResid {
    static constexpr bool PERM = false, AFTER_DRAIN = true;
    const float* base; float* out; bf16_t* hb; float* ssqp; int ldc;
    __device__ __forceinline__ void fused(f32x4 (&acc)[2][2][4][2], const Unit& u, int wr, int wc, int fr, int fq, PG8_LAS unsigned char* lds, int wid, int lane) const {
        typedef unsigned u32x2v __attribute__((ext_vector_type(2)));
        PG8_LAS float* P = (PG8_LAS float*)lds;
        const int col0 = u.pn * BM + wc * 32 + 4 * fq;
#pragma unroll
        for (int ai = 0; ai < 2; ++ai)
#pragma unroll
            for (int m = 0; m < 4; ++m) {
                const int r = ai * HALF + wr * 64 + m * 16 + fr; const size_t off = (size_t)(u.pm * BM + r) * ldc + col0; float ss = 0.f;
#pragma unroll
                for (int bj = 0; bj < 2; ++bj)
#pragma unroll
                    for (int n = 0; n < 2; ++n) {
                        const f32x4 bs = *(const f32x4*)(base + off + bj * HALF + n * 16); const f32x4 h = bs + acc[ai][bj][m][n];
                        *(f32x4*)(out + off + bj * HALF + n * 16) = h;
                        if (WBF) { u32x2v w; w.x = cvt_pk_bf16(h[0], h[1]); w.y = cvt_pk_bf16(h[2], h[3]); *(u32x2v*)(hb + off + bj * HALF + n * 16) = w; }
                        ss += (h[0] * h[0] + h[1] * h[1]) + (h[2] * h[2] + h[3] * h[3]); }
                ss += __shfl_xor(ss, 16); ss += __shfl_xor(ss, 32);
                if (fq == 0) P[r * 4 + wc] = ss;
                if (m & 1) asm volatile("" ::: "memory");
            }
        asm volatile("s_waitcnt lgkmcnt(0)" ::: "memory"); __builtin_amdgcn_s_barrier(); asm volatile("" ::: "memory");
        const int tid = wid * 64 + lane;
        if (tid < 256) { const f32x4 p = *(const PG8_LAS f32x4*)(P + tid * 4); ssqp[(size_t)(u.pm * BM + tid) * 8 + u.pn] = (p[0] + p[1]) + (p[2] + p[3]); }
    }
};
template <class Epi, class Sched, bool ALIGN_EPI = false, bool SP2 = false>
__device__ __forceinline__ void gemm_phase(PG8_LAS unsigned char* lds, const Gemm g, const Sched& S, const Epi& E) {
    const int tid = threadIdx.x, wid = __builtin_amdgcn_readfirstlane(tid >> 6), lane = tid & 63, wr = wid >> 2, wc = wid & 3, fr = lane & 15, fq = lane >> 4;
    const int K = g.K, nt = K / BK;
    unsigned voffA[2], voffB[2];
#pragma unroll
    for (int i = 0; i < 2; ++i) { int R, C; stage_rc(tid * 16 + i * 8192, R, C); const int Rb = Epi::PERM ? ((R & ~31) + perm32(R & 31)) : R;
        voffA[i] = (unsigned)(R * K + C) * 2u; voffB[i] = (unsigned)(Rb * K + C) * 2u; }
    const size_t kstep = (size_t)(BK * 2);
    const size_t hstep = (size_t)HALF * K * 2;
    const size_t tstep = 2 * hstep;
    const unsigned ldsw = (unsigned)wid * 1024u;
    const int aoff = lds_byte(wr * 64 + fr, fq * 8), boff = lds_byte(wc * 32 + fr, fq * 8);
#define PG8_SA(b, h) (((b) * 2 + (h)) * HTB)
#define PG8_SB(b, h) ((4 + (b) * 2 + (h)) * HTB)
#define PG8_STAGE(bufoff, gbase, voff) do { _Pragma("unroll") for (int _i = 0; _i < 2; ++_i) \
        __builtin_amdgcn_global_load_lds((const unsigned*)((const char*)(gbase) + (voff)[_i]), (PG8_LAS unsigned*)(lds + (bufoff) + ldsw + _i * 8192), 16, 0, 0); } while (0)
#define PG8_LDA(dst, b, h) do { _Pragma("unroll") for (int m = 0; m < 4; ++m) _Pragma("unroll") for (int k = 0; k < 2; ++k) dst[m][k] = *(const PG8_LAS bf16x8*)(lds + PG8_SA(b, h) + aoff + m * 2048 + k * 1024); } while (0)
#define PG8_LDB(dst, b, h) do { _Pragma("unroll") for (int n = 0; n < 2; ++n) _Pragma("unroll") for (int k = 0; k < 2; ++k) dst[n][k] = *(const PG8_LAS bf16x8*)(lds + PG8_SB(b, h) + boff + n * 2048 + k * 1024); } while (0)
#define PG8_MMA(ai, bj, At, Bt) do { __builtin_amdgcn_s_setprio(1); _Pragma("unroll") for (int m = 0; m < 4; ++m) _Pragma("unroll") for (int n = 0; n < 2; ++n) _Pragma("unroll") for (int k = 0; k < 2; ++k) \
        acc[ai][bj][m][n] = __builtin_amdgcn_mfma_f32_16x16x32_bf16(Bt[n][k], At[m][k], acc[ai][bj][m][n], 0, 0, 0); __builtin_amdgcn_s_setprio(0); } while (0)
#define PG8_WAIT_V(n) asm volatile("s_waitcnt vmcnt(" #n ")" ::: "memory")
#define PG8_WAIT_L(n) asm volatile("s_waitcnt lgkmcnt(" #n ")" ::: "memory")
#define PG8_BAR __builtin_amdgcn_s_barrier()
#define PG8_SCHED __builtin_amdgcn_sched_barrier(0)
    Unit cur, nxt; int ui = 0;
    if (!S.next(0, cur)) return;
    f32x4 acc[2][2][4][2];
#pragma unroll
    for (int a = 0; a < 2; ++a)
#pragma unroll
        for (int b = 0; b < 2; ++b)
#pragma unroll
            for (int m = 0; m < 4; ++m)
#pragma unroll
                for (int n = 0; n < 2; ++n) acc[a][b][m][n] = (f32x4){0.f, 0.f, 0.f, 0.f};
    bf16x8 At[4][2], B0[2][2], B1[2][2];
    const char* cA = (const char*)g.A + (size_t)cur.pm * tstep; const char* cB = (const char*)g.Bt + (size_t)cur.pn * tstep;
    S.a_ready(cur);
    if constexpr (SP2) {
        PG8_STAGE(PG8_SB(0, 0), cB, voffB); PG8_STAGE(PG8_SB(0, 1), cB + hstep, voffB); PG8_STAGE(PG8_SA(0, 0), cA, voffA); PG8_STAGE(PG8_SA(0, 1), cA + hstep, voffA);
        if (wr == 1) PG8_BAR;
        PG8_WAIT_V(2); PG8_BAR;
        PG8_STAGE(PG8_SB(1, 0), cB + kstep, voffB); PG8_STAGE(PG8_SA(1, 0), cA + kstep, voffA); PG8_STAGE(PG8_SB(1, 1), cB + hstep + kstep, voffB);
        PG8_WAIT_V(6); PG8_BAR;
    } else {
        PG8_STAGE(PG8_SB(0, 0), cB, voffB); PG8_STAGE(PG8_SA(0, 0), cA, voffA); PG8_STAGE(PG8_SB(0, 1), cB + hstep, voffB); PG8_STAGE(PG8_SA(0, 1), cA + hstep, voffA);
        if (wr == 1) PG8_BAR;
        PG8_WAIT_V(4); PG8_BAR;
        PG8_STAGE(PG8_SB(1, 0), cB + kstep, voffB); PG8_STAGE(PG8_SA(1, 0), cA + kstep, voffA); PG8_STAGE(PG8_SB(1, 1), cB + hstep + kstep, voffB);
        PG8_WAIT_V(6); PG8_BAR;
    }
    for (;;) {
        const bool has_next = S.next(ui + 1, nxt);
        const char* nA = has_next ? (const char*)g.A + (size_t)nxt.pm * tstep : cA; const char* nB = has_next ? (const char*)g.Bt + (size_t)nxt.pn * tstep : cB;
        for (int t = 0; t < nt; t += 2) {
            const bool last = (t == nt - 2);
            const char* a1 = cA + (size_t)(t + 1) * kstep;
            const char* a2 = last ? nA : cA + (size_t)(t + 2) * kstep; const char* b2 = last ? nB : cB + (size_t)(t + 2) * kstep;
            const char* a3 = a2 + kstep; const char* b3 = b2 + kstep;
            if (last && has_next) S.a_ready(nxt);
            if constexpr (SP2) {
            PG8_LDB(B0, 0, 0); PG8_LDB(B1, 0, 1); PG8_SCHED; PG8_LDA(At, 0, 0); PG8_STAGE(PG8_SA(1, 1), a1 + hstep, voffA);
            PG8_WAIT_V(8); PG8_WAIT_L(0); PG8_BAR; PG8_MMA(0, 0, At, B0); PG8_MMA(0, 1, At, B1); PG8_BAR; PG8_SCHED;
            PG8_LDA(At, 0, 1); PG8_STAGE(PG8_SB(0, 0), b2, voffB); PG8_STAGE(PG8_SB(0, 1), b2 + hstep, voffB); PG8_STAGE(PG8_SA(0, 0), a2, voffA);
            PG8_WAIT_V(8); PG8_WAIT_L(0); PG8_BAR; PG8_MMA(1, 0, At, B0); PG8_MMA(1, 1, At, B1); PG8_BAR; PG8_SCHED;
            PG8_LDB(B0, 1, 0); PG8_LDB(B1, 1, 1); PG8_SCHED; PG8_LDA(At, 1, 0); PG8_STAGE(PG8_SA(0, 1), a2 + hstep, voffA);
            PG8_WAIT_V(8); PG8_WAIT_L(0); PG8_BAR; PG8_MMA(0, 0, At, B0); PG8_MMA(0, 1, At, B1); PG8_BAR; PG8_SCHED;
            PG8_LDA(At, 1, 1); PG8_STAGE(PG8_SB(1, 0), b3, voffB); PG8_STAGE(PG8_SB(1, 1), b3 + hstep, voffB); PG8_STAGE(PG8_SA(1, 0), a3, voffA);
            PG8_WAIT_V(8); PG8_WAIT_L(0); PG8_BAR; PG8_MMA(1, 0, At, B0); PG8_MMA(1, 1, At, B1); PG8_BAR; PG8_SCHED;
            } else {
            PG8_LDB(B0, 0, 0); PG8_SCHED; PG8_LDA(At, 0, 0); PG8_STAGE(PG8_SA(1, 1), a1 + hstep, voffA);
            PG8_WAIT_L(8); PG8_BAR; PG8_WAIT_L(0); PG8_MMA(0, 0, At, B0); PG8_BAR; PG8_SCHED;
            PG8_LDB(B1, 0, 1); PG8_STAGE(PG8_SB(0, 0), b2, voffB);
            PG8_BAR; PG8_WAIT_L(0); PG8_MMA(0, 1, At, B1); PG8_BAR;
            PG8_LDA(At, 0, 1); PG8_STAGE(PG8_SA(0, 0), a2, voffA);
            PG8_BAR; PG8_WAIT_L(0); PG8_MMA(1, 0, At, B0); PG8_BAR; PG8_SCHED;
            PG8_STAGE(PG8_SB(0, 1), b2 + hstep, voffB);
            PG8_WAIT_V(6); PG8_BAR; PG8_MMA(1, 1, At, B1); PG8_BAR;
            PG8_LDB(B0, 1, 0); PG8_SCHED; PG8_LDA(At, 1, 0); PG8_STAGE(PG8_SA(0, 1), a2 + hstep, voffA);
            PG8_WAIT_L(8); PG8_BAR; PG8_WAIT_L(0); PG8_MMA(0, 0, At, B0); PG8_BAR; PG8_SCHED;
            PG8_LDB(B1, 1, 1); PG8_STAGE(PG8_SB(1, 0), b3, voffB);
            PG8_BAR; PG8_WAIT_L(0); PG8_MMA(0, 1, At, B1); PG8_BAR;
            PG8_LDA(At, 1, 1); PG8_STAGE(PG8_SA(1, 0), a3, voffA);
            PG8_BAR; PG8_WAIT_L(0); PG8_MMA(1, 0, At, B0); PG8_BAR; PG8_SCHED;
            PG8_STAGE(PG8_SB(1, 1), b3 + hstep, voffB);
            PG8_WAIT_V(6); PG8_BAR; PG8_MMA(1, 1, At, B1); PG8_BAR;
            }
        }
        if constexpr (ALIGN_EPI) { if (wr == 0) PG8_BAR; }
        if constexpr (!Epi::AFTER_DRAIN) { E(acc, cur, wr, wc, fr, fq); S.done(cur); }
        if (!has_next) break;
#pragma unroll
        for (int a = 0; a < 2; ++a)
#pragma unroll
            for (int b = 0; b < 2; ++b)
#pragma unroll
                for (int m = 0; m < 4; ++m)
#pragma unroll
                    for (int n = 0; n < 2; ++n) acc[a][b][m][n] = (f32x4){0.f, 0.f, 0.f, 0.f};
        cur = nxt; cA = nA; cB = nB; ++ui;
        if constexpr (ALIGN_EPI) { if (wr == 1) PG8_BAR; }
    }
    PG8_WAIT_V(0);
    if constexpr (!ALIGN_EPI) { if (wr == 0) PG8_BAR; }
    PG8_BAR;
    if constexpr (Epi::AFTER_DRAIN) { E.fused(acc, cur, wr, wc, fr, fq, lds, wid, lane); S.done(cur); }
#undef PG8_SA
#undef PG8_SB
#undef PG8_STAGE
#undef PG8_LDA
#undef PG8_LDB
#undef PG8_MMA
#undef PG8_WAIT_V
#undef PG8_WAIT_L
#undef PG8_BAR
#undef PG8_SCHED
}

}

constexpr int NB = 4, S = 2048, M = NB * S, D = 2048;
constexpr int EVEN_IN = 12320, N1 = 12288;
constexpr int C_ZA = 0, C_XBC = 2048, C_ZB = 6144, C_U = 8192, C_V = 10240;
constexpr int XBC_W = 4096;
constexpr int ODD_IN = 16384, MIXW = 4096;
constexpr float EPS = 1e-6f;
constexpr float LAMBDA_INIT = 0.35550906759096924f;

constexpr size_t MiB = 1u << 20;
constexpr size_t WS_CTL = 0, CTL_ZERO_BYTES = 1 * MiB;
constexpr size_t WS_WIN0 = 1 * MiB;
constexpr size_t WS_WOUT0 = 49 * MiB;
constexpr size_t WS_WIN1 = 65 * MiB;
constexpr size_t WS_WOUT1 = 129 * MiB;
constexpr size_t WS_XB = 145 * MiB;
constexpr size_t WS_PROJ0 = 177 * MiB;
constexpr size_t WS_STATES = 369 * MiB;
constexpr size_t WS_YCAT = 433 * MiB;
constexpr size_t WS_DT = 497 * MiB;
constexpr size_t WS_RSTD0 = 498 * MiB;
constexpr size_t WS_SGU_MU = WS_RSTD0 + 128 * 1024;
constexpr size_t WS_SGU_RS = WS_SGU_MU + 64 * 1024;
constexpr size_t WS_SSQ1 = WS_RSTD0 + 256 * 1024;
constexpr size_t WS_SSQ2 = WS_RSTD0 + 512 * 1024;
constexpr size_t WS_CDEC = WS_RSTD0 + 768 * 1024;
constexpr size_t WS_END = 499 * MiB;
constexpr int CW_BAR = 4096;

#define GAS __attribute__((address_space(1)))
#define LAS __attribute__((address_space(3)))
typedef unsigned short bf16;
typedef unsigned v4u __attribute__((ext_vector_type(4)));
typedef unsigned v2u __attribute__((ext_vector_type(2)));
typedef float f32x4 __attribute__((ext_vector_type(4)));
typedef float f32x16 __attribute__((ext_vector_type(16)));
typedef short bf16x8 __attribute__((ext_vector_type(8)));
#define LDS_WAIT() asm volatile("s_waitcnt lgkmcnt(0)" ::: "memory")
#define VM_WAIT() asm volatile("s_waitcnt vmcnt(0)" ::: "memory")
__device__ __forceinline__ unsigned pk2(float lo, float hi) { return pg8::cvt_pk_bf16(lo, hi); }
__device__ __forceinline__ float bf2f(bf16 v) { return __uint_as_float(((unsigned)v) << 16); }
__device__ __forceinline__ bf16 f2bf(float f) { unsigned u = __float_as_uint(f); return (bf16)((u + 0x7fffu + ((u >> 16) & 1u)) >> 16); }
__device__ __forceinline__ float sigmoidf_(float v) { return 1.f / (1.f + __expf(-v)); }
__device__ __forceinline__ float siluf_(float v) { return v * sigmoidf_(v); }
__device__ __forceinline__ float geluf_(float v) { const float c = 0.7978845608028654f; float t = tanhf(c * (v + 0.044715f * v * v * v)); return 0.5f * v * (1.f + t); }
__device__ __forceinline__ float softplusf_(float v) { return v > 20.f ? v : log1pf(__expf(v)); }
__device__ __forceinline__ float wave_sum(float v) {
#pragma unroll
    for (int o = 1; o < 64; o <<= 1) v += __shfl_xor(v, o);
    return v;
}

#define XB_TMO      128
#define XB_XCNT(j)  (256  + 64 * (j))
#define XB_XSUB(j)  (1280 + 64 * (j))
#define XB_XGEN(j)  (2304 + 64 * (j))
#define XB_TOP      3328
#define XB_TOPGEN   3392
#define XCD_BAR_WORDS 3456
#define XB_SPIN_CAP (1u << 25)

__device__ __forceinline__ unsigned xb_ld(unsigned* p)              { return __hip_atomic_load(p, __ATOMIC_RELAXED, __HIP_MEMORY_SCOPE_AGENT); }
__device__ __forceinline__ unsigned xb_add(unsigned* p, unsigned v) { return __hip_atomic_fetch_add(p, v, __ATOMIC_RELAXED, __HIP_MEMORY_SCOPE_AGENT); }
__device__ __forceinline__ unsigned xb_xcc_id() { return (unsigned)__builtin_amdgcn_s_getreg((3 << 11) | 20) & 0xFu; }
#define XB_SPIN(cond, bar) do { unsigned _sp = 0; while (cond) { __builtin_amdgcn_s_sleep(1); \
    if ((++_sp & 255u) == 0u) { if (xb_ld(&(bar)[XB_TMO])) break; if (_sp > XB_SPIN_CAP) { atomicAdd(&(bar)[XB_TMO], 1u); break; } } } } while (0)

struct XcdBarrier {
    unsigned* bar; unsigned x;
    volatile LAS unsigned* st;
};

__device__ __forceinline__ XcdBarrier xcd_barrier_post(unsigned* bar, volatile LAS unsigned* st) {
    XcdBarrier b; b.bar = bar; b.x = xb_xcc_id(); b.st = st;
    if (threadIdx.x == 0) (void)xb_add(&bar[XB_XCNT(b.x)], 1u);
    return b;
}
__device__ __forceinline__ void xcd_barrier_complete(unsigned* bar, unsigned x, unsigned& nloc, unsigned& nx) {
    const unsigned G = gridDim.x * gridDim.y * gridDim.z;
    unsigned sum, cnt, mine, sp = 0u;
    for (;;) {
        sum = 0u; cnt = 0u; mine = 0u;
#pragma unroll
        for (unsigned j = 0; j < 16; ++j) { const unsigned c = xb_ld(&bar[XB_XCNT(j)]); sum += c; cnt += (c > 0u) ? 1u : 0u; mine = (j == x) ? c : mine; }
        if (sum == G) break;
        __builtin_amdgcn_s_sleep(1);
        if ((++sp & 255u) == 0u) { if (xb_ld(&bar[XB_TMO])) break; if (sp > XB_SPIN_CAP) { atomicAdd(&bar[XB_TMO], 1u); break; } }
    }
    nloc = mine > 0u ? mine : 1u; nx = cnt > 0u ? cnt : 1u;
}

__device__ __forceinline__ void xcd_barrier(const XcdBarrier& b) {
    asm volatile("s_waitcnt vmcnt(0)" ::: "memory");
    __syncthreads();
    if (threadIdx.x == 0) {
        unsigned* bar = b.bar;
        __builtin_amdgcn_s_waitcnt(0);
        unsigned nloc = b.st[0], nx = b.st[1];
        if (nloc == 0u) { xcd_barrier_complete(bar, b.x, nloc, nx); b.st[0] = nloc; b.st[1] = nx; }
        const unsigned old = xb_add(&bar[XB_XSUB(b.x)], 1u);
        const unsigned gen = old / nloc;
        if (old + 1u == (gen + 1u) * nloc) {
            __builtin_amdgcn_fence(__ATOMIC_RELEASE, "agent");
            asm volatile("s_waitcnt vmcnt(0)" ::: "memory");
            const unsigned og = xb_add(&bar[XB_TOP], 1u);
            const unsigned tg = og / nx;
            if (og + 1u == (tg + 1u) * nx) xb_add(&bar[XB_TOPGEN], 1u);
            else XB_SPIN(xb_ld(&bar[XB_TOPGEN]) == tg, bar);
            __builtin_amdgcn_fence(__ATOMIC_ACQUIRE, "agent");
            xb_add(&bar[XB_XGEN(b.x)], 1u);
            asm volatile("s_waitcnt vmcnt(0)" ::: "memory");
        } else {
            XB_SPIN(xb_ld(&bar[XB_XGEN(b.x)]) == gen, bar);
            __builtin_amdgcn_fence(__ATOMIC_ACQUIRE, "agent");
            asm volatile("s_waitcnt vmcnt(0)" ::: "memory");
        }
    }
    __syncthreads();
}


__device__ __forceinline__ int lane_id() { int l; asm volatile("v_mbcnt_lo_u32_b32 %0, -1, 0\n\tv_mbcnt_hi_u32_b32 %0, -1, %0" : "=v"(l)); return l; }
#define F_LANE lane_id()
#define F_TID (F.wave * 64 + lane_id())
constexpr int NWAVES = 8;
constexpr int LDS_BYTES = 163840;
constexpr int LDSCTL_OFF = LDS_BYTES - 256;
struct Frame {
    LAS unsigned char* lds;
    volatile LAS unsigned* MISC;
    unsigned* ctl;
    int wave, G;
    const float* in[22]; float* out;
    bf16 *Wt_in0, *Wt_out0, *Wt_in1, *Wt_out1, *xb, *proj0, *ycat, *h1b, *qkvg, *ocat;
    float *dt, *rstd0, *ssq1, *ssq2;
};
enum InIdx { I_X = 0, I_NORMW, I_WIN0, I_CONVW, I_CONVB, I_DTB, I_ALOG, I_DSKIP, I_SSDNW, I_LNW, I_LNB, I_SGUWS, I_SGUB, I_WOUT0, I_WIN1, I_LQ1, I_LK1, I_LQ2, I_LK2, I_SUBW, I_WOUT1, I_FW };

__device__ __forceinline__ void p0_transpose_item(const float* W, int ldw, int K, bf16* WT, int nblk, int shift_from, int shift, const float* ksc, LAS float* scr, int item, int lane) {
    const int kb = item / nblk, nb = item % nblk, k0 = 64 * kb, n0 = 32 * nb, ns = n0 + (n0 >= shift_from ? shift : 0);
#pragma unroll 8
    for (int i = 0; i < 32; ++i) { const int kk = 2 * i + (lane >> 5); float v = W[(size_t)(k0 + kk) * ldw + ns + (lane & 31)]; if (ksc) v *= ksc[k0 + kk]; scr[kk * 33 + (lane & 31)] = v; }
    LDS_WAIT(); asm volatile("" ::: "memory");
    const int c = lane & 7;
#pragma unroll
    for (int j = 0; j < 4; ++j) { const int n = (lane >> 3) + 8 * j; const LAS float* s = scr + (8 * c) * 33 + n;
        v4u o; o.x = pk2(s[0 * 33], s[1 * 33]); o.y = pk2(s[2 * 33], s[3 * 33]); o.z = pk2(s[4 * 33], s[5 * 33]); o.w = pk2(s[6 * 33], s[7 * 33]);
        *(GAS v4u*)(WT + (size_t)(n0 + n) * K + k0 + 8 * c) = o; }
    LDS_WAIT(); asm volatile("" ::: "memory");
}
__device__ __forceinline__ void p0_prologue(Frame& F) {
    const int lane0 = F_LANE, tid0 = F.wave * 64 + lane0;
    {
        LAS float* scr = (LAS float*)(F.lds + F.wave * 16384);
        const int gw = (int)blockIdx.x * NWAVES + F.wave, NGW = F.G * NWAVES;
        constexpr int I_A = (D / 64) * (N1 / 32), I_B = (MIXW / 64) * (D / 32), I_C = (D / 64) * (ODD_IN / 32), I_D = I_B;
        constexpr int NITEMS = I_A + I_B + I_C + I_D;
        const float* nw = F.in[I_NORMW];
        for (int it = gw; it < NITEMS; it += NGW) {
            int r = it;
            if (r < I_A) { p0_transpose_item(F.in[I_WIN0], EVEN_IN, D, F.Wt_in0, N1 / 32, 6144, 32, nw, scr, r, lane0); continue; } r -= I_A;
            if (r < I_B) { p0_transpose_item(F.in[I_WOUT0], D, MIXW, F.Wt_out0, D / 32, 1 << 30, 0, nullptr, scr, r, lane0); continue; } r -= I_B;
            if (r < I_C) { p0_transpose_item(F.in[I_WIN1], ODD_IN, D, F.Wt_in1, ODD_IN / 32, 1 << 30, 0, nw + D, scr, r, lane0); continue; } r -= I_C;
            p0_transpose_item(F.in[I_WOUT1], D, MIXW, F.Wt_out1, D / 32, 1 << 30, 0, nullptr, scr, r, lane0);
        }
    }
    __syncthreads();
    constexpr int TROW = 4112;
    LAS unsigned char* tile = F.lds;
    LAS float* rst = (LAS float*)(F.lds + 32 * TROW);
    const float* x = F.in[I_X]; const float* nw0 = F.in[I_NORMW]; const float* wdt = F.in[I_WIN0] + 6144; const float* dtb = F.in[I_DTB];
    for (int blk = blockIdx.x; blk < M / 32; blk += F.G) {
        for (int i = 0; i < 4; ++i) {
            const int rl = F.wave * 4 + i, row = blk * 32 + rl;
            const GAS f32x4* xr = (const GAS f32x4*)(x + (size_t)row * D) + lane0;
            f32x4 v[8]; float ss = 0.f;
#pragma unroll
            for (int j = 0; j < 8; ++j) { v[j] = xr[64 * j]; ss += (v[j][0] * v[j][0] + v[j][1] * v[j][1]) + (v[j][2] * v[j][2] + v[j][3] * v[j][3]); }
            ss = wave_sum(ss);
            const float rstd = rsqrtf(ss * (1.0f / D) + EPS);
            if (lane0 == 0) { F.rstd0[row] = rstd; rst[rl] = rstd; }
            GAS v2u* o8 = (GAS v2u*)(F.xb + (size_t)row * D) + lane0;
#pragma unroll
            for (int j = 0; j < 8; ++j) { v2u w; w.x = pk2(v[j][0], v[j][1]); w.y = pk2(v[j][2], v[j][3]); o8[64 * j] = w; *(LAS v2u*)(tile + rl * TROW + (64 * j + lane0) * 8) = w; }
        }
        LDS_WAIT(); __syncthreads();
        const int r32 = lane0 & 31, hi = lane0 >> 5;
        f32x16 acc = {};
        for (int ks = 0; ks < 16; ++ks) {
            const int k0 = 256 * F.wave + 16 * ks + 8 * hi;
            const bf16x8 a = *(const LAS bf16x8*)(tile + r32 * TROW + k0 * 2);
            float wv[8];
#pragma unroll
            for (int j = 0; j < 8; ++j) wv[j] = wdt[(size_t)(k0 + j) * EVEN_IN + r32] * nw0[k0 + j];
            v4u bw; bw.x = pk2(wv[0], wv[1]); bw.y = pk2(wv[2], wv[3]); bw.z = pk2(wv[4], wv[5]); bw.w = pk2(wv[6], wv[7]);
            acc = __builtin_amdgcn_mfma_f32_32x32x16_bf16(a, __builtin_bit_cast(bf16x8, bw), acc, 0, 0, 0);
        }
        LDS_WAIT(); __syncthreads();
        LAS float* red = (LAS float*)F.lds;
#pragma unroll
        for (int r = 0; r < 16; ++r) { const int row = (r & 3) + 8 * (r >> 2) + 4 * hi; red[(F.wave * 32 + row) * 33 + r32] = acc[r]; }
        LDS_WAIT(); __syncthreads();
        for (int idx = tid0; idx < 1024; idx += NWAVES * 64) {
            const int row = idx >> 5, h = idx & 31; float s = 0.f;
#pragma unroll
            for (int w = 0; w < 8; ++w) s += red[(w * 32 + row) * 33 + h];
            F.dt[(size_t)(blk * 32 + row) * 32 + h] = softplusf_(s * rst[row] + dtb[h]);
        }
        LDS_WAIT(); __syncthreads();
    }
}
__device__ __forceinline__ void final_norm(Frame& F) {
    const int gw = (int)blockIdx.x * NWAVES + F.wave, NGW = F.G * NWAVES;
    const int lane0 = F_LANE;
    const GAS f32x4* fw = (const GAS f32x4*)F.in[I_FW] + lane0;
    for (int row = gw; row < M; row += NGW) {
        GAS f32x4* o = (GAS f32x4*)(F.out + (size_t)row * D) + lane0;
        const f32x4 a = *(const f32x4*)(F.ssq2 + (size_t)row * 8), b = *(const f32x4*)(F.ssq2 + (size_t)row * 8 + 4);
        const float rs = rsqrtf((((a[0] + a[1]) + (a[2] + a[3])) + ((b[0] + b[1]) + (b[2] + b[3]))) * (1.0f / D) + EPS);
        f32x4 v[8];
#pragma unroll
        for (int j = 0; j < 8; ++j) v[j] = o[64 * j];
#pragma unroll
        for (int j = 0; j < 8; ++j) o[64 * j] = v[j] * rs * fw[64 * j];
    }
}


__device__ __forceinline__ float gelu_fast(float v) { const float z = 0.7978845608028654f * (v + 0.044715f * v * v * v); return v * __builtin_amdgcn_rcpf(1.0f + __expf(-2.0f * z)); }
__device__ __forceinline__ float silu_fast(float v) { return v * __builtin_amdgcn_rcpf(1.0f + __expf(-v)); }
__device__ __forceinline__ void unpack8(const v4u r, float (&f)[8]) {
    f[0] = __uint_as_float(r.x << 16); f[1] = __uint_as_float(r.x & 0xffff0000u); f[2] = __uint_as_float(r.y << 16); f[3] = __uint_as_float(r.y & 0xffff0000u);
    f[4] = __uint_as_float(r.z << 16); f[5] = __uint_as_float(r.z & 0xffff0000u); f[6] = __uint_as_float(r.w << 16); f[7] = __uint_as_float(r.w & 0xffff0000u);
}
namespace att {
constexpr int STAGE = 32768, KOFF = 8192, VOFF = 16384, NSTG = 4;
constexpr float CEXP = 0.08838834764831845f * 1.4426950408889634f;
typedef short v4i16_t __attribute__((ext_vector_type(4)));
__device__ __forceinline__ v4i16_t vtr(LAS unsigned char* p) { return __builtin_amdgcn_ds_read_tr16_b64_v4i16((LAS v4i16_t*)p); }
__device__ __forceinline__ float swap_max(float v) { auto rr = __builtin_amdgcn_permlane32_swap(__float_as_uint(v), __float_as_uint(v), false, false); return fmaxf(__uint_as_float(rr[0]), __uint_as_float(rr[1])); }
__device__ __forceinline__ float swap_sum(float v) { auto rr = __builtin_amdgcn_permlane32_swap(__float_as_uint(v), __float_as_uint(v), false, false); return __uint_as_float(rr[0]) + __uint_as_float(rr[1]); }
__device__ __forceinline__ int crow(int r, int hi) { return (r & 3) + 8 * (r >> 2) + 4 * hi; }
__device__ __forceinline__ void glds16(const void* gsrc, unsigned lds_dst) { unsigned keep;
    asm volatile("s_mov_b32 %0, m0\n\ts_mov_b32 m0, %2\n\ts_nop 0\n\tglobal_load_lds_dwordx4 %1, off\n\ts_mov_b32 m0, %0" : "=&s"(keep) : "v"(gsrc), "s"(lds_dst) : "memory"); }
}
template <int VAR> __device__ __forceinline__ void attn_phase(Frame& F) {
    using namespace att;
    const int w = F.wave, map = w >> 2, sb = w & 3;
    LAS unsigned char* lds = F.lds;
    const bf16* qkvg = F.qkvg;
    const int vcu = ((int)blockIdx.x & 7) * (F.G >> 3) + ((int)blockIdx.x >> 3);
    for (int vu = vcu; vu < 64 * 4; vu += F.G) {
        const int bh = vu >> 2, s4 = vu & 3, b = bh >> 4, h = bh & 15;
        for (int ui = 0; ui < 4; ++ui) {
            const int qb = ui == 0 ? 15 - s4 : (ui == 1 ? 11 - s4 : (ui == 2 ? 4 + s4 : s4));
            const int q0 = qb * 128, NH = (q0 + 128) / 32, rb = q0 / 32 + sb;
            const int lane = F_LANE;
            const int r32 = lane & 31, hi = lane >> 5;
            const unsigned koff = (unsigned)((4 * w + (lane >> 4)) * ODD_IN + (((lane & 15) ^ ((4 * w + (lane >> 4)) & 15)) * 8));
            const unsigned voff0 = (unsigned)((lane >> 2) * ODD_IN + 32 * w + 8 * (lane & 3));
            const int kq = 4 * hi + ((lane & 15) >> 2);
            const int kbase = map * KOFF + r32 * 256, kswz = r32 & 15;
            const int vbase = VOFF + kq * 64 + 32 * ((lane >> 4) & 1) + 8 * (lane & 3);
            const bf16* kg = qkvg + (size_t)b * S * ODD_IN + 4096 + h * 256;
            const bf16* vg = qkvg + (size_t)b * S * ODD_IN + 8192 + h * 256;
            f32x16 O[8];
#pragma unroll
            for (int i = 0; i < 8; ++i) O[i] = (f32x16){};
            float m = -1e30f, l = 0.f;
            const unsigned lds0 = (unsigned)(uintptr_t)lds;
#define ATT_ISSUE(i_) do { const size_t _ro = (size_t)(i_) * 32 * ODD_IN; const unsigned _sb = lds0 + (unsigned)(((i_) & (NSTG - 1)) * STAGE); \
                glds16(kg + _ro + koff, (unsigned)__builtin_amdgcn_readfirstlane(_sb + w * 1024)); \
                glds16(kg + _ro + 128 + koff, (unsigned)__builtin_amdgcn_readfirstlane(_sb + KOFF + w * 1024)); \
                glds16(vg + _ro + voff0, (unsigned)__builtin_amdgcn_readfirstlane(_sb + VOFF + (2 * w) * 1024)); \
                glds16(vg + _ro + voff0 + (size_t)16 * ODD_IN, (unsigned)__builtin_amdgcn_readfirstlane(_sb + VOFF + (2 * w + 1) * 1024)); } while (0)
            if (VAR != 1) { ATT_ISSUE(0); ATT_ISSUE(1); ATT_ISSUE(2); }
            bf16x8 qf[8];
            { const bf16* qp = qkvg + ((size_t)b * S + q0 + 32 * sb + r32) * ODD_IN + h * 256 + map * 128 + 8 * hi;
#pragma unroll
              for (int ks = 0; ks < 8; ++ks) qf[ks] = *(const bf16x8*)(qp + 16 * ks); }
            asm volatile("s_waitcnt vmcnt(0)" ::: "memory");
#pragma unroll
            for (int ks = 0; ks < 8; ++ks) asm volatile("" : "+v"(qf[ks]));
            for (int hidx = 0; hidx < NH; ++hidx) {
                if (VAR == 1) {} else if (hidx + 2 < NH) asm volatile("s_waitcnt vmcnt(8)" ::: "memory"); else if (hidx + 1 < NH) asm volatile("s_waitcnt vmcnt(4)" ::: "memory"); else asm volatile("s_waitcnt vmcnt(0)" ::: "memory");
                asm volatile("s_waitcnt lgkmcnt(0)" ::: "memory"); if (VAR != 4) __builtin_amdgcn_s_barrier(); asm volatile("" ::: "memory");
                if (VAR != 1 && hidx + 3 < NH) ATT_ISSUE(hidx + 3);
                LAS unsigned char* st = lds + (hidx & (NSTG - 1)) * STAGE;
                {
                    if (hidx <= rb) {
                        f32x16 p = (f32x16){};
                        bf16x8 kf[8];
#pragma unroll
                        for (int ks = 0; ks < 8; ++ks) kf[ks] = *(const LAS bf16x8*)(st + kbase + (((2 * ks + hi) ^ kswz) << 4));
                        __builtin_amdgcn_sched_barrier(0);
#pragma unroll
                        for (int ks = 0; ks < 8; ++ks) p = __builtin_amdgcn_mfma_f32_32x32x16_bf16(kf[ks], qf[ks], p, 0, 0, 0);
#define ATT_VLOAD(dst, vp_, b0) _Pragma("unroll") for (int _b = 0; _b < 4; ++_b) { dst[_b][0] = vtr((vp_) + ((b0) + _b) * 2048); dst[_b][1] = vtr((vp_) + ((b0) + _b) * 2048 + 8 * 64); }
#define ATT_VFRAG(src, i) ((bf16x8){src[i][0][0], src[i][0][1], src[i][0][2], src[i][0][3], src[i][1][0], src[i][1][1], src[i][1][2], src[i][1][3]})
                        LAS unsigned char* vp0 = st + vbase;
                        att::v4i16_t va[4][2];
                        ATT_VLOAD(va, vp0, 0);
                        __builtin_amdgcn_sched_barrier(0);
                        if (VAR != 3) {
                        if (hidx == rb) {
#pragma unroll
                            for (int r = 0; r < 16; ++r) if (crow(r, hi) > r32) p[r] = -INFINITY;
                        }
                        float tm = p[0];
#pragma unroll
                        for (int r = 1; r < 16; ++r) tm = fmaxf(tm, p[r]);
                        tm = swap_max(tm);
                        if (__any((tm - m) * CEXP > 8.0f)) {
                            const float mn = fmaxf(m, tm);
                            const float al = __builtin_amdgcn_exp2f((m - mn) * CEXP);
                            l *= al;
#pragma unroll
                            for (int i = 0; i < 8; ++i) O[i] = O[i] * al;
                            m = mn;
                        }
                        const float mc = -m * CEXP;
                        float ls = 0.f;
#pragma unroll
                        for (int r = 0; r < 16; ++r) { p[r] = __builtin_amdgcn_exp2f(__builtin_fmaf(p[r], CEXP, mc)); ls += p[r]; }
                        l += ls;
                        }
                        v4u pw0, pw1;
                        pw0.x = pk2(p[0], p[1]); pw0.y = pk2(p[2], p[3]); pw0.z = pk2(p[4], p[5]); pw0.w = pk2(p[6], p[7]);
                        pw1.x = pk2(p[8], p[9]); pw1.y = pk2(p[10], p[11]); pw1.z = pk2(p[12], p[13]); pw1.w = pk2(p[14], p[15]);
                        const bf16x8 pf0 = __builtin_bit_cast(bf16x8, pw0), pf1 = __builtin_bit_cast(bf16x8, pw1);
                        __builtin_amdgcn_sched_barrier(0);
                        if (VAR == 2) { asm volatile("" :: "v"(pf0), "v"(pf1), "v"(va[0][0]), "v"(va[1][0]), "v"(va[2][1]), "v"(va[3][1])); } else
                        { att::v4i16_t vb2[4][2];
                          ATT_VLOAD(vb2, vp0, 4);
#pragma unroll
                          for (int blk = 0; blk < 4; ++blk) O[blk] = __builtin_amdgcn_mfma_f32_32x32x16_bf16(ATT_VFRAG(va, blk), pf0, O[blk], 0, 0, 0);
                          __builtin_amdgcn_sched_barrier(0);
                          ATT_VLOAD(va, vp0 + 16 * 64, 0);
#pragma unroll
                          for (int blk = 0; blk < 4; ++blk) O[4 + blk] = __builtin_amdgcn_mfma_f32_32x32x16_bf16(ATT_VFRAG(vb2, blk), pf0, O[4 + blk], 0, 0, 0);
                          __builtin_amdgcn_sched_barrier(0);
                          ATT_VLOAD(vb2, vp0 + 16 * 64, 4);
#pragma unroll
                          for (int blk = 0; blk < 4; ++blk) O[blk] = __builtin_amdgcn_mfma_f32_32x32x16_bf16(ATT_VFRAG(va, blk), pf1, O[blk], 0, 0, 0);
                          __builtin_amdgcn_sched_barrier(0);
#pragma unroll
                          for (int blk = 0; blk < 4; ++blk) O[4 + blk] = __builtin_amdgcn_mfma_f32_32x32x16_bf16(ATT_VFRAG(vb2, blk), pf1, O[4 + blk], 0, 0, 0);
                        }
#undef ATT_VLOAD
#undef ATT_VFRAG
                        __builtin_amdgcn_sched_barrier(0);
                    }
                }
            }
#undef ATT_ISSUE
            const float ltot = swap_sum(l);
            float lam = 1.0f;
            if (map == 1) { const float* lq1 = F.in[I_LQ1]; const float* lk1 = F.in[I_LK1]; const float* lq2 = F.in[I_LQ2]; const float* lk2 = F.in[I_LK2];
                float l1 = lq1[lane] * lk1[lane] + lq1[lane + 64] * lk1[lane + 64], l2 = lq2[lane] * lk2[lane] + lq2[lane + 64] * lk2[lane + 64];
                l1 = wave_sum(l1); l2 = wave_sum(l2); lam = __expf(l1) - __expf(l2) + LAMBDA_INIT; }
            const float inv = lam / ltot;
            const int ch = lane & 31;
            v4u gv[8];
#pragma unroll
            for (int it = 0; it < 8; ++it) gv[it] = *(const v4u*)(qkvg + ((size_t)b * S + q0 + 32 * sb + 16 * map + it * 2 + (lane >> 5)) * ODD_IN + 12288 + h * 256 + ch * 8);
            LDS_WAIT(); __syncthreads();
            constexpr int XP = 1040;
            LAS unsigned char* X = lds + sb * (32 * XP);
            if (map == 1) {
#pragma unroll
                for (int blk = 0; blk < 8; ++blk)
#pragma unroll
                    for (int g4 = 0; g4 < 4; ++g4) {
                        const f32x4 v = {O[blk][4 * g4] * inv, O[blk][4 * g4 + 1] * inv, O[blk][4 * g4 + 2] * inv, O[blk][4 * g4 + 3] * inv};
                        *(LAS f32x4*)(X + r32 * XP + (32 * blk + 8 * g4 + 4 * hi) * 4) = v;
                    }
            }
            LDS_WAIT(); __syncthreads();
            LAS unsigned char* T = X;
            if (map == 0) {
                float ss = 0.f;
#pragma unroll
                for (int blk = 0; blk < 8; ++blk)
#pragma unroll
                    for (int g4 = 0; g4 < 4; ++g4) {
                        const f32x4 xv = *(const LAS f32x4*)(X + r32 * XP + (32 * blk + 8 * g4 + 4 * hi) * 4);
#pragma unroll
                        for (int i = 0; i < 4; ++i) { const float o = O[blk][4 * g4 + i] * inv - xv[i]; O[blk][4 * g4 + i] = o; ss += o * o; }
                    }
                ss = swap_sum(ss);
                const float rsv = rsqrtf(ss * (1.0f / 256.0f) + EPS) * (1.0f - LAMBDA_INIT);
                LDS_WAIT();
#pragma unroll
                for (int blk = 0; blk < 8; ++blk)
#pragma unroll
                    for (int g4 = 0; g4 < 4; ++g4) {
                        v2u pk; pk.x = pk2(O[blk][4 * g4] * rsv, O[blk][4 * g4 + 1] * rsv); pk.y = pk2(O[blk][4 * g4 + 2] * rsv, O[blk][4 * g4 + 3] * rsv);
                        *(LAS v2u*)(T + r32 * 528 + (32 * blk + 8 * g4 + 4 * hi) * 2) = pk;
                    }
            }
            LDS_WAIT(); __syncthreads();
            {
                const float* subw = F.in[I_SUBW];
                const f32x4 sw0 = *(const f32x4*)(subw + ch * 8), sw1 = *(const f32x4*)(subw + ch * 8 + 4);
#pragma unroll
                for (int it = 0; it < 8; ++it) {
                    const int row = 16 * map + it * 2 + (lane >> 5);
                    const size_t grow = (size_t)b * S + q0 + 32 * sb + row;
                    const v4u ov = *(const LAS v4u*)(T + row * 528 + ch * 16);
                    float o8[8], g8[8]; unpack8(ov, o8); unpack8(gv[it], g8);
                    v4u res;
                    res.x = pk2(o8[0] * sw0[0] * silu_fast(g8[0]), o8[1] * sw0[1] * silu_fast(g8[1]));
                    res.y = pk2(o8[2] * sw0[2] * silu_fast(g8[2]), o8[3] * sw0[3] * silu_fast(g8[3]));
                    res.z = pk2(o8[4] * sw1[0] * silu_fast(g8[4]), o8[5] * sw1[1] * silu_fast(g8[5]));
                    res.w = pk2(o8[6] * sw1[2] * silu_fast(g8[6]), o8[7] * sw1[3] * silu_fast(g8[7]));
                    *(v4u*)(F.ocat + grow * MIXW + h * 256 + ch * 8) = res;
                }
            }
            LDS_WAIT(); __syncthreads();
        }
    }
}


__device__ __forceinline__ void sgu_stats_phase(Frame& F, float* mu, float* rs) {
    const int gw = (int)blockIdx.x * NWAVES + F.wave, NGW = F.G * NWAVES, lane = F_LANE;
    for (int row = gw; row < M; row += NGW) {
        const v4u* vp = (const v4u*)(F.proj0 + (size_t)row * N1 + C_V) + lane;
        float g[32]; float sm = 0.f;
#pragma unroll
        for (int i = 0; i < 4; ++i) { float f[8]; unpack8(vp[64 * i], f);
#pragma unroll
            for (int j = 0; j < 8; ++j) { g[8 * i + j] = gelu_fast(f[j]); sm += g[8 * i + j]; } }
        const float mean = wave_sum(sm) * (1.0f / 2048.0f);
        float q = 0.f;
#pragma unroll
        for (int i = 0; i < 32; ++i) { const float d = g[i] - mean; q += d * d; }
        const float var = wave_sum(q) * (1.0f / 2048.0f);
        if (lane == 0) { mu[row] = mean; rs[row] = rsqrtf(var + EPS); }
    }
}
__device__ __forceinline__ void sgu_phase(Frame& F, const float* mu, const float* rs) {
    const int lane = F_LANE, tid = F.wave * 64 + lane, w = F.wave, r32 = lane & 31, hi = lane >> 5;
    LAS unsigned char* lds = F.lds;
    LAS unsigned char* VIMG = lds;
    LAS float* MT = (LAS float*)(lds + 32768);
    const bf16* proj0 = F.proj0; const float* ln_w = F.in[I_LNW]; const float* ln_b = F.in[I_LNB]; const float* wsg = F.in[I_SGUWS]; const float* sb = F.in[I_SGUB];
    const int ck = tid & 15;
    for (int item = (int)blockIdx.x; item < 64 * 16; item += F.G) {
        const int g = item & 15, row0 = (item >> 4) * 128;
        const int chb = g * 128 + ck * 8;
        v4u ur[4], zr[4];
        { float lw[8], lb[8];
#pragma unroll
          for (int j = 0; j < 8; ++j) { lw[j] = ln_w[chb + j]; lb[j] = ln_b[chb + j]; }
#pragma unroll
          for (int i = 0; i < 4; ++i) {
              const int s = (tid >> 4) + 32 * i; const size_t ro = (size_t)(row0 + s) * N1;
              const v4u vr = *(const v4u*)(proj0 + ro + C_V + chb);
              ur[i] = *(const v4u*)(proj0 + ro + C_U + chb); zr[i] = *(const v4u*)(proj0 + ro + C_ZB + chb);
              const float m_ = mu[row0 + s], r_ = rs[row0 + s];
              float f[8]; unpack8(vr, f);
#pragma unroll
              for (int j = 0; j < 8; ++j) f[j] = (gelu_fast(f[j]) - m_) * r_ * lw[j] + lb[j];
              v4u o; o.x = pk2(f[0], f[1]); o.y = pk2(f[2], f[3]); o.z = pk2(f[4], f[5]); o.w = pk2(f[6], f[7]);
              *(LAS v4u*)(VIMG + (ck >> 2) * 8192 + s * 64 + (ck & 3) * 16) = o;
          } }
        LDS_WAIT(); __syncthreads();
        { const int tb = w >> 1, cb0 = 2 * (w & 1), t = 32 * tb + r32;
          f32x16 acc0 = {}, acc1 = {};
          const float* wrow = wsg + ((size_t)g * 128 + t) * 128 + 8 * hi;
          LAS unsigned char* vb = VIMG + cb0 * 8192 + (8 * hi + ((lane & 15) >> 2)) * 64 + 32 * ((lane >> 4) & 1) + 8 * (lane & 3);
          for (int ks = 0; ks < 2 * tb + 2; ++ks) {
              const f32x4 w0 = *(const f32x4*)(wrow + 16 * ks), w1 = *(const f32x4*)(wrow + 16 * ks + 4);
              const int s0 = 16 * ks + 8 * hi;
              float wv[8] = {w0[0], w0[1], w0[2], w0[3], w1[0], w1[1], w1[2], w1[3]};
#pragma unroll
              for (int j = 0; j < 8; ++j) wv[j] = (s0 + j <= t) ? wv[j] : 0.f;
              v4u aw; aw.x = pk2(wv[0], wv[1]); aw.y = pk2(wv[2], wv[3]); aw.z = pk2(wv[4], wv[5]); aw.w = pk2(wv[6], wv[7]);
              const bf16x8 af = __builtin_bit_cast(bf16x8, aw);
              LAS unsigned char* vp = vb + ks * 16 * 64;
              const att::v4i16_t b0l = att::vtr(vp), b0h = att::vtr(vp + 4 * 64), b1l = att::vtr(vp + 8192), b1h = att::vtr(vp + 8192 + 4 * 64);
              const bf16x8 bf0 = (bf16x8){b0l[0], b0l[1], b0l[2], b0l[3], b0h[0], b0h[1], b0h[2], b0h[3]};
              const bf16x8 bf1 = (bf16x8){b1l[0], b1l[1], b1l[2], b1l[3], b1h[0], b1h[1], b1h[2], b1h[3]};
              acc0 = __builtin_amdgcn_mfma_f32_32x32x16_bf16(af, bf0, acc0, 0, 0, 0);
              acc1 = __builtin_amdgcn_mfma_f32_32x32x16_bf16(af, bf1, acc1, 0, 0, 0);
          }
          const float* bp = sb + g * 128 + 32 * tb + 4 * hi;
#pragma unroll
          for (int q4 = 0; q4 < 4; ++q4) { const f32x4 bv = *(const f32x4*)(bp + 8 * q4);
#pragma unroll
              for (int i = 0; i < 4; ++i) { const int r = 4 * q4 + i, tt = 32 * tb + att::crow(r, hi);
                  MT[tt * 132 + 32 * cb0 + r32] = acc0[r] + bv[i]; MT[tt * 132 + 32 * cb0 + 32 + r32] = acc1[r] + bv[i]; } }
        }
        LDS_WAIT(); __syncthreads();
#pragma unroll
        for (int i = 0; i < 4; ++i) {
            const int t = (tid >> 4) + 32 * i;
            const f32x4 m0 = *(const LAS f32x4*)(MT + t * 132 + ck * 8), m1 = *(const LAS f32x4*)(MT + t * 132 + ck * 8 + 4);
            float u[8], z[8]; unpack8(ur[i], u); unpack8(zr[i], z);
            const float mm[8] = {m0[0], m0[1], m0[2], m0[3], m1[0], m1[1], m1[2], m1[3]};
            float y[8];
#pragma unroll
            for (int j = 0; j < 8; ++j) y[j] = gelu_fast(u[j]) * mm[j] * silu_fast(z[j]);
            v4u o; o.x = pk2(y[0], y[1]); o.y = pk2(y[2], y[3]); o.z = pk2(y[4], y[5]); o.w = pk2(y[6], y[7]);
            *(v4u*)(F.ycat + (size_t)(row0 + t) * MIXW + 2048 + chb) = o;
        }
    }
    LDS_WAIT(); __syncthreads();
}


namespace ssd {
constexpr int XIMG = 0, BIMG = 65536, CIMG = 98304, CSOFF = 135168, DTOFF = CSOFF + 2048, YT = 65536, YT_PITCH = 528;
__device__ __forceinline__ void dt_scan(Frame& F, int row0, int g) {
    if (F.wave < 4) {
        const int hl = F.wave, hg = 4 * g + hl, lane = F_LANE, t0 = 2 * lane;
        LAS float* CS = (LAS float*)(F.lds + CSOFF) + hl * 128; LAS float* DTS = (LAS float*)(F.lds + DTOFF) + hl * 128;
        const float a = -__expf(F.in[I_ALOG][hg]);
        const float d0 = F.dt[(size_t)(row0 + t0) * 32 + hg], d1 = F.dt[(size_t)(row0 + t0 + 1) * 32 + hg];
        const float x0 = d0 * a, x1 = d1 * a; float sc = x0 + x1;
#pragma unroll
        for (int o = 1; o < 64; o <<= 1) { const float v = __shfl_up(sc, o); if (lane >= o) sc += v; }
        CS[t0] = sc - x1; CS[t0 + 1] = sc; DTS[t0] = d0; DTS[t0 + 1] = d1;
    }
}
template <bool WITH_C, class Sink>
__device__ __forceinline__ void conv_tile(Frame& F, int row0, int g, bool has_halo, const Sink& sink) {
    const int chunk = F_LANE, seg = F.wave;
    if (!WITH_C && chunk >= 48) return;
    const int ch = chunk < 32 ? g * 256 + chunk * 8 : (chunk < 48 ? 2048 + g * 128 + (chunk - 32) * 8 : 3072 + g * 128 + (chunk - 48) * 8);
    const float* cw = F.in[I_CONVW] + ch; const float* cb = F.in[I_CONVB] + ch;
    float w0[8], w1[8], w2[8], w3[8], bs[8];
#pragma unroll
    for (int j = 0; j < 8; ++j) { w0[j] = cw[j]; w1[j] = cw[XBC_W + j]; w2[j] = cw[2 * XBC_W + j]; w3[j] = cw[3 * XBC_W + j]; bs[j] = cb[j]; }
    const bf16* src = F.proj0 + (size_t)row0 * N1 + C_XBC + ch;
    const int t0 = 16 * seg;
    float r0[8], r1[8], r2[8];
    if (t0 > 0 || has_halo) { unpack8(*(const v4u*)(src + (ptrdiff_t)(t0 - 3) * N1), r0); unpack8(*(const v4u*)(src + (ptrdiff_t)(t0 - 2) * N1), r1); unpack8(*(const v4u*)(src + (ptrdiff_t)(t0 - 1) * N1), r2); }
    else {
#pragma unroll
        for (int j = 0; j < 8; ++j) { r0[j] = 0.f; r1[j] = 0.f; r2[j] = 0.f; } }
#pragma unroll
    for (int hb = 0; hb < 2; ++hb) {
        v4u raw[8];
#pragma unroll
        for (int i = 0; i < 8; ++i) raw[i] = *(const v4u*)(src + (size_t)(t0 + 8 * hb + i) * N1);
#pragma unroll
        for (int i = 0; i < 8; ++i) {
            float cur[8], o[8]; unpack8(raw[i], cur);
#pragma unroll
            for (int j = 0; j < 8; ++j) { const float a = bs[j] + w0[j] * r0[j] + w1[j] * r1[j] + w2[j] * r2[j] + w3[j] * cur[j]; o[j] = silu_fast(a); r0[j] = r1[j]; r1[j] = r2[j]; r2[j] = cur[j]; }
            sink(t0 + 8 * hb + i, 8 * hb + i, chunk, o);
        }
        asm volatile("" ::: "memory");
    }
}
}
__device__ __forceinline__ void ssd_phase_a(Frame& F, float* states, float* cdec) {
    using namespace ssd;
    const int lane = F_LANE, w = F.wave, r32 = lane & 31, hi = lane >> 5;
    LAS unsigned char* lds = F.lds;
    for (int item = (int)blockIdx.x; item < NB * 16 * 8; item += F.G) {
        const int g = item & 7, c = (item >> 3) & 15, b = item >> 7, row0 = b * S + c * 128;
        dt_scan(F, row0, g);
        LDS_WAIT(); __syncthreads();
        { LAS float* CS = (LAS float*)(lds + CSOFF); LAS float* DTS = (LAS float*)(lds + DTOFF);
          if (w == 0 && lane < 4) cdec[(b * 16 + c) * 32 + 4 * g + lane] = __expf(CS[lane * 128 + 127]);
          const bool isx = lane < 32; const int hl = isx ? (lane >> 3) : 0;
          const int abase = isx ? (XIMG + (lane >> 2) * 8192 + (lane & 3) * 16) : (BIMG + ((lane - 32) >> 2) * 8192 + ((lane - 32) & 3) * 16);
          const float csend = CS[hl * 128 + 127];
          conv_tile<false>(F, row0, g, c > 0, [&](int t, int t15, int chunk, float (&o)[8]) {
              const float wt = isx ? DTS[hl * 128 + t] * __expf(csend - CS[hl * 128 + t]) : 1.0f;
              v4u pk; pk.x = pk2(o[0] * wt, o[1] * wt); pk.y = pk2(o[2] * wt, o[3] * wt); pk.z = pk2(o[4] * wt, o[5] * wt); pk.w = pk2(o[6] * wt, o[7] * wt);
              *(LAS v4u*)(lds + abase + t * 64) = pk; }); }
        LDS_WAIT(); __syncthreads();
        { f32x16 acc[4];
#pragma unroll
          for (int i = 0; i < 4; ++i) acc[i] = (f32x16){};
          LAS unsigned char* ab = lds + XIMG + w * 8192 + (8 * hi + ((lane & 15) >> 2)) * 64 + 32 * ((lane >> 4) & 1) + 8 * (lane & 3);
          LAS unsigned char* bb = lds + BIMG + (8 * hi + ((lane & 15) >> 2)) * 64 + 32 * ((lane >> 4) & 1) + 8 * (lane & 3);
#pragma unroll 2
          for (int ks = 0; ks < 8; ++ks) {
              const att::v4i16_t al = att::vtr(ab + ks * 1024), ah = att::vtr(ab + ks * 1024 + 256);
              const bf16x8 af = (bf16x8){al[0], al[1], al[2], al[3], ah[0], ah[1], ah[2], ah[3]};
#pragma unroll
              for (int nb = 0; nb < 4; ++nb) {
                  const att::v4i16_t bl = att::vtr(bb + nb * 8192 + ks * 1024), bh = att::vtr(bb + nb * 8192 + ks * 1024 + 256);
                  const bf16x8 bfr = (bf16x8){bl[0], bl[1], bl[2], bl[3], bh[0], bh[1], bh[2], bh[3]};
                  acc[nb] = __builtin_amdgcn_mfma_f32_32x32x16_bf16(af, bfr, acc[nb], 0, 0, 0);
              }
          }
          float* sp = states + ((size_t)((b * 16 + c) * 32 + 4 * g + (w >> 1)) * 64 + 32 * (w & 1)) * 128;
#pragma unroll
          for (int nb = 0; nb < 4; ++nb)
#pragma unroll
              for (int r = 0; r < 16; ++r) sp[att::crow(r, hi) * 128 + 32 * nb + r32] = acc[nb][r];
        }
        LDS_WAIT(); __syncthreads();
    }
}
__device__ __forceinline__ void ssd_phase_b(Frame& F, const float* states, const float* cdec, bf16* prev) {
    for (int gid = (int)blockIdx.x * (NWAVES * 64) + F_TID; gid < NB * 32 * 64 * 16; gid += F.G * NWAVES * 64) {
        const int nck = gid & 15, p = (gid >> 4) & 63, hg = (gid >> 10) & 31, b = gid >> 15;
        f32x4 h0 = {0.f, 0.f, 0.f, 0.f}, h1 = {0.f, 0.f, 0.f, 0.f};
#pragma unroll 5
        for (int c = 0; c < 15; ++c) {
            const size_t off = ((size_t)((b * 16 + c) * 32 + hg) * 64 + p) * 128 + nck * 8;
            const f32x4 s0 = *(const f32x4*)(states + off), s1 = *(const f32x4*)(states + off + 4);
            const float cd = cdec[(b * 16 + c) * 32 + hg];
            h0 = h0 * cd + s0; h1 = h1 * cd + s1;
            v4u pk; pk.x = pk2(h0[0], h0[1]); pk.y = pk2(h0[2], h0[3]); pk.z = pk2(h1[0], h1[1]); pk.w = pk2(h1[2], h1[3]);
            *(v4u*)(prev + off + (size_t)32 * 64 * 128) = pk;
        }
    }
}
__device__ __forceinline__ void ssd_phase_c(Frame& F, const bf16* prev) {
    using namespace ssd;
    const int lane = F_LANE, w = F.wave, tid = w * 64 + lane, r32 = lane & 31, hi = lane >> 5;
    LAS unsigned char* lds = F.lds;
    const float* dsk = F.in[I_DSKIP]; const float* nw = F.in[I_SSDNW];
    for (int item = (int)blockIdx.x; item < NB * 16 * 8; item += F.G) {
        const int g = item & 7, c = (item >> 3) & 15, b = item >> 7, row0 = b * S + c * 128;
        dt_scan(F, row0, g);
        { const bool isx = lane < 32; const int cc = (lane - 32) & 15;
          const int xbase = XIMG + (lane >> 2) * 8192 + (lane & 3) * 16, bcbase = lane < 48 ? BIMG : CIMG;
          conv_tile<true>(F, row0, g, c > 0, [&](int t, int t15, int chunk, float (&o)[8]) {
              v4u pk; pk.x = pk2(o[0], o[1]); pk.y = pk2(o[2], o[3]); pk.z = pk2(o[4], o[5]); pk.w = pk2(o[6], o[7]);
              const int addr = isx ? (xbase + t * 64) : (bcbase + t * 256 + ((cc ^ t15) << 4));
              *(LAS v4u*)(lds + addr) = pk; }); }
        LDS_WAIT(); __syncthreads();
        {
            const int lb = w & 3, hp = w >> 2, l = 32 * lb + r32;
            LAS float* CS = (LAS float*)(lds + CSOFF); LAS float* DTS = (LAS float*)(lds + DTOFF);
            f32x16 acc[2][2];
#pragma unroll
            for (int j = 0; j < 2; ++j)
#pragma unroll
                for (int pb = 0; pb < 2; ++pb) acc[j][pb] = (f32x16){};
            bf16x8 cf[8];
#pragma unroll
            for (int ks = 0; ks < 8; ++ks) cf[ks] = *(const LAS bf16x8*)(lds + CIMG + l * 256 + (((2 * ks + hi) ^ (l & 15)) << 4));
            float csl[2];
#pragma unroll
            for (int j = 0; j < 2; ++j) csl[j] = CS[(2 * hp + j) * 128 + l];
            if (c > 0) {
#pragma unroll
                for (int j = 0; j < 2; ++j) {
                    const bf16* pp = prev + ((size_t)((b * 16 + c) * 32 + 4 * g + 2 * hp + j) * 64 + r32) * 128 + 8 * hi;
#pragma unroll
                    for (int pb = 0; pb < 2; ++pb) {
#pragma unroll
                        for (int ks = 0; ks < 8; ++ks) {
                            const bf16x8 pf = *(const bf16x8*)(pp + (size_t)pb * 32 * 128 + 16 * ks);
                            acc[j][pb] = __builtin_amdgcn_mfma_f32_32x32x16_bf16(pf, cf[ks], acc[j][pb], 0, 0, 0);
                        }
                    }
                    const float e = __expf(csl[j]);
                    acc[j][0] = acc[j][0] * e; acc[j][1] = acc[j][1] * e;
                }
            }
            LAS unsigned char* xb0 = lds + XIMG + (4 * hi + ((lane & 15) >> 2)) * 64 + 32 * ((lane >> 4) & 1) + 8 * (lane & 3);
            for (int sbk = 0; sbk <= lb; ++sbk) {
                f32x16 X = (f32x16){};
                const int srow = 32 * sbk + r32;
#pragma unroll
                for (int ks = 0; ks < 8; ++ks) {
                    const bf16x8 bfr = *(const LAS bf16x8*)(lds + BIMG + srow * 256 + (((2 * ks + hi) ^ (srow & 15)) << 4));
                    X = __builtin_amdgcn_mfma_f32_32x32x16_bf16(bfr, cf[ks], X, 0, 0, 0);
                }
#pragma unroll
                for (int j = 0; j < 2; ++j) {
                    const int hl = 2 * hp + j;
                    float xh[16];
#pragma unroll
                    for (int q4 = 0; q4 < 4; ++q4) {
                        const f32x4 cs4 = *(const LAS f32x4*)(CS + hl * 128 + 32 * sbk + 8 * q4 + 4 * hi), dt4 = *(const LAS f32x4*)(DTS + hl * 128 + 32 * sbk + 8 * q4 + 4 * hi);
#pragma unroll
                        for (int i = 0; i < 4; ++i) { const int r = 4 * q4 + i, s_ = 32 * sbk + 8 * q4 + 4 * hi + i;
                            const float v = X[r] * __expf(csl[j] - cs4[i]) * dt4[i]; xh[r] = (s_ <= l) ? v : 0.f; }
                    }
                    v4u p0, p1;
                    p0.x = pk2(xh[0], xh[1]); p0.y = pk2(xh[2], xh[3]); p0.z = pk2(xh[4], xh[5]); p0.w = pk2(xh[6], xh[7]);
                    p1.x = pk2(xh[8], xh[9]); p1.y = pk2(xh[10], xh[11]); p1.z = pk2(xh[12], xh[13]); p1.w = pk2(xh[14], xh[15]);
                    const bf16x8 pf0 = __builtin_bit_cast(bf16x8, p0), pf1 = __builtin_bit_cast(bf16x8, p1);
#pragma unroll
                    for (int s2 = 0; s2 < 2; ++s2)
#pragma unroll
                        for (int pb = 0; pb < 2; ++pb) {
                            LAS unsigned char* xp = xb0 + (2 * hl + pb) * 8192 + (32 * sbk + 16 * s2) * 64;
                            const att::v4i16_t lo = att::vtr(xp), hi4 = att::vtr(xp + 8 * 64);
                            const bf16x8 xf = (bf16x8){lo[0], lo[1], lo[2], lo[3], hi4[0], hi4[1], hi4[2], hi4[3]};
                            acc[j][pb] = __builtin_amdgcn_mfma_f32_32x32x16_bf16(xf, s2 == 0 ? pf0 : pf1, acc[j][pb], 0, 0, 0);
                        }
                }
            }
            LDS_WAIT(); __syncthreads();
#pragma unroll
            for (int j = 0; j < 2; ++j)
#pragma unroll
                for (int pb = 0; pb < 2; ++pb)
#pragma unroll
                    for (int q4 = 0; q4 < 4; ++q4) {
                        v2u pk; pk.x = pk2(acc[j][pb][4 * q4], acc[j][pb][4 * q4 + 1]); pk.y = pk2(acc[j][pb][4 * q4 + 2], acc[j][pb][4 * q4 + 3]);
                        *(LAS v2u*)(lds + YT + l * YT_PITCH + ((2 * hp + j) * 64 + 32 * pb + 8 * q4 + 4 * hi) * 2) = pk;
                    }
        }
        LDS_WAIT(); __syncthreads();
        {
            const int ckk = tid & 31, chg = g * 256 + ckk * 8;
            const float Dk = dsk[4 * g + (ckk >> 3)];
            float nwv[8];
#pragma unroll
            for (int j = 0; j < 8; ++j) nwv[j] = nw[chg + j];
#pragma unroll 2
            for (int i = 0; i < 8; ++i) {
                const int t = (tid >> 5) + 16 * i;
                const v4u yr = *(const LAS v4u*)(lds + YT + t * YT_PITCH + ckk * 16);
                const v4u xr = *(const LAS v4u*)(lds + XIMG + (ckk >> 2) * 8192 + t * 64 + (ckk & 3) * 16);
                const v4u zr = *(const v4u*)(F.proj0 + (size_t)(row0 + t) * N1 + C_ZA + chg);
                float y[8], x[8], z[8]; unpack8(yr, y); unpack8(xr, x); unpack8(zr, z);
                float v[8]; float ss = 0.f;
#pragma unroll
                for (int j = 0; j < 8; ++j) { v[j] = (y[j] + Dk * x[j]) * silu_fast(z[j]); ss += v[j] * v[j]; }
#pragma unroll
                for (int o = 1; o < 32; o <<= 1) ss += __shfl_xor(ss, o);
                const float rsv = rsqrtf(ss * (1.0f / 256.0f) + EPS);
                v4u o; o.x = pk2(v[0] * rsv * nwv[0], v[1] * rsv * nwv[1]); o.y = pk2(v[2] * rsv * nwv[2], v[3] * rsv * nwv[3]);
                o.z = pk2(v[4] * rsv * nwv[4], v[5] * rsv * nwv[5]); o.w = pk2(v[6] * rsv * nwv[6], v[7] * rsv * nwv[7]);
                *(v4u*)(F.ycat + (size_t)(row0 + t) * MIXW + chg) = o;
            }
        }
        LDS_WAIT(); __syncthreads();
    }
}

enum Phase { PH_PRO = 0, PH_G1, PH_SSD_A, PH_SSD_B, PH_SSD_C, PH_G2, PH_G3, PH_ATT, PH_G4, PH_FIN, PH_N };
struct Args { const float* in[22]; float* out; unsigned char* ws; int ph_lo, ph_hi, li, pad; };
template <int VAR> __global__ void __launch_bounds__(NWAVES * 64, 2) mega(Args args) {
    extern __shared__ __attribute__((aligned(16))) unsigned char lds[];
    Frame F;
    F.lds = (LAS unsigned char*)lds;
    F.MISC = (volatile LAS unsigned*)(F.lds + LDSCTL_OFF);
    F.wave = __builtin_amdgcn_readfirstlane((int)threadIdx.x >> 6); F.G = gridDim.x;
    unsigned char* ws = args.ws;
    F.ctl = (unsigned*)(ws + WS_CTL);
#pragma unroll
    for (int i = 0; i < 22; ++i) F.in[i] = args.in[i];
    F.out = args.out;
    F.Wt_in0 = (bf16*)(ws + WS_WIN0); F.Wt_out0 = (bf16*)(ws + WS_WOUT0); F.Wt_in1 = (bf16*)(ws + WS_WIN1); F.Wt_out1 = (bf16*)(ws + WS_WOUT1);
    F.xb = (bf16*)(ws + WS_XB); F.proj0 = (bf16*)(ws + WS_PROJ0); F.ycat = (bf16*)(ws + WS_YCAT); F.h1b = F.xb; F.qkvg = F.proj0; F.ocat = F.ycat;
    F.dt = (float*)(ws + WS_DT); F.rstd0 = (float*)(ws + WS_RSTD0); F.ssq1 = (float*)(ws + WS_SSQ1); F.ssq2 = (float*)(ws + WS_SSQ2);
    if (threadIdx.x < 64) ((LAS unsigned*)(F.lds + LDSCTL_OFF))[threadIdx.x] = 0u;
    __syncthreads();
    const int lo = args.ph_lo, hi = args.ph_hi;
    XcdBarrier bar; bar.bar = F.ctl + CW_BAR + args.li * XCD_BAR_WORDS; bar.x = 0; bar.st = nullptr;
    if (hi - lo > 1) bar = xcd_barrier_post(F.ctl + CW_BAR + args.li * XCD_BAR_WORDS, F.MISC + 8);
#define IN(k) (lo <= (k) && (k) < hi)
#define SEAM(k) do { if (IN(k) && IN((k) + 1)) xcd_barrier(bar); } while (0)

    if (IN(PH_PRO)) { p0_prologue(F); }
    SEAM(PH_PRO);
    if (IN(PH_G1)) {
        pg8::Gemm g{F.xb, F.Wt_in0, M, N1, D}; pg8::StaticOrder S; S.init(M, N1, F.G, (int)blockIdx.x);
        pg8::EpiRowScaleBf16<1> E{F.proj0, N1, F.rstd0};
        pg8::gemm_phase<pg8::EpiRowScaleBf16<1>, pg8::StaticOrder, true, true>(F.lds, g, S, E);
    }
    SEAM(PH_G1);
    float* sgu_mu = (float*)(ws + WS_SGU_MU); float* sgu_rs = (float*)(ws + WS_SGU_RS);
    float* states = (float*)(ws + WS_STATES); float* cdec = (float*)(ws + WS_CDEC); bf16* prevb = (bf16*)(ws + WS_XB);
    if (IN(PH_SSD_A)) { ssd_phase_a(F, states, cdec); sgu_stats_phase(F, sgu_mu, sgu_rs); }
    SEAM(PH_SSD_A);
    if (IN(PH_SSD_B)) { ssd_phase_b(F, states, cdec, prevb); sgu_phase(F, sgu_mu, sgu_rs); }
    SEAM(PH_SSD_B);
    if (IN(PH_SSD_C)) { ssd_phase_c(F, prevb); }
    SEAM(PH_SSD_C);
    if (IN(PH_G2)) {
        pg8::Gemm g{F.ycat, F.Wt_out0, M, D, MIXW}; pg8::StaticOrder S; S.init(M, D, F.G, (int)blockIdx.x);
        pg8::EpiResid<true> E{F.in[I_X], F.out, F.h1b, F.ssq1, D};
        pg8::gemm_phase<pg8::EpiResid<true>, pg8::StaticOrder, false, true>(F.lds, g, S, E);
    }
    SEAM(PH_G2);
    if (IN(PH_G3)) {
        pg8::Gemm g{F.h1b, F.Wt_in1, M, ODD_IN, D}; pg8::StaticOrder S; S.init(M, ODD_IN, F.G, (int)blockIdx.x);
        pg8::EpiRowScaleBf16<8> E{F.qkvg, ODD_IN, F.ssq1};
        pg8::gemm_phase<pg8::EpiRowScaleBf16<8>, pg8::StaticOrder, true, true>(F.lds, g, S, E);
    }
    SEAM(PH_G3);
    if (IN(PH_ATT)) { attn_phase<VAR>(F); }
    SEAM(PH_ATT);
    if (IN(PH_G4)) {
        pg8::Gemm g{F.ocat, F.Wt_out1, M, D, MIXW}; pg8::StaticOrder S; S.init(M, D, F.G, (int)blockIdx.x);
        pg8::EpiResid<false> E{F.out, F.out, nullptr, F.ssq2, D};
        pg8::gemm_phase<pg8::EpiResid<false>, pg8::StaticOrder, false, true>(F.lds, g, S, E);
    }
    SEAM(PH_G4);
    if (IN(PH_FIN)) { final_norm(F); }
#undef IN
#undef SEAM
}

extern "C" void kernel_launch(void* const* d_in, const int* in_sizes, int n_in, void* d_out, int out_size, void* d_ws, size_t ws_size, hipStream_t stream) {
    static int grid = 0;
    if (grid == 0) {
        if (n_in != 22 || ws_size < WS_END || out_size != M * D) { fprintf(stderr, "kernel_launch: unexpected n_in %d / out_size %d / ws_size %zu (< %zu)\n", n_in, out_size, ws_size, (size_t)WS_END); grid = -1; return; }
        int dev = 0, cus = 0, per_cu = 0;
        if (hipGetDevice(&dev) != hipSuccess || hipDeviceGetAttribute(&cus, hipDeviceAttributeMultiprocessorCount, dev) != hipSuccess) { fprintf(stderr, "kernel_launch: device query failed\n"); grid = -1; return; }
        if (hipFuncSetAttribute((const void*)mega<0>, hipFuncAttributeMaxDynamicSharedMemorySize, LDS_BYTES) != hipSuccess) { fprintf(stderr, "kernel_launch: hipFuncSetAttribute failed\n"); grid = -1; return; }
        if (hipOccupancyMaxActiveBlocksPerMultiprocessor(&per_cu, (const void*)mega<0>, NWAVES * 64, LDS_BYTES) != hipSuccess || per_cu < 1) { fprintf(stderr, "kernel_launch: occupancy query says %d blocks/CU\n", per_cu); (void)hipGetLastError(); grid = -1; return; }
        if (cus != 256) { fprintf(stderr, "kernel_launch: built for 256 CUs, device has %d\n", cus); grid = -1; return; }
        grid = cus;
    }
    if (grid < 0) return;
    const float* in[22]; for (int i = 0; i < 22; ++i) in[i] = (const float*)d_in[i];
    float* out = (float*)d_out; unsigned char* ws = (unsigned char*)d_ws;
    (void)hipMemsetAsync(ws + WS_CTL, 0, CTL_ZERO_BYTES, stream);
    Args a{};
    for (int i = 0; i < 22; ++i) a.in[i] = in[i];
    a.out = out; a.ws = ws;
    auto launch = [&](int lo, int hi, int li) { a.ph_lo = lo; a.ph_hi = hi; a.li = li; hipLaunchKernelGGL(mega<0>, dim3(grid), dim3(NWAVES * 64), LDS_BYTES, stream, a); };
    launch(PH_PRO, PH_N, 0);
#if defined(EXTRA_LO)
#ifndef EXTRA_VAR
#define EXTRA_VAR 0
#endif
    { static bool once = false; if (!once) { once = true; (void)hipFuncSetAttribute((const void*)mega<EXTRA_VAR>, hipFuncAttributeMaxDynamicSharedMemorySize, LDS_BYTES); }
      a.ph_lo = EXTRA_LO; a.ph_hi = EXTRA_HI; a.li = 1; hipLaunchKernelGGL(mega<EXTRA_VAR>, dim3(grid), dim3(NWAVES * 64), LDS_BYTES, stream, a); }
#endif
#if defined(EXTRA2_LO)
    launch(EXTRA2_LO, EXTRA2_HI, 2);
#endif
}
```

```cpp
#include <hip/hip_runtime.h>
#include <cstdio>
#include <cstdint>

namespace pg8 {
#define PG8_LAS __attribute__((address_space(3)))
typedef unsigned short bf16_t;
typedef short bf16x8 __attribute__((ext_vector_type(8)));
typedef float f32x4 __attribute__((ext_vector_type(4)));
typedef unsigned u32x4 __attribute__((ext_vector_type(4)));
constexpr int BM = 256, BK = 64, HALF = 128, HTB = HALF * BK * 2  , STAGE_BYTES = 8 * HTB, NXCD = 8, WGM = 8;

__host__ __device__ __forceinline__ int lds_byte(int r, int c) { const int st = (r >> 4) * 2 + (c >> 5), rr = r & 15, cc = c & 31, ob = rr * 64 + cc * 2; return st * 1024 + (ob ^ (((ob >> 9) & 1) << 5)); }
__host__ __device__ __forceinline__ void stage_rc(int b, int& R, int& C) { const int st = b / 1024, sb = b % 1024, swz = sb ^ (((sb >> 9) & 1) << 5); R = (st >> 1) * 16 + swz / 64; C = (st & 1) * 32 + (swz % 64) / 2; }
__host__ __device__ __forceinline__ int perm32(int rho) { const int n = rho >> 4, i = rho & 15; return 8 * (i >> 2) + 4 * n + (i & 3); }

struct Unit { int pm, pn; };
struct Gemm { const bf16_t* A; const bf16_t* Bt; int M, N, K; };

struct StaticOrder {
    int nM, nN, nwg, G, c;
    __host__ __device__ void init(int M, int N, int G_, int c_) { nM = M / BM; nN = N / BM; nwg = nM * nN; G = G_; c = c_; }
    __host__ __device__ bool next(int i, Unit& u) const {
        const long L = (long)i * G + c; if (L >= nwg) return false;
        int wgid = (int)L; { const int q = nwg / NXCD, r = nwg % NXCD, xcd = wgid % NXCD, off = wgid / NXCD; wgid = (xcd < r ? xcd * (q + 1) : r * (q + 1) + (xcd - r) * q) + off; }
        const int nig = WGM * nN, gid = wgid / nig, fm = gid * WGM, gsz = (nM - fm) < WGM ? (nM - fm) : WGM;
        u.pm = fm + ((wgid % nig) % gsz); u.pn = (wgid % nig) / gsz; return true;
    }
    __device__ __forceinline__ void a_ready(const Unit&) const {}
    __device__ __forceinline__ void done(const Unit&) const {}
};

__device__ __forceinline__ unsigned cvt_pk_bf16(float lo, float hi) { unsigned r; asm volatile("v_cvt_pk_bf16_f32 %0, %1, %2" : "=v"(r) : "v"(lo), "v"(hi)); return r; }

constexpr float RMS_EPS = 1e-6f;
template <int NP> struct EpiRowScaleBf16 {
    static constexpr bool PERM = true, AFTER_DRAIN = false;
    bf16_t* O; int ldc; const float* rs;
    __device__ __forceinline__ void operator()(const f32x4 (&acc)[2][2][4][2], const Unit& u, int wr, int wc, int fr, int fq) const {
        const int row0 = u.pm * BM + wr * 64 + fr, col0 = u.pn * BM + wc * 32 + 8 * fq;
#pragma unroll
        for (int ai = 0; ai < 2; ++ai)
#pragma unroll
            for (int m = 0; m < 4; ++m) {
                const int row = row0 + ai * HALF + m * 16;
                float sc;
                if (NP == 1) sc = rs[row];
                else { const f32x4 a = *(const f32x4*)(rs + (size_t)row * 8), b = *(const f32x4*)(rs + (size_t)row * 8 + 4);
                       sc = rsqrtf((((a[0] + a[1]) + (a[2] + a[3])) + ((b[0] + b[1]) + (b[2] + b[3]))) * (1.0f / 2048.0f) + RMS_EPS); }
                bf16_t* rowp = O + (size_t)row * ldc + col0;
#pragma unroll
                for (int bj = 0; bj < 2; ++bj) { const f32x4 v0 = acc[ai][bj][m][0] * sc, v1 = acc[ai][bj][m][1] * sc;
                    u32x4 w; w.x = cvt_pk_bf16(v0[0], v0[1]); w.y = cvt_pk_bf16(v0[2], v0[3]); w.z = cvt_pk_bf16(v1[0], v1[1]); w.w = cvt_pk_bf16(v1[2], v1[3]);
                    *(u32x4*)(rowp + bj * HALF) = w; }
            }
    }
};
template <bool WBF> struct EpiResid {
    static constexpr bool PERM = false, AFTER_DRAIN = true;
    const float* base; float* out; bf16_t* hb; float* ssqp; int ldc;
    __device__ __forceinline__ void fused(f32x4 (&acc)[2][2][4][2], const Unit& u, int wr, int wc, int fr, int fq, PG8_LAS unsigned char* lds, int wid, int lane) const {
        typedef unsigned u32x2v __attribute__((ext_vector_type(2)));
        PG8_LAS float* P = (PG8_LAS float*)lds;
        const int col0 = u.pn * BM + wc * 32 + 4 * fq;
#pragma unroll
        for (int ai = 0; ai < 2; ++ai)
#pragma unroll
            for (int m = 0; m < 4; ++m) {
                const int r = ai * HALF + wr * 64 + m * 16 + fr; const size_t off = (size_t)(u.pm * BM + r) * ldc + col0; float ss = 0.f;
#pragma unroll
                for (int bj = 0; bj < 2; ++bj)
#pragma unroll
                    for (int n = 0; n < 2; ++n) {
                        const f32x4 bs = *(const f32x4*)(base + off + bj * HALF + n * 16); const f32x4 h = bs + acc[ai][bj][m][n];
                        *(f32x4*)(out + off + bj * HALF + n * 16) = h;
                        if (WBF) { u32x2v w; w.x = cvt_pk_bf16(h[0], h[1]); w.y = cvt_pk_bf16(h[2], h[3]); *(u32x2v*)(hb + off + bj * HALF + n * 16) = w; }
                        ss += (h[0] * h[0] + h[1] * h[1]) + (h[2] * h[2] + h[3] * h[3]); }
                ss += __shfl_xor(ss, 16); ss += __shfl_xor(ss, 32);
                if (fq == 0) P[r * 4 + wc] = ss;
                if (m & 1) asm volatile("" ::: "memory");
            }
        asm volatile("s_waitcnt lgkmcnt(0)" ::: "memory"); __builtin_amdgcn_s_barrier(); asm volatile("" ::: "memory");
        const int tid = wid * 64 + lane;
        if (tid < 256) { const f32x4 p = *(const PG8_LAS f32x4*)(P + tid * 4); ssqp[(size_t)(u.pm * BM + tid) * 8 + u.pn] = (p[0] + p[1]) + (p[2] + p[3]); }
    }
};
template <class Epi, class Sched, bool ALIGN_EPI = false, bool SP2 = false>
__device__ __forceinline__ void gemm_phase(PG8_LAS unsigned char* lds, const Gemm g, const Sched& S, const Epi& E) {
    const int tid = threadIdx.x, wid = __builtin_amdgcn_readfirstlane(tid >> 6), lane = tid & 63, wr = wid >> 2, wc = wid & 3, fr = lane & 15, fq = lane >> 4;
    const int K = g.K, nt = K / BK;
    unsigned voffA[2], voffB[2];
#pragma unroll
    for (int i = 0; i < 2; ++i) { int R, C; stage_rc(tid * 16 + i * 8192, R, C); const int Rb = Epi::PERM ? ((R & ~31) + perm32(R & 31)) : R;
        voffA[i] = (unsigned)(R * K + C) * 2u; voffB[i] = (unsigned)(Rb * K + C) * 2u; }
    const size_t kstep = (size_t)(BK * 2);
    const size_t hstep = (size_t)HALF * K * 2;
    const size_t tstep = 2 * hstep;
    const unsigned ldsw = (unsigned)wid * 1024u;
    const int aoff = lds_byte(wr * 64 + fr, fq * 8), boff = lds_byte(wc * 32 + fr, fq * 8);
#define PG8_SA(b, h) (((b) * 2 + (h)) * HTB)
#define PG8_SB(b, h) ((4 + (b) * 2 + (h)) * HTB)
#define PG8_STAGE(bufoff, gbase, voff) do { _Pragma("unroll") for (int _i = 0; _i < 2; ++_i) \
        __builtin_amdgcn_global_load_lds((const unsigned*)((const char*)(gbase) + (voff)[_i]), (PG8_LAS unsigned*)(lds + (bufoff) + ldsw + _i * 8192), 16, 0, 0); } while (0)
#define PG8_LDA(dst, b, h) do { _Pragma("unroll") for (int m = 0; m < 4; ++m) _Pragma("unroll") for (int k = 0; k < 2; ++k) dst[m][k] = *(const PG8_LAS bf16x8*)(lds + PG8_SA(b, h) + aoff + m * 2048 + k * 1024); } while (0)
#define PG8_LDB(dst, b, h) do { _Pragma("unroll") for (int n = 0; n < 2; ++n) _Pragma("unroll") for (int k = 0; k < 2; ++k) dst[n][k] = *(const PG8_LAS bf16x8*)(lds + PG8_SB(b, h) + boff + n * 2048 + k * 1024); } while (0)
#define PG8_MMA(ai, bj, At, Bt) do { __builtin_amdgcn_s_setprio(1); _Pragma("unroll") for (int m = 0; m < 4; ++m) _Pragma("unroll") for (int n = 0; n < 2; ++n) _Pragma("unroll") for (int k = 0; k < 2; ++k) \
        acc[ai][bj][m][n] = __builtin_amdgcn_mfma_f32_16x16x32_bf16(Bt[n][k], At[m][k], acc[ai][bj][m][n], 0, 0, 0); __builtin_amdgcn_s_setprio(0); } while (0)
#define PG8_WAIT_V(n) asm volatile("s_waitcnt vmcnt(" #n ")" ::: "memory")
#define PG8_WAIT_L(n) asm volatile("s_waitcnt lgkmcnt(" #n ")" ::: "memory")
#define PG8_BAR __builtin_amdgcn_s_barrier()
#define PG8_SCHED __builtin_amdgcn_sched_barrier(0)
    Unit cur, nxt; int ui = 0;
    if (!S.next(0, cur)) return;
    f32x4 acc[2][2][4][2];
#pragma unroll
    for (int a = 0; a < 2; ++a)
#pragma unroll
        for (int b = 0; b < 2; ++b)
#pragma unroll
            for (int m = 0; m < 4; ++m)
#pragma unroll
                for (int n = 0; n < 2; ++n) acc[a][b][m][n] = (f32x4){0.f, 0.f, 0.f, 0.f};
    bf16x8 At[4][2], B0[2][2], B1[2][2];
    const char* cA = (const char*)g.A + (size_t)cur.pm * tstep; const char* cB = (const char*)g.Bt + (size_t)cur.pn * tstep;
    S.a_ready(cur);
    if constexpr (SP2) {
        PG8_STAGE(PG8_SB(0, 0), cB, voffB); PG8_STAGE(PG8_SB(0, 1), cB + hstep, voffB); PG8_STAGE(PG8_SA(0, 0), cA, voffA); PG8_STAGE(PG8_SA(0, 1), cA + hstep, voffA);
        if (wr == 1) PG8_BAR;
        PG8_WAIT_V(2); PG8_BAR;
        PG8_STAGE(PG8_SB(1, 0), cB + kstep, voffB); PG8_STAGE(PG8_SA(1, 0), cA + kstep, voffA); PG8_STAGE(PG8_SB(1, 1), cB + hstep + kstep, voffB);
        PG8_WAIT_V(6); PG8_BAR;
    } else {
        PG8_STAGE(PG8_SB(0, 0), cB, voffB); PG8_STAGE(PG8_SA(0, 0), cA, voffA); PG8_STAGE(PG8_SB(0, 1), cB + hstep, voffB); PG8_STAGE(PG8_SA(0, 1), cA + hstep, voffA);
        if (wr == 1) PG8_BAR;
        PG8_WAIT_V(4); PG8_BAR;
        PG8_STAGE(PG8_SB(1, 0), cB + kstep, voffB); PG8_STAGE(PG8_SA(1, 0), cA + kstep, voffA); PG8_STAGE(PG8_SB(1, 1), cB + hstep + kstep, voffB);
        PG8_WAIT_V(6); PG8_BAR;
    }
    for (;;) {
        const bool has_next = S.next(ui + 1, nxt);
        const char* nA = has_next ? (const char*)g.A + (size_t)nxt.pm * tstep : cA; const char* nB = has_next ? (const char*)g.Bt + (size_t)nxt.pn * tstep : cB;
        for (int t = 0; t < nt; t += 2) {
            const bool last = (t == nt - 2);
            const char* a1 = cA + (size_t)(t + 1) * kstep;
            const char* a2 = last ? nA : cA + (size_t)(t + 2) * kstep; const char* b2 = last ? nB : cB + (size_t)(t + 2) * kstep;
            const char* a3 = a2 + kstep; const char* b3 = b2 + kstep;
            if (last && has_next) S.a_ready(nxt);
            if constexpr (SP2) {
            PG8_LDB(B0, 0, 0); PG8_LDB(B1, 0, 1); PG8_SCHED; PG8_LDA(At, 0, 0); PG8_STAGE(PG8_SA(1, 1), a1 + hstep, voffA);
            PG8_WAIT_V(8); PG8_WAIT_L(0); PG8_BAR; PG8_MMA(0, 0, At, B0); PG8_MMA(0, 1, At, B1); PG8_BAR; PG8_SCHED;
            PG8_LDA(At, 0, 1); PG8_STAGE(PG8_SB(0, 0), b2, voffB); PG8_STAGE(PG8_SB(0, 1), b2 + hstep, voffB); PG8_STAGE(PG8_SA(0, 0), a2, voffA);
            PG8_WAIT_V(8); PG8_WAIT_L(0); PG8_BAR; PG8_MMA(1, 0, At, B0); PG8_MMA(1, 1, At, B1); PG8_BAR; PG8_SCHED;
            PG8_LDB(B0, 1, 0); PG8_LDB(B1, 1, 1); PG8_SCHED; PG8_LDA(At, 1, 0); PG8_STAGE(PG8_SA(0, 1), a2 + hstep, voffA);
            PG8_WAIT_V(8); PG8_WAIT_L(0); PG8_BAR; PG8_MMA(0, 0, At, B0); PG8_MMA(0, 1, At, B1); PG8_BAR; PG8_SCHED;
            PG8_LDA(At, 1, 1); PG8_STAGE(PG8_SB(1, 0), b3, voffB); PG8_STAGE(PG8_SB(1, 1), b3 + hstep, voffB); PG8_STAGE(PG8_SA(1, 0), a3, voffA);
            PG8_WAIT_V(8); PG8_WAIT_L(0); PG8_BAR; PG8_MMA(1, 0, At, B0); PG8_MMA(1, 1, At, B1); PG8_BAR; PG8_SCHED;
            } else {
            PG8_LDB(B0, 0, 0); PG8_SCHED; PG8_LDA(At, 0, 0); PG8_STAGE(PG8_SA(1, 1), a1 + hstep, voffA);
            PG8_WAIT_L(8); PG8_BAR; PG8_WAIT_L(0); PG8_MMA(0, 0, At, B0); PG8_BAR; PG8_SCHED;
            PG8_LDB(B1, 0, 1); PG8_STAGE(PG8_SB(0, 0), b2, voffB);
            PG8_BAR; PG8_WAIT_L(0); PG8_MMA(0, 1, At, B1); PG8_BAR;
            PG8_LDA(At, 0, 1); PG8_STAGE(PG8_SA(0, 0), a2, voffA);
            PG8_BAR; PG8_WAIT_L(0); PG8_MMA(1, 0, At, B0); PG8_BAR; PG8_SCHED;
            PG8_STAGE(PG8_SB(0, 1), b2 + hstep, voffB);
            PG8_WAIT_V(6); PG8_BAR; PG8_MMA(1, 1, At, B1); PG8_BAR;
            PG8_LDB(B0, 1, 0); PG8_SCHED; PG8_LDA(At, 1, 0); PG8_STAGE(PG8_SA(0, 1), a2 + hstep, voffA);
            PG8_WAIT_L(8); PG8_BAR; PG8_WAIT_L(0); PG8_MMA(0, 0, At, B0); PG8_BAR; PG8_SCHED;
            PG8_LDB(B1, 1, 1); PG8_STAGE(PG8_SB(1, 0), b3, voffB);
            PG8_BAR; PG8_WAIT_L(0); PG8_MMA(0, 1, At, B1); PG8_BAR;
            PG8_LDA(At, 1, 1); PG8_STAGE(PG8_SA(1, 0), a3, voffA);
            PG8_BAR; PG8_WAIT_L(0); PG8_MMA(1, 0, At, B0); PG8_BAR; PG8_SCHED;
            PG8_STAGE(PG8_SB(1, 1), b3 + hstep, voffB);
            PG8_WAIT_V(6); PG8_BAR; PG8_MMA(1, 1, At, B1); PG8_BAR;
            }
        }
        if constexpr (ALIGN_EPI) { if (wr == 0) PG8_BAR; }
        if constexpr (!Epi::AFTER_DRAIN) { E(acc, cur, wr, wc, fr, fq); S.done(cur); }
        if (!has_next) break;
#pragma unroll
        for (int a = 0; a < 2; ++a)
#pragma unroll
            for (int b = 0; b < 2; ++b)
#pragma unroll
                for (int m = 0; m < 4; ++m)
#pragma unroll
                    for (int n = 0; n < 2; ++n) acc[a][b][m][n] = (f32x4){0.f, 0.f, 0.f, 0.f};
        cur = nxt; cA = nA; cB = nB; ++ui;
        if constexpr (ALIGN_EPI) { if (wr == 1) PG8_BAR; }
    }
    PG8_WAIT_V(0);
    if constexpr (!ALIGN_EPI) { if (wr == 0) PG8_BAR; }
    PG8_BAR;
    if constexpr (Epi::AFTER_DRAIN) { E.fused(acc, cur, wr, wc, fr, fq, lds, wid, lane); S.done(cur); }
#undef PG8_SA
#undef PG8_SB
#undef PG8_STAGE
#undef PG8_LDA
#undef PG8_LDB
#undef PG8_MMA
#undef PG8_WAIT_V
#undef PG8_WAIT_L
#undef PG8_BAR
#undef PG8_SCHED
}

}

constexpr int NB = 4, S = 2048, M = NB * S, D = 2048;
constexpr int EVEN_IN = 12320, N1 = 12288;
constexpr int C_ZA = 0, C_XBC = 2048, C_ZB = 6144, C_U = 8192, C_V = 10240;
constexpr int XBC_W = 4096;
constexpr int ODD_IN = 16384, MIXW = 4096;
constexpr float EPS = 1e-6f;
constexpr float LAMBDA_INIT = 0.35550906759096924f;

constexpr size_t MiB = 1u << 20;
constexpr size_t WS_CTL = 0, CTL_ZERO_BYTES = 1 * MiB;
constexpr size_t WS_WIN0 = 1 * MiB;
constexpr size_t WS_WOUT0 = 49 * MiB;
constexpr size_t WS_WIN1 = 65 * MiB;
constexpr size_t WS_WOUT1 = 129 * MiB;
constexpr size_t WS_XB = 145 * MiB;
constexpr size_t WS_PROJ0 = 177 * MiB;
constexpr size_t WS_STATES = 369 * MiB;
constexpr size_t WS_YCAT = 433 * MiB;
constexpr size_t WS_DT = 497 * MiB;
constexpr size_t WS_RSTD0 = 498 * MiB;
constexpr size_t WS_SGU_MU = WS_RSTD0 + 128 * 1024;
constexpr size_t WS_SGU_RS = WS_SGU_MU + 64 * 1024;
constexpr size_t WS_SSQ1 = WS_RSTD0 + 256 * 1024;
constexpr size_t WS_SSQ2 = WS_RSTD0 + 512 * 1024;
constexpr size_t WS_CDEC = WS_RSTD0 + 768 * 1024;
constexpr size_t WS_END = 499 * MiB;
constexpr int CW_BAR = 4096;

#define GAS __attribute__((address_space(1)))
#define LAS __attribute__((address_space(3)))
typedef unsigned short bf16;
typedef unsigned v4u __attribute__((ext_vector_type(4)));
typedef unsigned v2u __attribute__((ext_vector_type(2)));
typedef float f32x4 __attribute__((ext_vector_type(4)));
typedef float f32x16 __attribute__((ext_vector_type(16)));
typedef short bf16x8 __attribute__((ext_vector_type(8)));
#define LDS_WAIT() asm volatile("s_waitcnt lgkmcnt(0)" ::: "memory")
#define VM_WAIT() asm volatile("s_waitcnt vmcnt(0)" ::: "memory")
__device__ __forceinline__ unsigned pk2(float lo, float hi) { return pg8::cvt_pk_bf16(lo, hi); }
__device__ __forceinline__ float bf2f(bf16 v) { return __uint_as_float(((unsigned)v) << 16); }
__device__ __forceinline__ bf16 f2bf(float f) { unsigned u = __float_as_uint(f); return (bf16)((u + 0x7fffu + ((u >> 16) & 1u)) >> 16); }
__device__ __forceinline__ float sigmoidf_(float v) { return 1.f / (1.f + __expf(-v)); }
__device__ __forceinline__ float siluf_(float v) { return v * sigmoidf_(v); }
__device__ __forceinline__ float geluf_(float v) { const float c = 0.7978845608028654f; float t = tanhf(c * (v + 0.044715f * v * v * v)); return 0.5f * v * (1.f + t); }
__device__ __forceinline__ float softplusf_(float v) { return v > 20.f ? v : log1pf(__expf(v)); }
__device__ __forceinline__ float wave_sum(float v) {
#pragma unroll
    for (int o = 1; o < 64; o <<= 1) v += __shfl_xor(v, o);
    return v;
}

#define XB_TMO      128
#define XB_XCNT(j)  (256  + 64 * (j))
#define XB_XSUB(j)  (1280 + 64 * (j))
#define XB_XGEN(j)  (2304 + 64 * (j))
#define XB_TOP      3328
#define XB_TOPGEN   3392
#define XCD_BAR_WORDS 3456
#define XB_SPIN_CAP (1u << 25)

__device__ __forceinline__ unsigned xb_ld(unsigned* p)              { return __hip_atomic_load(p, __ATOMIC_RELAXED, __HIP_MEMORY_SCOPE_AGENT); }
__device__ __forceinline__ unsigned xb_add(unsigned* p, unsigned v) { return __hip_atomic_fetch_add(p, v, __ATOMIC_RELAXED, __HIP_MEMORY_SCOPE_AGENT); }
__device__ __forceinline__ unsigned xb_xcc_id() { return (unsigned)__builtin_amdgcn_s_getreg((3 << 11) | 20) & 0xFu; }
#define XB_SPIN(cond, bar) do { unsigned _sp = 0; while (cond) { __builtin_amdgcn_s_sleep(1); \
    if ((++_sp & 255u) == 0u) { if (xb_ld(&(bar)[XB_TMO])) break; if (_sp > XB_SPIN_CAP) { atomicAdd(&(bar)[XB_TMO], 1u); break; } } } } while (0)

struct XcdBarrier {
    unsigned* bar; unsigned x;
    volatile LAS unsigned* st;
};

__device__ __forceinline__ XcdBarrier xcd_barrier_post(unsigned* bar, volatile LAS unsigned* st) {
    XcdBarrier b; b.bar = bar; b.x = xb_xcc_id(); b.st = st;
    if (threadIdx.x == 0) (void)xb_add(&bar[XB_XCNT(b.x)], 1u);
    return b;
}
__device__ __forceinline__ void xcd_barrier_complete(unsigned* bar, unsigned x, unsigned& nloc, unsigned& nx) {
    const unsigned G = gridDim.x * gridDim.y * gridDim.z;
    unsigned sum, cnt, mine, sp = 0u;
    for (;;) {
        sum = 0u; cnt = 0u; mine = 0u;
#pragma unroll
        for (unsigned j = 0; j < 16; ++j) { const unsigned c = xb_ld(&bar[XB_XCNT(j)]); sum += c; cnt += (c > 0u) ? 1u : 0u; mine = (j == x) ? c : mine; }
        if (sum == G) break;
        __builtin_amdgcn_s_sleep(1);
        if ((++sp & 255u) == 0u) { if (xb_ld(&bar[XB_TMO])) break; if (sp > XB_SPIN_CAP) { atomicAdd(&bar[XB_TMO], 1u); break; } }
    }
    nloc = mine > 0u ? mine : 1u; nx = cnt > 0u ? cnt : 1u;
}

__device__ __forceinline__ void xcd_barrier(const XcdBarrier& b) {
    asm volatile("s_waitcnt vmcnt(0)" ::: "memory");
    __syncthreads();
    if (threadIdx.x == 0) {
        unsigned* bar = b.bar;
        __builtin_amdgcn_s_waitcnt(0);
        unsigned nloc = b.st[0], nx = b.st[1];
        if (nloc == 0u) { xcd_barrier_complete(bar, b.x, nloc, nx); b.st[0] = nloc; b.st[1] = nx; }
        const unsigned old = xb_add(&bar[XB_XSUB(b.x)], 1u);
        const unsigned gen = old / nloc;
        if (old + 1u == (gen + 1u) * nloc) {
            __builtin_amdgcn_fence(__ATOMIC_RELEASE, "agent");
            asm volatile("s_waitcnt vmcnt(0)" ::: "memory");
            const unsigned og = xb_add(&bar[XB_TOP], 1u);
            const unsigned tg = og / nx;
            if (og + 1u == (tg + 1u) * nx) xb_add(&bar[XB_TOPGEN], 1u);
            else XB_SPIN(xb_ld(&bar[XB_TOPGEN]) == tg, bar);
            __builtin_amdgcn_fence(__ATOMIC_ACQUIRE, "agent");
            xb_add(&bar[XB_XGEN(b.x)], 1u);
            asm volatile("s_waitcnt vmcnt(0)" ::: "memory");
        } else {
            XB_SPIN(xb_ld(&bar[XB_XGEN(b.x)]) == gen, bar);
            __builtin_amdgcn_fence(__ATOMIC_ACQUIRE, "agent");
            asm volatile("s_waitcnt vmcnt(0)" ::: "memory");
        }
    }
    __syncthreads();
}


__device__ __forceinline__ int lane_id() { int l; asm volatile("v_mbcnt_lo_u32_b32 %0, -1, 0\n\tv_mbcnt_hi_u32_b32 %0, -1, %0" : "=v"(l)); return l; }
#define F_LANE lane_id()
#define F_TID (F.wave * 64 + lane_id())
constexpr int NWAVES = 8;
constexpr int LDS_BYTES = 163840;
constexpr int LDSCTL_OFF = LDS_BYTES - 256;
struct Frame {
    LAS unsigned char* lds;
    volatile LAS unsigned* MISC;
    unsigned* ctl;
    int wave, G;
    const float* in[22]; float* out;
    bf16 *Wt_in0, *Wt_out0, *Wt_in1, *Wt_out1, *xb, *proj0, *ycat, *h1b, *qkvg, *ocat;
    float *dt, *rstd0, *ssq1, *ssq2;
};
enum InIdx { I_X = 0, I_NORMW, I_WIN0, I_CONVW, I_CONVB, I_DTB, I_ALOG, I_DSKIP, I_SSDNW, I_LNW, I_LNB, I_SGUWS, I_SGUB, I_WOUT0, I_WIN1, I_LQ1, I_LK1, I_LQ2, I_LK2, I_SUBW, I_WOUT1, I_FW };

__device__ __forceinline__ void p0_transpose_item(const float* W, int ldw, int K, bf16* WT, int nblk, int shift_from, int shift, const float* ksc, LAS float* scr, int item, int lane) {
    const int kb = item / nblk, nb = item % nblk, k0 = 64 * kb, n0 = 64 * nb, ns = n0 + (n0 >= shift_from ? shift : 0);
    const int kr = lane >> 4, nc = 4 * (lane & 15);
    const float* src = W + (size_t)(k0 + kr) * ldw + ns + nc;
    f32x4 v[16];
#pragma unroll
    for (int j = 0; j < 16; ++j) v[j] = *(const f32x4*)(src + (size_t)(4 * j) * ldw);
    if (ksc) {
#pragma unroll
        for (int j = 0; j < 16; ++j) v[j] = v[j] * ksc[k0 + 4 * j + kr];
    }
#pragma unroll
    for (int j = 0; j < 16; ++j) { LAS float* d = scr + (4 * j + kr) * 65 + nc; d[0] = v[j][0]; d[1] = v[j][1]; d[2] = v[j][2]; d[3] = v[j][3]; }
    LDS_WAIT(); asm volatile("" ::: "memory");
    const int c = lane & 7;
#pragma unroll
    for (int j = 0; j < 8; ++j) { const int n = (lane >> 3) + 8 * j; const LAS float* s = scr + (8 * c) * 65 + n;
        v4u o; o.x = pk2(s[0 * 65], s[1 * 65]); o.y = pk2(s[2 * 65], s[3 * 65]); o.z = pk2(s[4 * 65], s[5 * 65]); o.w = pk2(s[6 * 65], s[7 * 65]);
        *(GAS v4u*)(WT + (size_t)(n0 + n) * K + k0 + 8 * c) = o; }
    LDS_WAIT(); asm volatile("" ::: "memory");
}
__device__ __forceinline__ void p0_prologue(Frame& F) {
    const int lane0 = F_LANE, tid0 = F.wave * 64 + lane0;
    {
        LAS float* scr = (LAS float*)(F.lds + F.wave * 16640);
        const int gw = (int)blockIdx.x * NWAVES + F.wave, NGW = F.G * NWAVES;
        constexpr int I_A = (D / 64) * (N1 / 64), I_B = (MIXW / 64) * (D / 64), I_C = (D / 64) * (ODD_IN / 64), I_D = I_B;
        constexpr int NITEMS = I_A + I_B + I_C + I_D;
        const float* nw = F.in[I_NORMW];
        for (int it = gw; it < NITEMS; it += NGW) {
            int r = it;
            if (r < I_A) { p0_transpose_item(F.in[I_WIN0], EVEN_IN, D, F.Wt_in0, N1 / 64, 6144, 32, nw, scr, r, lane0); continue; } r -= I_A;
            if (r < I_B) { p0_transpose_item(F.in[I_WOUT0], D, MIXW, F.Wt_out0, D / 64, 1 << 30, 0, nullptr, scr, r, lane0); continue; } r -= I_B;
            if (r < I_C) { p0_transpose_item(F.in[I_WIN1], ODD_IN, D, F.Wt_in1, ODD_IN / 64, 1 << 30, 0, nw + D, scr, r, lane0); continue; } r -= I_C;
            p0_transpose_item(F.in[I_WOUT1], D, MIXW, F.Wt_out1, D / 64, 1 << 30, 0, nullptr, scr, r, lane0);
        }
    }
    __syncthreads();
    constexpr int TROW = 4112;
    LAS unsigned char* tile = F.lds;
    LAS float* rst = (LAS float*)(F.lds + 32 * TROW);
    const float* x = F.in[I_X]; const float* nw0 = F.in[I_NORMW]; const float* wdt = F.in[I_WIN0] + 6144; const float* dtb = F.in[I_DTB];
    for (int blk = blockIdx.x; blk < M / 32; blk += F.G) {
        for (int i = 0; i < 4; ++i) {
            const int rl = F.wave * 4 + i, row = blk * 32 + rl;
            const GAS f32x4* xr = (const GAS f32x4*)(x + (size_t)row * D) + lane0;
            f32x4 v[8]; float ss = 0.f;
#pragma unroll
            for (int j = 0; j < 8; ++j) { v[j] = xr[64 * j]; ss += (v[j][0] * v[j][0] + v[j][1] * v[j][1]) + (v[j][2] * v[j][2] + v[j][3] * v[j][3]); }
            ss = wave_sum(ss);
            const float rstd = rsqrtf(ss * (1.0f / D) + EPS);
            if (lane0 == 0) { F.rstd0[row] = rstd; rst[rl] = rstd; }
            GAS v2u* o8 = (GAS v2u*)(F.xb + (size_t)row * D) + lane0;
#pragma unroll
            for (int j = 0; j < 8; ++j) { v2u w; w.x = pk2(v[j][0], v[j][1]); w.y = pk2(v[j][2], v[j][3]); o8[64 * j] = w; *(LAS v2u*)(tile + rl * TROW + (64 * j + lane0) * 8) = w; }
        }
        LDS_WAIT(); __syncthreads();
        const int r32 = lane0 & 31, hi = lane0 >> 5;
        f32x16 acc = {};
#pragma unroll 8
        for (int ks = 0; ks < 16; ++ks) {
            const int k0 = 256 * F.wave + 16 * ks + 8 * hi;
            const bf16x8 a = *(const LAS bf16x8*)(tile + r32 * TROW + k0 * 2);
            float wv[8];
#pragma unroll
            for (int j = 0; j < 8; ++j) wv[j] = wdt[(size_t)(k0 + j) * EVEN_IN + r32] * nw0[k0 + j];
            v4u bw; bw.x = pk2(wv[0], wv[1]); bw.y = pk2(wv[2], wv[3]); bw.z = pk2(wv[4], wv[5]); bw.w = pk2(wv[6], wv[7]);
            acc = __builtin_amdgcn_mfma_f32_32x32x16_bf16(a, __builtin_bit_cast(bf16x8, bw), acc, 0, 0, 0);
        }
        LDS_WAIT(); __syncthreads();
        LAS float* red = (LAS float*)F.lds;
#pragma unroll
        for (int r = 0; r < 16; ++r) { const int row = (r & 3) + 8 * (r >> 2) + 4 * hi; red[(F.wave * 32 + row) * 33 + r32] = acc[r]; }
        LDS_WAIT(); __syncthreads();
        for (int idx = tid0; idx < 1024; idx += NWAVES * 64) {
            const int row = idx >> 5, h = idx & 31; float s = 0.f;
#pragma unroll
            for (int w = 0; w < 8; ++w) s += red[(w * 32 + row) * 33 + h];
            F.dt[(size_t)(blk * 32 + row) * 32 + h] = softplusf_(s * rst[row] + dtb[h]);
        }
        LDS_WAIT(); __syncthreads();
    }
}
__device__ __forceinline__ void final_norm(Frame& F) {
    const int gw = (int)blockIdx.x * NWAVES + F.wave, NGW = F.G * NWAVES;
    const int lane0 = F_LANE;
    const GAS f32x4* fw = (const GAS f32x4*)F.in[I_FW] + lane0;
    for (int row = gw; row < M; row += NGW) {
        GAS f32x4* o = (GAS f32x4*)(F.out + (size_t)row * D) + lane0;
        const f32x4 a = *(const f32x4*)(F.ssq2 + (size_t)row * 8), b = *(const f32x4*)(F.ssq2 + (size_t)row * 8 + 4);
        const float rs = rsqrtf((((a[0] + a[1]) + (a[2] + a[3])) + ((b[0] + b[1]) + (b[2] + b[3]))) * (1.0f / D) + EPS);
        f32x4 v[8];
#pragma unroll
        for (int j = 0; j < 8; ++j) v[j] = o[64 * j];
#pragma unroll
        for (int j = 0; j < 8; ++j) o[64 * j] = v[j] * rs * fw[64 * j];
    }
}


__device__ __forceinline__ float gelu_fast(float v) { const float z = 0.7978845608028654f * (v + 0.044715f * v * v * v); return v * __builtin_amdgcn_rcpf(1.0f + __expf(-2.0f * z)); }
__device__ __forceinline__ float silu_fast(float v) { return v * __builtin_amdgcn_rcpf(1.0f + __expf(-v)); }
__device__ __forceinline__ void unpack8(const v4u r, float (&f)[8]) {
    f[0] = __uint_as_float(r.x << 16); f[1] = __uint_as_float(r.x & 0xffff0000u); f[2] = __uint_as_float(r.y << 16); f[3] = __uint_as_float(r.y & 0xffff0000u);
    f[4] = __uint_as_float(r.z << 16); f[5] = __uint_as_float(r.z & 0xffff0000u); f[6] = __uint_as_float(r.w << 16); f[7] = __uint_as_float(r.w & 0xffff0000u);
}
namespace att {
constexpr int STAGE = 32768, KOFF = 8192, VOFF = 16384, NSTG = 4;
constexpr float CEXP = 0.08838834764831845f * 1.4426950408889634f;
typedef short v4i16_t __attribute__((ext_vector_type(4)));
__device__ __forceinline__ v4i16_t vtr(LAS unsigned char* p) { return __builtin_amdgcn_ds_read_tr16_b64_v4i16((LAS v4i16_t*)p); }
__device__ __forceinline__ float swap_max(float v) { auto rr = __builtin_amdgcn_permlane32_swap(__float_as_uint(v), __float_as_uint(v), false, false); return fmaxf(__uint_as_float(rr[0]), __uint_as_float(rr[1])); }
__device__ __forceinline__ float swap_sum(float v) { auto rr = __builtin_amdgcn_permlane32_swap(__float_as_uint(v), __float_as_uint(v), false, false); return __uint_as_float(rr[0]) + __uint_as_float(rr[1]); }
__device__ __forceinline__ int crow(int r, int hi) { return (r & 3) + 8 * (r >> 2) + 4 * hi; }
__device__ __forceinline__ void glds16(const void* gsrc, unsigned lds_dst) { unsigned keep;
    asm volatile("s_mov_b32 %0, m0\n\ts_mov_b32 m0, %2\n\ts_nop 0\n\tglobal_load_lds_dwordx4 %1, off\n\ts_mov_b32 m0, %0" : "=&s"(keep) : "v"(gsrc), "s"(lds_dst) : "memory"); }
}
template <int VAR> __device__ __forceinline__ void attn_phase(Frame& F) {
    using namespace att;
    const int w = F.wave, map = w >> 2, sb = w & 3;
    LAS unsigned char* lds = F.lds;
    const bf16* qkvg = F.qkvg;
    const int vcu = ((int)blockIdx.x & 7) * (F.G >> 3) + ((int)blockIdx.x >> 3);
    for (int vu = vcu; vu < 64 * 4; vu += F.G) {
        const int bh = vu >> 2, s4 = vu & 3, b = bh >> 4, h = bh & 15;
        for (int ui = 0; ui < 4; ++ui) {
            const int qb = ui == 0 ? 15 - s4 : (ui == 1 ? 11 - s4 : (ui == 2 ? 4 + s4 : s4));
            const int q0 = qb * 128, NH = (q0 + 128) / 32, rb = q0 / 32 + sb;
            const int lane = F_LANE;
            const int r32 = lane & 31, hi = lane >> 5;
            const unsigned koff = (unsigned)((4 * w + (lane >> 4)) * ODD_IN + (((lane & 15) ^ ((4 * w + (lane >> 4)) & 15)) * 8));
            const unsigned voff0 = (unsigned)((lane >> 2) * ODD_IN + 32 * w + 8 * (lane & 3));
            const int kq = 4 * hi + ((lane & 15) >> 2);
            const int kbase = map * KOFF + r32 * 256, kswz = r32 & 15;
            const int vbase = VOFF + kq * 64 + 32 * ((lane >> 4) & 1) + 8 * (lane & 3);
            const bf16* kg = qkvg + (size_t)b * S * ODD_IN + 4096 + h * 256;
            const bf16* vg = qkvg + (size_t)b * S * ODD_IN + 8192 + h * 256;
            f32x16 O[8];
#pragma unroll
            for (int i = 0; i < 8; ++i) O[i] = (f32x16){};
            float m = -1e30f, l = 0.f;
            const unsigned lds0 = (unsigned)(uintptr_t)lds;
#define ATT_ISSUE(i_) do { const size_t _ro = (size_t)(i_) * 32 * ODD_IN; const unsigned _sb = lds0 + (unsigned)(((i_) & (NSTG - 1)) * STAGE); \
                glds16(kg + _ro + koff, (unsigned)__builtin_amdgcn_readfirstlane(_sb + w * 1024)); \
                glds16(kg + _ro + 128 + koff, (unsigned)__builtin_amdgcn_readfirstlane(_sb + KOFF + w * 1024)); \
                glds16(vg + _ro + voff0, (unsigned)__builtin_amdgcn_readfirstlane(_sb + VOFF + (2 * w) * 1024)); \
                glds16(vg + _ro + voff0 + (size_t)16 * ODD_IN, (unsigned)__builtin_amdgcn_readfirstlane(_sb + VOFF + (2 * w + 1) * 1024)); } while (0)
            if (VAR != 1) { ATT_ISSUE(0); ATT_ISSUE(1); ATT_ISSUE(2); }
            bf16x8 qf[8];
            { const bf16* qp = qkvg + ((size_t)b * S + q0 + 32 * sb + r32) * ODD_IN + h * 256 + map * 128 + 8 * hi;
#pragma unroll
              for (int ks = 0; ks < 8; ++ks) qf[ks] = *(const bf16x8*)(qp + 16 * ks); }
            asm volatile("s_waitcnt vmcnt(0)" ::: "memory");
#pragma unroll
            for (int ks = 0; ks < 8; ++ks) asm volatile("" : "+v"(qf[ks]));
            for (int hidx = 0; hidx < NH; ++hidx) {
                if (VAR == 1) {} else if (hidx + 2 < NH) asm volatile("s_waitcnt vmcnt(8)" ::: "memory"); else if (hidx + 1 < NH) asm volatile("s_waitcnt vmcnt(4)" ::: "memory"); else asm volatile("s_waitcnt vmcnt(0)" ::: "memory");
                asm volatile("s_waitcnt lgkmcnt(0)" ::: "memory"); if (VAR != 4) __builtin_amdgcn_s_barrier(); asm volatile("" ::: "memory");
                if (VAR != 1 && hidx + 3 < NH) ATT_ISSUE(hidx + 3);
                LAS unsigned char* st = lds + (hidx & (NSTG - 1)) * STAGE;
                {
                    if (hidx <= rb) {
                        f32x16 p = (f32x16){};
                        bf16x8 kf[8];
#pragma unroll
                        for (int ks = 0; ks < 8; ++ks) kf[ks] = *(const LAS bf16x8*)(st + kbase + (((2 * ks + hi) ^ kswz) << 4));
                        __builtin_amdgcn_sched_barrier(0);
#pragma unroll
                        for (int ks = 0; ks < 8; ++ks) p = __builtin_amdgcn_mfma_f32_32x32x16_bf16(kf[ks], qf[ks], p, 0, 0, 0);
#define ATT_VLOAD(dst, vp_, b0) _Pragma("unroll") for (int _b = 0; _b < 4; ++_b) { dst[_b][0] = vtr((vp_) + ((b0) + _b) * 2048); dst[_b][1] = vtr((vp_) + ((b0) + _b) * 2048 + 8 * 64); }
#define ATT_VFRAG(src, i) ((bf16x8){src[i][0][0], src[i][0][1], src[i][0][2], src[i][0][3], src[i][1][0], src[i][1][1], src[i][1][2], src[i][1][3]})
                        LAS unsigned char* vp0 = st + vbase;
                        att::v4i16_t va[4][2];
                        ATT_VLOAD(va, vp0, 0);
                        __builtin_amdgcn_sched_barrier(0);
                        if (VAR != 3) {
                        if (hidx == rb) {
#pragma unroll
                            for (int r = 0; r < 16; ++r) if (crow(r, hi) > r32) p[r] = -INFINITY;
                        }
                        float tm = p[0];
#pragma unroll
                        for (int r = 1; r < 16; ++r) tm = fmaxf(tm, p[r]);
                        tm = swap_max(tm);
                        if (__any((tm - m) * CEXP > 8.0f)) {
                            const float mn = fmaxf(m, tm);
                            const float al = __builtin_amdgcn_exp2f((m - mn) * CEXP);
                            l *= al;
#pragma unroll
                            for (int i = 0; i < 8; ++i) O[i] = O[i] * al;
                            m = mn;
                        }
                        const float mc = -m * CEXP;
                        float ls = 0.f;
#pragma unroll
                        for (int r = 0; r < 16; ++r) { p[r] = __builtin_amdgcn_exp2f(__builtin_fmaf(p[r], CEXP, mc)); ls += p[r]; }
                        l += ls;
                        }
                        v4u pw0, pw1;
                        pw0.x = pk2(p[0], p[1]); pw0.y = pk2(p[2], p[3]); pw0.z = pk2(p[4], p[5]); pw0.w = pk2(p[6], p[7]);
                        pw1.x = pk2(p[8], p[9]); pw1.y = pk2(p[10], p[11]); pw1.z = pk2(p[12], p[13]); pw1.w = pk2(p[14], p[15]);
                        const bf16x8 pf0 = __builtin_bit_cast(bf16x8, pw0), pf1 = __builtin_bit_cast(bf16x8, pw1);
                        __builtin_amdgcn_sched_barrier(0);
                        if (VAR == 2) { asm volatile("" :: "v"(pf0), "v"(pf1), "v"(va[0][0]), "v"(va[1][0]), "v"(va[2][1]), "v"(va[3][1])); } else
                        { att::v4i16_t vb2[4][2];
                          ATT_VLOAD(vb2, vp0, 4);
#pragma unroll
                          for (int blk = 0; blk < 4; ++blk) O[blk] = __builtin_amdgcn_mfma_f32_32x32x16_bf16(ATT_VFRAG(va, blk), pf0, O[blk], 0, 0, 0);
                          __builtin_amdgcn_sched_barrier(0);
                          ATT_VLOAD(va, vp0 + 16 * 64, 0);
#pragma unroll
                          for (int blk = 0; blk < 4; ++blk) O[4 + blk] = __builtin_amdgcn_mfma_f32_32x32x16_bf16(ATT_VFRAG(vb2, blk), pf0, O[4 + blk], 0, 0, 0);
                          __builtin_amdgcn_sched_barrier(0);
                          ATT_VLOAD(vb2, vp0 + 16 * 64, 4);
#pragma unroll
                          for (int blk = 0; blk < 4; ++blk) O[blk] = __builtin_amdgcn_mfma_f32_32x32x16_bf16(ATT_VFRAG(va, blk), pf1, O[blk], 0, 0, 0);
                          __builtin_amdgcn_sched_barrier(0);
#pragma unroll
                          for (int blk = 0; blk < 4; ++blk) O[4 + blk] = __builtin_amdgcn_mfma_f32_32x32x16_bf16(ATT_VFRAG(vb2, blk), pf1, O[4 + blk], 0, 0, 0);
                        }
#undef ATT_VLOAD
#undef ATT_VFRAG
                        __builtin_amdgcn_sched_barrier(0);
                    }
                }
            }
#undef ATT_ISSUE
            const float ltot = swap_sum(l);
            float lam = 1.0f;
            if (map == 1) { const float* lq1 = F.in[I_LQ1]; const float* lk1 = F.in[I_LK1]; const float* lq2 = F.in[I_LQ2]; const float* lk2 = F.in[I_LK2];
                float l1 = lq1[lane] * lk1[lane] + lq1[lane + 64] * lk1[lane + 64], l2 = lq2[lane] * lk2[lane] + lq2[lane + 64] * lk2[lane + 64];
                l1 = wave_sum(l1); l2 = wave_sum(l2); lam = __expf(l1) - __expf(l2) + LAMBDA_INIT; }
            const float inv = lam / ltot;
            const int ch = lane & 31;
            v4u gv[8];
#pragma unroll
            for (int it = 0; it < 8; ++it) gv[it] = *(const v4u*)(qkvg + ((size_t)b * S + q0 + 32 * sb + 16 * map + it * 2 + (lane >> 5)) * ODD_IN + 12288 + h * 256 + ch * 8);
            LDS_WAIT(); __syncthreads();
            constexpr int XP = 1040;
            LAS unsigned char* X = lds + sb * (32 * XP);
            if (map == 1) {
#pragma unroll
                for (int blk = 0; blk < 8; ++blk)
#pragma unroll
                    for (int g4 = 0; g4 < 4; ++g4) {
                        const f32x4 v = {O[blk][4 * g4] * inv, O[blk][4 * g4 + 1] * inv, O[blk][4 * g4 + 2] * inv, O[blk][4 * g4 + 3] * inv};
                        *(LAS f32x4*)(X + r32 * XP + (32 * blk + 8 * g4 + 4 * hi) * 4) = v;
                    }
            }
            LDS_WAIT(); __syncthreads();
            LAS unsigned char* T = X;
            if (map == 0) {
                float ss = 0.f;
#pragma unroll
                for (int blk = 0; blk < 8; ++blk)
#pragma unroll
                    for (int g4 = 0; g4 < 4; ++g4) {
                        const f32x4 xv = *(const LAS f32x4*)(X + r32 * XP + (32 * blk + 8 * g4 + 4 * hi) * 4);
#pragma unroll
                        for (int i = 0; i < 4; ++i) { const float o = O[blk][4 * g4 + i] * inv - xv[i]; O[blk][4 * g4 + i] = o; ss += o * o; }
                    }
                ss = swap_sum(ss);
                const float rsv = rsqrtf(ss * (1.0f / 256.0f) + EPS) * (1.0f - LAMBDA_INIT);
                LDS_WAIT();
#pragma unroll
                for (int blk = 0; blk < 8; ++blk)
#pragma unroll
                    for (int g4 = 0; g4 < 4; ++g4) {
                        v2u pk; pk.x = pk2(O[blk][4 * g4] * rsv, O[blk][4 * g4 + 1] * rsv); pk.y = pk2(O[blk][4 * g4 + 2] * rsv, O[blk][4 * g4 + 3] * rsv);
                        *(LAS v2u*)(T + r32 * 528 + (32 * blk + 8 * g4 + 4 * hi) * 2) = pk;
                    }
            }
            LDS_WAIT(); __syncthreads();
            {
                const float* subw = F.in[I_SUBW];
                const f32x4 sw0 = *(const f32x4*)(subw + ch * 8), sw1 = *(const f32x4*)(subw + ch * 8 + 4);
#pragma unroll
                for (int it = 0; it < 8; ++it) {
                    const int row = 16 * map + it * 2 + (lane >> 5);
                    const size_t grow = (size_t)b * S + q0 + 32 * sb + row;
                    const v4u ov = *(const LAS v4u*)(T + row * 528 + ch * 16);
                    float o8[8], g8[8]; unpack8(ov, o8); unpack8(gv[it], g8);
                    v4u res;
                    res.x = pk2(o8[0] * sw0[0] * silu_fast(g8[0]), o8[1] * sw0[1] * silu_fast(g8[1]));
                    res.y = pk2(o8[2] * sw0[2] * silu_fast(g8[2]), o8[3] * sw0[3] * silu_fast(g8[3]));
                    res.z = pk2(o8[4] * sw1[0] * silu_fast(g8[4]), o8[5] * sw1[1] * silu_fast(g8[5]));
                    res.w = pk2(o8[6] * sw1[2] * silu_fast(g8[6]), o8[7] * sw1[3] * silu_fast(g8[7]));
                    *(v4u*)(F.ocat + grow * MIXW + h * 256 + ch * 8) = res;
                }
            }
            LDS_WAIT(); __syncthreads();
        }
    }
}


__device__ __forceinline__ void sgu_stats_phase(Frame& F, float* mu, float* rs) {
    const int gw = (int)blockIdx.x * NWAVES + F.wave, NGW = F.G * NWAVES, lane = F_LANE;
    for (int row = gw; row < M; row += NGW) {
        const v4u* vp = (const v4u*)(F.proj0 + (size_t)row * N1 + C_V) + lane;
        float g[32]; float sm = 0.f;
#pragma unroll
        for (int i = 0; i < 4; ++i) { float f[8]; unpack8(vp[64 * i], f);
#pragma unroll
            for (int j = 0; j < 8; ++j) { g[8 * i + j] = gelu_fast(f[j]); sm += g[8 * i + j]; } }
        const float mean = wave_sum(sm) * (1.0f / 2048.0f);
        float q = 0.f;
#pragma unroll
        for (int i = 0; i < 32; ++i) { const float d = g[i] - mean; q += d * d; }
        const float var = wave_sum(q) * (1.0f / 2048.0f);
        if (lane == 0) { mu[row] = mean; rs[row] = rsqrtf(var + EPS); }
    }
}
__device__ __forceinline__ void sgu_phase(Frame& F, const float* mu, const float* rs) {
    const int lane = F_LANE, tid = F.wave * 64 + lane, w = F.wave, r32 = lane & 31, hi = lane >> 5;
    LAS unsigned char* lds = F.lds;
    LAS unsigned char* VIMG = lds;
    LAS float* MT = (LAS float*)(lds + 32768);
    const bf16* proj0 = F.proj0; const float* ln_w = F.in[I_LNW]; const float* ln_b = F.in[I_LNB]; const float* wsg = F.in[I_SGUWS]; const float* sb = F.in[I_SGUB];
    const int ck = tid & 15;
    for (int item = (int)blockIdx.x; item < 64 * 16; item += F.G) {
        const int g = item & 15, row0 = (item >> 4) * 128;
        const int chb = g * 128 + ck * 8;
        v4u ur[4], zr[4];
        { float lw[8], lb[8];
#pragma unroll
          for (int j = 0; j < 8; ++j) { lw[j] = ln_w[chb + j]; lb[j] = ln_b[chb + j]; }
#pragma unroll
          for (int i = 0; i < 4; ++i) {
              const int s = (tid >> 4) + 32 * i; const size_t ro = (size_t)(row0 + s) * N1;
              const v4u vr = *(const v4u*)(proj0 + ro + C_V + chb);
              ur[i] = *(const v4u*)(proj0 + ro + C_U + chb); zr[i] = *(const v4u*)(proj0 + ro + C_ZB + chb);
              const float m_ = mu[row0 + s], r_ = rs[row0 + s];
              float f[8]; unpack8(vr, f);
#pragma unroll
              for (int j = 0; j < 8; ++j) f[j] = (gelu_fast(f[j]) - m_) * r_ * lw[j] + lb[j];
              v4u o; o.x = pk2(f[0], f[1]); o.y = pk2(f[2], f[3]); o.z = pk2(f[4], f[5]); o.w = pk2(f[6], f[7]);
              *(LAS v4u*)(VIMG + (ck >> 2) * 8192 + s * 64 + (ck & 3) * 16) = o;
          } }
        LDS_WAIT(); __syncthreads();
        { const int tb = w >> 1, cb0 = 2 * (w & 1), t = 32 * tb + r32;
          f32x16 acc0 = {}, acc1 = {};
          const float* wrow = wsg + ((size_t)g * 128 + t) * 128 + 8 * hi;
          LAS unsigned char* vb = VIMG + cb0 * 8192 + (8 * hi + ((lane & 15) >> 2)) * 64 + 32 * ((lane >> 4) & 1) + 8 * (lane & 3);
          for (int ks = 0; ks < 2 * tb + 2; ++ks) {
              const f32x4 w0 = *(const f32x4*)(wrow + 16 * ks), w1 = *(const f32x4*)(wrow + 16 * ks + 4);
              const int s0 = 16 * ks + 8 * hi;
              float wv[8] = {w0[0], w0[1], w0[2], w0[3], w1[0], w1[1], w1[2], w1[3]};
#pragma unroll
              for (int j = 0; j < 8; ++j) wv[j] = (s0 + j <= t) ? wv[j] : 0.f;
              v4u aw; aw.x = pk2(wv[0], wv[1]); aw.y = pk2(wv[2], wv[3]); aw.z = pk2(wv[4], wv[5]); aw.w = pk2(wv[6], wv[7]);
              const bf16x8 af = __builtin_bit_cast(bf16x8, aw);
              LAS unsigned char* vp = vb + ks * 16 * 64;
              const att::v4i16_t b0l = att::vtr(vp), b0h = att::vtr(vp + 4 * 64), b1l = att::vtr(vp + 8192), b1h = att::vtr(vp + 8192 + 4 * 64);
              const bf16x8 bf0 = (bf16x8){b0l[0], b0l[1], b0l[2], b0l[3], b0h[0], b0h[1], b0h[2], b0h[3]};
              const bf16x8 bf1 = (bf16x8){b1l[0], b1l[1], b1l[2], b1l[3], b1h[0], b1h[1], b1h[2], b1h[3]};
              acc0 = __builtin_amdgcn_mfma_f32_32x32x16_bf16(af, bf0, acc0, 0, 0, 0);
              acc1 = __builtin_amdgcn_mfma_f32_32x32x16_bf16(af, bf1, acc1, 0, 0, 0);
          }
          const float* bp = sb + g * 128 + 32 * tb + 4 * hi;
#pragma unroll
          for (int q4 = 0; q4 < 4; ++q4) { const f32x4 bv = *(const f32x4*)(bp + 8 * q4);
#pragma unroll
              for (int i = 0; i < 4; ++i) { const int r = 4 * q4 + i, tt = 32 * tb + att::crow(r, hi);
                  MT[tt * 132 + 32 * cb0 + r32] = acc0[r] + bv[i]; MT[tt * 132 + 32 * cb0 + 32 + r32] = acc1[r] + bv[i]; } }
        }
        LDS_WAIT(); __syncthreads();
#pragma unroll
        for (int i = 0; i < 4; ++i) {
            const int t = (tid >> 4) + 32 * i;
            const f32x4 m0 = *(const LAS f32x4*)(MT + t * 132 + ck * 8), m1 = *(const LAS f32x4*)(MT + t * 132 + ck * 8 + 4);
            float u[8], z[8]; unpack8(ur[i], u); unpack8(zr[i], z);
            const float mm[8] = {m0[0], m0[1], m0[2], m0[3], m1[0], m1[1], m1[2], m1[3]};
            float y[8];
#pragma unroll
            for (int j = 0; j < 8; ++j) y[j] = gelu_fast(u[j]) * mm[j] * silu_fast(z[j]);
            v4u o; o.x = pk2(y[0], y[1]); o.y = pk2(y[2], y[3]); o.z = pk2(y[4], y[5]); o.w = pk2(y[6], y[7]);
            *(v4u*)(F.ycat + (size_t)(row0 + t) * MIXW + 2048 + chb) = o;
        }
    }
    LDS_WAIT(); __syncthreads();
}


namespace ssd {
constexpr int XIMG = 0, BIMG = 65536, CIMG = 98304, CSOFF = 135168, DTOFF = CSOFF + 2048, YT = 65536, YT_PITCH = 528;
__device__ __forceinline__ void dt_scan(Frame& F, int row0, int g) {
    if (F.wave < 4) {
        const int hl = F.wave, hg = 4 * g + hl, lane = F_LANE, t0 = 2 * lane;
        LAS float* CS = (LAS float*)(F.lds + CSOFF) + hl * 128; LAS float* DTS = (LAS float*)(F.lds + DTOFF) + hl * 128;
        const float a = -__expf(F.in[I_ALOG][hg]);
        const float d0 = F.dt[(size_t)(row0 + t0) * 32 + hg], d1 = F.dt[(size_t)(row0 + t0 + 1) * 32 + hg];
        const float x0 = d0 * a, x1 = d1 * a; float sc = x0 + x1;
#pragma unroll
        for (int o = 1; o < 64; o <<= 1) { const float v = __shfl_up(sc, o); if (lane >= o) sc += v; }
        CS[t0] = sc - x1; CS[t0 + 1] = sc; DTS[t0] = d0; DTS[t0 + 1] = d1;
    }
}
template <bool WITH_C, class Sink>
__device__ __forceinline__ void conv_tile(Frame& F, int row0, int g, bool has_halo, const Sink& sink) {
    const int chunk = F_LANE, seg = F.wave;
    if (!WITH_C && chunk >= 48) return;
    const int ch = chunk < 32 ? g * 256 + chunk * 8 : (chunk < 48 ? 2048 + g * 128 + (chunk - 32) * 8 : 3072 + g * 128 + (chunk - 48) * 8);
    const float* cw = F.in[I_CONVW] + ch; const float* cb = F.in[I_CONVB] + ch;
    float w0[8], w1[8], w2[8], w3[8], bs[8];
#pragma unroll
    for (int j = 0; j < 8; ++j) { w0[j] = cw[j]; w1[j] = cw[XBC_W + j]; w2[j] = cw[2 * XBC_W + j]; w3[j] = cw[3 * XBC_W + j]; bs[j] = cb[j]; }
    const bf16* src = F.proj0 + (size_t)row0 * N1 + C_XBC + ch;
    const int t0 = 16 * seg;
    float r0[8], r1[8], r2[8];
    if (t0 > 0 || has_halo) { unpack8(*(const v4u*)(src + (ptrdiff_t)(t0 - 3) * N1), r0); unpack8(*(const v4u*)(src + (ptrdiff_t)(t0 - 2) * N1), r1); unpack8(*(const v4u*)(src + (ptrdiff_t)(t0 - 1) * N1), r2); }
    else {
#pragma unroll
        for (int j = 0; j < 8; ++j) { r0[j] = 0.f; r1[j] = 0.f; r2[j] = 0.f; } }
#pragma unroll
    for (int hb = 0; hb < 2; ++hb) {
        v4u raw[8];
#pragma unroll
        for (int i = 0; i < 8; ++i) raw[i] = *(const v4u*)(src + (size_t)(t0 + 8 * hb + i) * N1);
#pragma unroll
        for (int i = 0; i < 8; ++i) {
            float cur[8], o[8]; unpack8(raw[i], cur);
#pragma unroll
            for (int j = 0; j < 8; ++j) { const float a = bs[j] + w0[j] * r0[j] + w1[j] * r1[j] + w2[j] * r2[j] + w3[j] * cur[j]; o[j] = silu_fast(a); r0[j] = r1[j]; r1[j] = r2[j]; r2[j] = cur[j]; }
            sink(t0 + 8 * hb + i, 8 * hb + i, chunk, o);
        }
        asm volatile("" ::: "memory");
    }
}
}
__device__ __forceinline__ void ssd_phase_a(Frame& F, float* states, float* cdec) {
    using namespace ssd;
    const int lane = F_LANE, w = F.wave, r32 = lane & 31, hi = lane >> 5;
    LAS unsigned char* lds = F.lds;
    for (int item = (int)blockIdx.x; item < NB * 16 * 8; item += F.G) {
        const int g = item & 7, c = (item >> 3) & 15, b = item >> 7, row0 = b * S + c * 128;
        dt_scan(F, row0, g);
        LDS_WAIT(); __syncthreads();
        { LAS float* CS = (LAS float*)(lds + CSOFF); LAS float* DTS = (LAS float*)(lds + DTOFF);
          if (w == 0 && lane < 4) cdec[(b * 16 + c) * 32 + 4 * g + lane] = __expf(CS[lane * 128 + 127]);
          const bool isx = lane < 32; const int hl = isx ? (lane >> 3) : 0;
          const int abase = isx ? (XIMG + (lane >> 2) * 8192 + (lane & 3) * 16) : (BIMG + ((lane - 32) >> 2) * 8192 + ((lane - 32) & 3) * 16);
          const float csend = CS[hl * 128 + 127];
          conv_tile<false>(F, row0, g, c > 0, [&](int t, int t15, int chunk, float (&o)[8]) {
              const float wt = isx ? DTS[hl * 128 + t] * __expf(csend - CS[hl * 128 + t]) : 1.0f;
              v4u pk; pk.x = pk2(o[0] * wt, o[1] * wt); pk.y = pk2(o[2] * wt, o[3] * wt); pk.z = pk2(o[4] * wt, o[5] * wt); pk.w = pk2(o[6] * wt, o[7] * wt);
              *(LAS v4u*)(lds + abase + t * 64) = pk; }); }
        LDS_WAIT(); __syncthreads();
        { f32x16 acc[4];
#pragma unroll
          for (int i = 0; i < 4; ++i) acc[i] = (f32x16){};
          LAS unsigned char* ab = lds + XIMG + w * 8192 + (8 * hi + ((lane & 15) >> 2)) * 64 + 32 * ((lane >> 4) & 1) + 8 * (lane & 3);
          LAS unsigned char* bb = lds + BIMG + (8 * hi + ((lane & 15) >> 2)) * 64 + 32 * ((lane >> 4) & 1) + 8 * (lane & 3);
#pragma unroll 2
          for (int ks = 0; ks < 8; ++ks) {
              const att::v4i16_t al = att::vtr(ab + ks * 1024), ah = att::vtr(ab + ks * 1024 + 256);
              const bf16x8 af = (bf16x8){al[0], al[1], al[2], al[3], ah[0], ah[1], ah[2], ah[3]};
#pragma unroll
              for (int nb = 0; nb < 4; ++nb) {
                  const att::v4i16_t bl = att::vtr(bb + nb * 8192 + ks * 1024), bh = att::vtr(bb + nb * 8192 + ks * 1024 + 256);
                  const bf16x8 bfr = (bf16x8){bl[0], bl[1], bl[2], bl[3], bh[0], bh[1], bh[2], bh[3]};
                  acc[nb] = __builtin_amdgcn_mfma_f32_32x32x16_bf16(af, bfr, acc[nb], 0, 0, 0);
              }
          }
          float* sp = states + ((size_t)((b * 16 + c) * 32 + 4 * g + (w >> 1)) * 64 + 32 * (w & 1)) * 128;
#pragma unroll
          for (int nb = 0; nb < 4; ++nb)
#pragma unroll
              for (int r = 0; r < 16; ++r) sp[att::crow(r, hi) * 128 + 32 * nb + r32] = acc[nb][r];
        }
        LDS_WAIT(); __syncthreads();
    }
}
__device__ __forceinline__ void ssd_phase_b(Frame& F, const float* states, const float* cdec, bf16* prev) {
    for (int gid = (int)blockIdx.x * (NWAVES * 64) + F_TID; gid < NB * 32 * 64 * 16; gid += F.G * NWAVES * 64) {
        const int nck = gid & 15, p = (gid >> 4) & 63, hg = (gid >> 10) & 31, b = gid >> 15;
        f32x4 h0 = {0.f, 0.f, 0.f, 0.f}, h1 = {0.f, 0.f, 0.f, 0.f};
#pragma unroll 5
        for (int c = 0; c < 15; ++c) {
            const size_t off = ((size_t)((b * 16 + c) * 32 + hg) * 64 + p) * 128 + nck * 8;
            const f32x4 s0 = *(const f32x4*)(states + off), s1 = *(const f32x4*)(states + off + 4);
            const float cd = cdec[(b * 16 + c) * 32 + hg];
            h0 = h0 * cd + s0; h1 = h1 * cd + s1;
            v4u pk; pk.x = pk2(h0[0], h0[1]); pk.y = pk2(h0[2], h0[3]); pk.z = pk2(h1[0], h1[1]); pk.w = pk2(h1[2], h1[3]);
            *(v4u*)(prev + off + (size_t)32 * 64 * 128) = pk;
        }
    }
}
__device__ __forceinline__ void ssd_phase_c(Frame& F, const bf16* prev) {
    using namespace ssd;
    const int lane = F_LANE, w = F.wave, tid = w * 64 + lane, r32 = lane & 31, hi = lane >> 5;
    LAS unsigned char* lds = F.lds;
    const float* dsk = F.in[I_DSKIP]; const float* nw = F.in[I_SSDNW];
    for (int item = (int)blockIdx.x; item < NB * 16 * 8; item += F.G) {
        const int g = item & 7, c = (item >> 3) & 15, b = item >> 7, row0 = b * S + c * 128;
        dt_scan(F, row0, g);
        { const bool isx = lane < 32; const int cc = (lane - 32) & 15;
          const int xbase = XIMG + (lane >> 2) * 8192 + (lane & 3) * 16, bcbase = lane < 48 ? BIMG : CIMG;
          conv_tile<true>(F, row0, g, c > 0, [&](int t, int t15, int chunk, float (&o)[8]) {
              v4u pk; pk.x = pk2(o[0], o[1]); pk.y = pk2(o[2], o[3]); pk.z = pk2(o[4], o[5]); pk.w = pk2(o[6], o[7]);
              const int addr = isx ? (xbase + t * 64) : (bcbase + t * 256 + ((cc ^ t15) << 4));
              *(LAS v4u*)(lds + addr) = pk; }); }
        LDS_WAIT(); __syncthreads();
        {
            const int lb = w & 3, hp = w >> 2, l = 32 * lb + r32;
            LAS float* CS = (LAS float*)(lds + CSOFF); LAS float* DTS = (LAS float*)(lds + DTOFF);
            f32x16 acc[2][2];
#pragma unroll
            for (int j = 0; j < 2; ++j)
#pragma unroll
                for (int pb = 0; pb < 2; ++pb) acc[j][pb] = (f32x16){};
            bf16x8 cf[8];
#pragma unroll
            for (int ks = 0; ks < 8; ++ks) cf[ks] = *(const LAS bf16x8*)(lds + CIMG + l * 256 + (((2 * ks + hi) ^ (l & 15)) << 4));
            float csl[2];
#pragma unroll
            for (int j = 0; j < 2; ++j) csl[j] = CS[(2 * hp + j) * 128 + l];
            if (c > 0) {
#pragma unroll
                for (int j = 0; j < 2; ++j) {
                    const bf16* pp = prev + ((size_t)((b * 16 + c) * 32 + 4 * g + 2 * hp + j) * 64 + r32) * 128 + 8 * hi;
#pragma unroll
                    for (int pb = 0; pb < 2; ++pb) {
#pragma unroll
                        for (int ks = 0; ks < 8; ++ks) {
                            const bf16x8 pf = *(const bf16x8*)(pp + (size_t)pb * 32 * 128 + 16 * ks);
                            acc[j][pb] = __builtin_amdgcn_mfma_f32_32x32x16_bf16(pf, cf[ks], acc[j][pb], 0, 0, 0);
                        }
                    }
                    const float e = __expf(csl[j]);
                    acc[j][0] = acc[j][0] * e; acc[j][1] = acc[j][1] * e;
                }
            }
            LAS unsigned char* xb0 = lds + XIMG + (4 * hi + ((lane & 15) >> 2)) * 64 + 32 * ((lane >> 4) & 1) + 8 * (lane & 3);
            for (int sbk = 0; sbk <= lb; ++sbk) {
                f32x16 X = (f32x16){};
                const int srow = 32 * sbk + r32;
#pragma unroll
                for (int ks = 0; ks < 8; ++ks) {
                    const bf16x8 bfr = *(const LAS bf16x8*)(lds + BIMG + srow * 256 + (((2 * ks + hi) ^ (srow & 15)) << 4));
                    X = __builtin_amdgcn_mfma_f32_32x32x16_bf16(bfr, cf[ks], X, 0, 0, 0);
                }
#pragma unroll
                for (int j = 0; j < 2; ++j) {
                    const int hl = 2 * hp + j;
                    float xh[16];
#pragma unroll
                    for (int q4 = 0; q4 < 4; ++q4) {
                        const f32x4 cs4 = *(const LAS f32x4*)(CS + hl * 128 + 32 * sbk + 8 * q4 + 4 * hi), dt4 = *(const LAS f32x4*)(DTS + hl * 128 + 32 * sbk + 8 * q4 + 4 * hi);
#pragma unroll
                        for (int i = 0; i < 4; ++i) { const int r = 4 * q4 + i, s_ = 32 * sbk + 8 * q4 + 4 * hi + i;
                            const float v = X[r] * __expf(csl[j] - cs4[i]) * dt4[i]; xh[r] = (s_ <= l) ? v : 0.f; }
                    }
                    v4u p0, p1;
                    p0.x = pk2(xh[0], xh[1]); p0.y = pk2(xh[2], xh[3]); p0.z = pk2(xh[4], xh[5]); p0.w = pk2(xh[6], xh[7]);
                    p1.x = pk2(xh[8], xh[9]); p1.y = pk2(xh[10], xh[11]); p1.z = pk2(xh[12], xh[13]); p1.w = pk2(xh[14], xh[15]);
                    const bf16x8 pf0 = __builtin_bit_cast(bf16x8, p0), pf1 = __builtin_bit_cast(bf16x8, p1);
#pragma unroll
                    for (int s2 = 0; s2 < 2; ++s2)
#pragma unroll
                        for (int pb = 0; pb < 2; ++pb) {
                            LAS unsigned char* xp = xb0 + (2 * hl + pb) * 8192 + (32 * sbk + 16 * s2) * 64;
                            const att::v4i16_t lo = att::vtr(xp), hi4 = att::vtr(xp + 8 * 64);
                            const bf16x8 xf = (bf16x8){lo[0], lo[1], lo[2], lo[3], hi4[0], hi4[1], hi4[2], hi4[3]};
                            acc[j][pb] = __builtin_amdgcn_mfma_f32_32x32x16_bf16(xf, s2 == 0 ? pf0 : pf1, acc[j][pb], 0, 0, 0);
                        }
                }
            }
            LDS_WAIT(); __syncthreads();
#pragma unroll
            for (int j = 0; j < 2; ++j)
#pragma unroll
                for (int pb = 0; pb < 2; ++pb)
#pragma unroll
                    for (int q4 = 0; q4 < 4; ++q4) {
                        v2u pk; pk.x = pk2(acc[j][pb][4 * q4], acc[j][pb][4 * q4 + 1]); pk.y = pk2(acc[j][pb][4 * q4 + 2], acc[j][pb][4 * q4 + 3]);
                        *(LAS v2u*)(lds + YT + l * YT_PITCH + ((2 * hp + j) * 64 + 32 * pb + 8 * q4 + 4 * hi) * 2) = pk;
                    }
        }
        LDS_WAIT(); __syncthreads();
        {
            const int ckk = tid & 31, chg = g * 256 + ckk * 8;
            const float Dk = dsk[4 * g + (ckk >> 3)];
            float nwv[8];
#pragma unroll
            for (int j = 0; j < 8; ++j) nwv[j] = nw[chg + j];
#pragma unroll 2
            for (int i = 0; i < 8; ++i) {
                const int t = (tid >> 5) + 16 * i;
                const v4u yr = *(const LAS v4u*)(lds + YT + t * YT_PITCH + ckk * 16);
                const v4u xr = *(const LAS v4u*)(lds + XIMG + (ckk >> 2) * 8192 + t * 64 + (ckk & 3) * 16);
                const v4u zr = *(const v4u*)(F.proj0 + (size_t)(row0 + t) * N1 + C_ZA + chg);
                float y[8], x[8], z[8]; unpack8(yr, y); unpack8(xr, x); unpack8(zr, z);
                float v[8]; float ss = 0.f;
#pragma unroll
                for (int j = 0; j < 8; ++j) { v[j] = (y[j] + Dk * x[j]) * silu_fast(z[j]); ss += v[j] * v[j]; }
#pragma unroll
                for (int o = 1; o < 32; o <<= 1) ss += __shfl_xor(ss, o);
                const float rsv = rsqrtf(ss * (1.0f / 256.0f) + EPS);
                v4u o; o.x = pk2(v[0] * rsv * nwv[0], v[1] * rsv * nwv[1]); o.y = pk2(v[2] * rsv * nwv[2], v[3] * rsv * nwv[3]);
                o.z = pk2(v[4] * rsv * nwv[4], v[5] * rsv * nwv[5]); o.w = pk2(v[6] * rsv * nwv[6], v[7] * rsv * nwv[7]);
                *(v4u*)(F.ycat + (size_t)(row0 + t) * MIXW + chg) = o;
            }
        }
        LDS_WAIT(); __syncthreads();
    }
}

enum Phase { PH_PRO = 0, PH_G1, PH_SSD_A, PH_SSD_B, PH_SSD_C, PH_G2, PH_G3, PH_ATT, PH_G4, PH_FIN, PH_N };
struct Args { const float* in[22]; float* out; unsigned char* ws; int ph_lo, ph_hi, li, pad; };
template <int VAR> __global__ void __launch_bounds__(NWAVES * 64, 2) mega(Args args) {
    extern __shared__ __attribute__((aligned(16))) unsigned char lds[];
    Frame F;
    F.lds = (LAS unsigned char*)lds;
    F.MISC = (volatile LAS unsigned*)(F.lds + LDSCTL_OFF);
    F.wave = __builtin_amdgcn_readfirstlane((int)threadIdx.x >> 6); F.G = gridDim.x;
    unsigned char* ws = args.ws;
    F.ctl = (unsigned*)(ws + WS_CTL);
#pragma unroll
    for (int i = 0; i < 22; ++i) F.in[i] = args.in[i];
    F.out = args.out;
    F.Wt_in0 = (bf16*)(ws + WS_WIN0); F.Wt_out0 = (bf16*)(ws + WS_WOUT0); F.Wt_in1 = (bf16*)(ws + WS_WIN1); F.Wt_out1 = (bf16*)(ws + WS_WOUT1);
    F.xb = (bf16*)(ws + WS_XB); F.proj0 = (bf16*)(ws + WS_PROJ0); F.ycat = (bf16*)(ws + WS_YCAT); F.h1b = F.xb; F.qkvg = F.proj0; F.ocat = F.ycat;
    F.dt = (float*)(ws + WS_DT); F.rstd0 = (float*)(ws + WS_RSTD0); F.ssq1 = (float*)(ws + WS_SSQ1); F.ssq2 = (float*)(ws + WS_SSQ2);
    if (threadIdx.x < 64) ((LAS unsigned*)(F.lds + LDSCTL_OFF))[threadIdx.x] = 0u;
    __syncthreads();
    const int lo = args.ph_lo, hi = args.ph_hi;
    XcdBarrier bar; bar.bar = F.ctl + CW_BAR + args.li * XCD_BAR_WORDS; bar.x = 0; bar.st = nullptr;
    if (hi - lo > 1) bar = xcd_barrier_post(F.ctl + CW_BAR + args.li * XCD_BAR_WORDS, F.MISC + 8);
#define IN(k) (lo <= (k) && (k) < hi)
#define SEAM(k) do { if (IN(k) && IN((k) + 1)) xcd_barrier(bar); } while (0)

    if (IN(PH_PRO)) { p0_prologue(F); }
    SEAM(PH_PRO);
    if (IN(PH_G1)) {
        pg8::Gemm g{F.xb, F.Wt_in0, M, N1, D}; pg8::StaticOrder S; S.init(M, N1, F.G, (int)blockIdx.x);
        pg8::EpiRowScaleBf16<1> E{F.proj0, N1, F.rstd0};
        pg8::gemm_phase<pg8::EpiRowScaleBf16<1>, pg8::StaticOrder, true, true>(F.lds, g, S, E);
    }
    SEAM(PH_G1);
    float* sgu_mu = (float*)(ws + WS_SGU_MU); float* sgu_rs = (float*)(ws + WS_SGU_RS);
    float* states = (float*)(ws + WS_STATES); float* cdec = (float*)(ws + WS_CDEC); bf16* prevb = (bf16*)(ws + WS_XB);
    if (IN(PH_SSD_A)) { ssd_phase_a(F, states, cdec); sgu_stats_phase(F, sgu_mu, sgu_rs); }
    SEAM(PH_SSD_A);
    if (IN(PH_SSD_B)) { ssd_phase_b(F, states, cdec, prevb); sgu_phase(F, sgu_mu, sgu_rs); }
    SEAM(PH_SSD_B);
    if (IN(PH_SSD_C)) { ssd_phase_c(F, prevb); }
    SEAM(PH_SSD_C);
    if (IN(PH_G2)) {
        pg8::Gemm g{F.ycat, F.Wt_out0, M, D, MIXW}; pg8::StaticOrder S; S.init(M, D, F.G, (int)blockIdx.x);
        pg8::EpiResid<true> E{F.in[I_X], F.out, F.h1b, F.ssq1, D};
        pg8::gemm_phase<pg8::EpiResid<true>, pg8::StaticOrder, false, true>(F.lds, g, S, E);
    }
    SEAM(PH_G2);
    if (IN(PH_G3)) {
        pg8::Gemm g{F.h1b, F.Wt_in1, M, ODD_IN, D}; pg8::StaticOrder S; S.init(M, ODD_IN, F.G, (int)blockIdx.x);
        pg8::EpiRowScaleBf16<8> E{F.qkvg, ODD_IN, F.ssq1};
        pg8::gemm_phase<pg8::EpiRowScaleBf16<8>, pg8::StaticOrder, true, true>(F.lds, g, S, E);
    }
    SEAM(PH_G3);
    if (IN(PH_ATT)) { attn_phase<VAR>(F); }
    SEAM(PH_ATT);
    if (IN(PH_G4)) {
        pg8::Gemm g{F.ocat, F.Wt_out1, M, D, MIXW}; pg8::StaticOrder S; S.init(M, D, F.G, (int)blockIdx.x);
        pg8::EpiResid<false> E{F.out, F.out, nullptr, F.ssq2, D};
        pg8::gemm_phase<pg8::EpiResid<false>, pg8::StaticOrder, false, true>(F.lds, g, S, E);
    }
    SEAM(PH_G4);
    if (IN(PH_FIN)) { final_norm(F); }
#undef IN
#undef SEAM
}

extern "C" void kernel_launch(void* const* d_in, const int* in_sizes, int n_in, void* d_out, int out_size, void* d_ws, size_t ws_size, hipStream_t stream) {
    static int grid = 0;
    if (grid == 0) {
        if (n_in != 22 || ws_size < WS_END || out_size != M * D) { fprintf(stderr, "kernel_launch: unexpected n_in %d / out_size %d / ws_size %zu (< %zu)\n", n_in, out_size, ws_size, (size_t)WS_END); grid = -1; return; }
        int dev = 0, cus = 0, per_cu = 0;
        if (hipGetDevice(&dev) != hipSuccess || hipDeviceGetAttribute(&cus, hipDeviceAttributeMultiprocessorCount, dev) != hipSuccess) { fprintf(stderr, "kernel_launch: device query failed\n"); grid = -1; return; }
        if (hipFuncSetAttribute((const void*)mega<0>, hipFuncAttributeMaxDynamicSharedMemorySize, LDS_BYTES) != hipSuccess) { fprintf(stderr, "kernel_launch: hipFuncSetAttribute failed\n"); grid = -1; return; }
        if (hipOccupancyMaxActiveBlocksPerMultiprocessor(&per_cu, (const void*)mega<0>, NWAVES * 64, LDS_BYTES) != hipSuccess || per_cu < 1) { fprintf(stderr, "kernel_launch: occupancy query says %d blocks/CU\n", per_cu); (void)hipGetLastError(); grid = -1; return; }
        if (cus != 256) { fprintf(stderr, "kernel_launch: built for 256 CUs, device has %d\n", cus); grid = -1; return; }
        grid = cus;
    }
    if (grid < 0) return;
    const float* in[22]; for (int i = 0; i < 22; ++i) in[i] = (const float*)d_in[i];
    float* out = (float*)d_out; unsigned char* ws = (unsigned char*)d_ws;
    (void)hipMemsetAsync(ws + WS_CTL, 0, CTL_ZERO_BYTES, stream);
    Args a{};
    for (int i = 0; i < 22; ++i) a.in[i] = in[i];
    a.out = out; a.ws = ws;
    auto launch = [&](int lo, int hi, int li) { a.ph_lo = lo; a.ph_hi = hi; a.li = li; hipLaunchKernelGGL(mega<0>, dim3(grid), dim3(NWAVES * 64), LDS_BYTES, stream, a); };
    launch(PH_PRO, PH_N, 0);
#if defined(EXTRA_LO)
#ifndef EXTRA_VAR
#define EXTRA_VAR 0
#endif
    { static bool once = false; if (!once) { once = true; (void)hipFuncSetAttribute((const void*)mega<EXTRA_VAR>, hipFuncAttributeMaxDynamicSharedMemorySize, LDS_BYTES); }
      a.ph_lo = EXTRA_LO; a.ph_hi = EXTRA_HI; a.li = 1; hipLaunchKernelGGL(mega<EXTRA_VAR>, dim3(grid), dim3(NWAVES * 64), LDS_BYTES, stream, a); }
#endif
#if defined(EXTRA2_LO)
    launch(EXTRA2_LO, EXTRA2_HI, 2);
#endif
}
```
